# Optimizing an MI355X kernel written in HIP

```python
import math
import jax, jax.numpy as jnp
from jax import lax
import numpy as np

D_MODEL = 1024
BATCH = 2
SEQ = 16384
DEPTH = 4

N_MIXERS = 3
N_MLSTM = (DEPTH + 2) // 3
N_S5 = (DEPTH + 1) // 3
N_SWA = DEPTH // 3
DN_ALPHA = (2 * DEPTH) ** 0.25
DN_BETA = (8 * DEPTH) ** -0.25
LN_EPS = 1e-5

M_HEADS = 4
M_DQK = D_MODEL // 8
M_DV = D_MODEL // M_HEADS
M_CONV = 4
M_CHUNK = 64
M_IN = 2 * M_HEADS * M_DQK + M_HEADS * M_DV + D_MODEL + 2 * M_HEADS

S5_GROUP = 16
S5_GROUPS = D_MODEL // S5_GROUP
S5_STATE = 64
S5_CHUNK = 128

A_HEADS = 16
A_KV_HEADS = 4
A_GROUP = A_HEADS // A_KV_HEADS
A_HEAD_DIM = D_MODEL // A_HEADS
WINDOW = 128
A_BLOCK = 128

E_GROUPS = 4
E_PER_GROUP = 8
N_EXPERTS = E_GROUPS * E_PER_GROUP
TOP_K = 2
D_EXPERT = 512
MOE_BLOCK = 128

kernel_name = 'hybrid_mlstm_s5_swa_hmoe_deepnorm'


def _layer_norm(x, g, b):
    xf = x.astype(jnp.float32)
    mu = xf.mean(-1, keepdims=True)
    var = jnp.mean(jnp.square(xf - mu), -1, keepdims=True)
    return ((xf - mu) * lax.rsqrt(var + LN_EPS)).astype(x.dtype) * g + b


def _causal_dwconv(x, w, b):
    k = w.shape[0]
    y = lax.conv_general_dilated(x, w[:, None, :], window_strides=(1,), padding=[(k - 1, 0)],
                                 dimension_numbers=('NWC', 'WIO', 'NWC'), feature_group_count=x.shape[-1])
    return y + b


def _mlstm_chunk_step(carry, inp):
    C, n, m = carry
    q, k, v, li, lf = inp
    L = q.shape[2]
    causal = jnp.tril(jnp.ones((L, L), bool))
    b = jnp.cumsum(lf, axis=-1)
    d = jnp.where(causal, b[..., :, None] - b[..., None, :] + li[..., None, :], -jnp.inf)
    inter = b + m[..., None]
    m_t = jnp.maximum(inter, d.max(-1))
    w = jnp.exp(d - m_t[..., None]) * jnp.einsum('bhtk,bhsk->bhts', q, k)
    e_inter = jnp.exp(inter - m_t)
    num = jnp.einsum('bhts,bhsv->bhtv', w, v) + e_inter[..., None] * jnp.einsum('bhtk,bhkv->bhtv', q, C)
    den = w.sum(-1) + e_inter * jnp.einsum('bhtk,bhk->bht', q, n)
    h = num / jnp.maximum(jnp.abs(den), jnp.exp(-m_t))[..., None]
    b_last = b[..., -1]
    g = b_last[..., None] - b + li
    m_new = jnp.maximum(b_last + m, g.max(-1))
    decay = jnp.exp(b_last + m - m_new)
    wk = jnp.exp(g - m_new[..., None])[..., None] * k
    C_new = decay[..., None, None] * C + jnp.einsum('bhsk,bhsv->bhkv', wk, v)
    n_new = decay[..., None] * n + wk.sum(2)
    return (C_new, n_new, m_new), h


def _mlstm_mixer(h, w_in, conv_w, conv_b, b_if, norm_g, w_out):
    Bn, S, _ = h.shape
    nc = S // M_CHUNK
    f32 = jnp.float32
    n_qk = 2 * M_HEADS * M_DQK
    n_v = M_HEADS * M_DV
    proj = h @ w_in
    qk = jax.nn.silu(_causal_dwconv(proj[..., :n_qk], conv_w, conv_b))
    v = proj[..., n_qk:n_qk + n_v]
    o = proj[..., n_qk + n_v:n_qk + n_v + D_MODEL]
    gates = (proj[..., n_qk + n_v + D_MODEL:] + b_if).astype(f32)
    li = gates[..., :M_HEADS]
    lf = jax.nn.log_sigmoid(gates[..., M_HEADS:])

    def to_chunks(t, dh):
        return t.astype(f32).reshape(Bn, nc, M_CHUNK, M_HEADS, dh).transpose(1, 0, 3, 2, 4)

    def gate_chunks(t):
        return t.reshape(Bn, nc, M_CHUNK, M_HEADS).transpose(1, 0, 3, 2)

    q = to_chunks(qk[..., :M_HEADS * M_DQK], M_DQK)
    k = to_chunks(qk[..., M_HEADS * M_DQK:], M_DQK) * (M_DQK ** -0.5)
    vc = to_chunks(v, M_DV)
    init = (jnp.zeros((Bn, M_HEADS, M_DQK, M_DV), f32), jnp.zeros((Bn, M_HEADS, M_DQK), f32),
            jnp.zeros((Bn, M_HEADS), f32))
    _, hs = lax.scan(_mlstm_chunk_step, init, (q, k, vc, gate_chunks(li), gate_chunks(lf)))
    hs = hs.transpose(1, 0, 3, 2, 4).reshape(Bn, S, M_HEADS, M_DV)
    mu = hs.mean(-1, keepdims=True)
    var = jnp.mean(jnp.square(hs - mu), -1, keepdims=True)
    hn = ((hs - mu) * lax.rsqrt(var + LN_EPS)).reshape(Bn, S, n_v).astype(h.dtype) * norm_g
    return (hn * jax.nn.sigmoid(o)) @ w_out


def _cmul_scan_op(e1, e2):
    a1r, a1i, b1r, b1i = e1
    a2r, a2i, b2r, b2i = e2
    return (a2r * a1r - a2i * a1i, a2r * a1i + a2i * a1r,
            a2r * b1r - a2i * b1i + b2r, a2r * b1i + a2i * b1r + b2i)


def _s5_mixer(h, w_in, lam_re, lam_im, log_dt, b_re, b_im, c_re, c_im, d_skip, w_glu):
    Bn, S, _ = h.shape
    f32 = jnp.float32
    L = S5_CHUNK
    nc = S // L
    u = h @ w_in
    lr = lam_re.astype(f32)
    lim = lam_im.astype(f32)
    dt = jnp.exp(log_dt.astype(f32))[:, None]
    mag = jnp.exp(lr * dt)
    abar_re = mag * jnp.cos(lim * dt)
    abar_im = mag * jnp.sin(lim * dt)
    lam_sq = lr * lr + lim * lim
    t_re = ((abar_re - 1.0) * lr + abar_im * lim) / lam_sq
    t_im = (abar_im * lr - (abar_re - 1.0) * lim) / lam_sq
    br = b_re.astype(f32)
    bi = b_im.astype(f32)
    bb_re = t_re[..., None] * br - t_im[..., None] * bi
    bb_im = t_re[..., None] * bi + t_im[..., None] * br
    steps = jnp.arange(1, L + 1, dtype=f32)[:, None, None]
    pmag = jnp.exp(lr * dt * steps)
    pw_re = pmag * jnp.cos(lim * dt * steps)
    pw_im = pmag * jnp.sin(lim * dt * steps)
    cr = c_re.astype(f32)
    ci = c_im.astype(f32)

    def step(carry, u_c):
        x_re, x_im = carry
        bu_re = jnp.einsum('blgi,gpi->blgp', u_c, bb_re)
        bu_im = jnp.einsum('blgi,gpi->blgp', u_c, bb_im)
        a_re = jnp.broadcast_to(abar_re, bu_re.shape)
        a_im = jnp.broadcast_to(abar_im, bu_re.shape)
        _, _, xs_re, xs_im = lax.associative_scan(_cmul_scan_op, (a_re, a_im, bu_re, bu_im), axis=1)
        xs_re = xs_re + pw_re * x_re[:, None] - pw_im * x_im[:, None]
        xs_im = xs_im + pw_re * x_im[:, None] + pw_im * x_re[:, None]
        y = jnp.einsum('blgp,gip->blgi', xs_re, cr) - jnp.einsum('blgp,gip->blgi', xs_im, ci)
        return (xs_re[:, -1], xs_im[:, -1]), y

    uc = u.astype(f32).reshape(Bn, nc, L, S5_GROUPS, S5_GROUP).transpose(1, 0, 2, 3, 4)
    init = (jnp.zeros((Bn, S5_GROUPS, S5_STATE), f32), jnp.zeros((Bn, S5_GROUPS, S5_STATE), f32))
    _, ys = lax.scan(step, init, uc)
    y = ys.transpose(1, 0, 2, 3, 4).reshape(Bn, S, D_MODEL).astype(h.dtype) + d_skip * u
    z = jax.nn.gelu(y) @ w_glu
    return z[..., :D_MODEL] * jax.nn.sigmoid(z[..., D_MODEL:])


def _swa_mixer(h, w_qkv, b_qkv, sinks, w_o):
    Bn, S, _ = h.shape
    nb = S // A_BLOCK
    f32 = jnp.float32
    qkv = h @ w_qkv + b_qkv
    nq = A_HEADS * A_HEAD_DIM
    nkv = A_KV_HEADS * A_HEAD_DIM
    q = qkv[..., :nq].reshape(Bn, nb, A_BLOCK, A_KV_HEADS, A_GROUP, A_HEAD_DIM)
    k = qkv[..., nq:nq + nkv].reshape(Bn, S, A_KV_HEADS, A_HEAD_DIM)
    v = qkv[..., nq + nkv:].reshape(Bn, S, A_KV_HEADS, A_HEAD_DIM)

    def band(t):
        tp = jnp.pad(t, ((0, 0), (A_BLOCK, 0), (0, 0), (0, 0))).reshape(Bn, nb + 1, A_BLOCK, A_KV_HEADS, A_HEAD_DIM)
        return jnp.concatenate([tp[:, :-1], tp[:, 1:]], axis=2)

    kw = band(k)
    vw = band(v)
    s = jnp.einsum('bnqhgd,bnkhd->bhgnqk', q.astype(f32), kw.astype(f32)) * (A_HEAD_DIM ** -0.5)
    blk = jnp.arange(nb)[:, None, None] * A_BLOCK
    qpos = blk + jnp.arange(A_BLOCK)[None, :, None]
    kpos = blk - A_BLOCK + jnp.arange(2 * A_BLOCK)[None, None, :]
    valid = (kpos <= qpos) & (qpos - kpos < WINDOW) & (kpos >= 0)
    s = jnp.where(valid, s, -jnp.inf)
    sink = sinks.astype(f32).reshape(A_KV_HEADS, A_GROUP)[None, :, :, None, None]
    m = jnp.maximum(s.max(-1), sink)
    p = jnp.exp(s - m[..., None])
    p = p / (p.sum(-1) + jnp.exp(sink - m))[..., None]
    o = jnp.einsum('bhgnqk,bnkhd->bnqhgd', p.astype(h.dtype), vw).reshape(Bn, S, D_MODEL)
    return o @ w_o


def _hier_moe(h, w_group, b_group, w_router, b_router, w1, w3, w2):
    Bn, S, Dm = h.shape
    T = Bn * S
    f32 = jnp.float32
    xt = h.reshape(T, Dm)
    glog = (xt @ w_group + b_group).astype(f32)
    g_sel = jnp.argmax(glog, -1)
    p_g = jnp.take_along_axis(jax.nn.softmax(glog, -1), g_sel[:, None], -1)[:, 0]
    elog = (xt @ w_router + b_router).astype(f32).reshape(T, E_GROUPS, E_PER_GROUP)
    elog_g = jnp.take_along_axis(elog, g_sel[:, None, None], 1)[:, 0]
    top_v, top_i = lax.top_k(elog_g, TOP_K)
    w_tok = jax.nn.softmax(top_v, -1) * p_g[:, None]
    e_a = (g_sel[:, None] * E_PER_GROUP + top_i).reshape(-1)
    tok_a = jnp.repeat(jnp.arange(T, dtype=jnp.int32), TOP_K)
    w_a = w_tok.reshape(-1)
    n_assign = T * TOP_K
    order = jnp.argsort(e_a)
    se = e_a[order]
    stok = tok_a[order]
    sw = w_a[order]
    counts = jax.ops.segment_sum(jnp.ones_like(e_a), e_a, num_segments=N_EXPERTS)
    padded = (counts + MOE_BLOCK - 1) // MOE_BLOCK * MOE_BLOCK
    start = jnp.cumsum(counts) - counts
    pend = jnp.cumsum(padded)
    pstart = pend - padded
    pos = pstart[se] + (jnp.arange(n_assign) - start[se])
    P = n_assign + N_EXPERTS * MOE_BLOCK
    nblk = P // MOE_BLOCK
    buf_tok = jnp.zeros((P,), jnp.int32).at[pos].set(stok)
    buf_w = jnp.zeros((P,), f32).at[pos].set(sw)
    buf_x = jnp.zeros((P, Dm), h.dtype).at[pos].set(xt[stok])
    blk_e = jnp.clip(jnp.searchsorted(pend, jnp.arange(nblk) * MOE_BLOCK, side='right'), 0, N_EXPERTS - 1)

    def expert_block(args):
        xb, e = args
        return (jax.nn.silu(xb @ w1[e]) * (xb @ w3[e])) @ w2[e]

    y = lax.map(expert_block, (buf_x.reshape(nblk, MOE_BLOCK, Dm), blk_e)).reshape(P, Dm)
    y = y * buf_w[:, None].astype(y.dtype)
    return jnp.zeros((T, Dm), h.dtype).at[buf_tok].add(y).reshape(Bn, S, Dm)


def setup_inputs(seed: int = 0) -> dict:
    key = jax.random.key(seed)
    ks = iter(jax.random.split(key, 64))
    f32 = jnp.float32
    D = D_MODEL

    def nrm(shape, std):
        return jax.random.normal(next(ks), shape, f32) * std

    inp = {}
    inp['x'] = nrm((BATCH, SEQ, D), 1.0)
    inp['c'] = nrm((BATCH, D), 1.0)
    inp['ada_w'] = nrm((DEPTH, D, 6 * D), 0.5 * D ** -0.5)
    inp['ada_b'] = nrm((DEPTH, 6 * D), 0.01)
    inp['ln1_g'] = 1.0 + nrm((DEPTH, D), 0.02)
    inp['ln1_b'] = nrm((DEPTH, D), 0.01)
    inp['ln2_g'] = 1.0 + nrm((DEPTH, D), 0.02)
    inp['ln2_b'] = nrm((DEPTH, D), 0.01)
    inp['mlstm_w_in'] = nrm((N_MLSTM, D, M_IN), D ** -0.5)
    inp['mlstm_conv_w'] = nrm((N_MLSTM, M_CONV, 2 * M_HEADS * M_DQK), M_CONV ** -0.5)
    inp['mlstm_conv_b'] = nrm((N_MLSTM, 2 * M_HEADS * M_DQK), 0.01)
    f_bias = 3.0 + 3.0 * jax.random.uniform(next(ks), (N_MLSTM, M_HEADS), f32)
    inp['mlstm_b_if'] = jnp.concatenate([nrm((N_MLSTM, M_HEADS), 0.1) - 1.0, f_bias], -1)
    inp['mlstm_norm_g'] = 1.0 + nrm((N_MLSTM, M_HEADS * M_DV), 0.02)
    inp['mlstm_w_out'] = nrm((N_MLSTM, M_HEADS * M_DV, D), (M_HEADS * M_DV) ** -0.5 * DN_BETA)
    inp['s5_w_in'] = nrm((N_S5, D, D), D ** -0.5)
    inp['s5_lam_re'] = -0.5 + nrm((N_S5, S5_GROUPS, S5_STATE), 0.01)
    inp['s5_lam_im'] = math.pi * jnp.arange(S5_STATE, dtype=f32)[None, None, :] + nrm((N_S5, S5_GROUPS, S5_STATE), 0.01)
    inp['s5_log_dt'] = jax.random.uniform(next(ks), (N_S5, S5_GROUPS), f32, minval=math.log(1e-3), maxval=math.log(1e-1))
    inp['s5_b_re'] = nrm((N_S5, S5_GROUPS, S5_STATE, S5_GROUP), (2 * S5_GROUP) ** -0.5)
    inp['s5_b_im'] = nrm((N_S5, S5_GROUPS, S5_STATE, S5_GROUP), (2 * S5_GROUP) ** -0.5)
    inp['s5_c_re'] = nrm((N_S5, S5_GROUPS, S5_GROUP, S5_STATE), S5_STATE ** -0.5)
    inp['s5_c_im'] = nrm((N_S5, S5_GROUPS, S5_GROUP, S5_STATE), S5_STATE ** -0.5)
    inp['s5_d'] = nrm((N_S5, D), 1.0)
    inp['s5_w_glu'] = jnp.concatenate([nrm((N_S5, D, D), D ** -0.5 * DN_BETA), nrm((N_S5, D, D), D ** -0.5)], -1)
    n_qkv = (A_HEADS + 2 * A_KV_HEADS) * A_HEAD_DIM
    inp['swa_w_qkv'] = nrm((N_SWA, D, n_qkv), D ** -0.5)
    inp['swa_b_qkv'] = nrm((N_SWA, n_qkv), 0.01)
    inp['swa_sinks'] = nrm((N_SWA, A_HEADS), 0.5)
    inp['swa_w_o'] = nrm((N_SWA, A_HEADS * A_HEAD_DIM, D), (A_HEADS * A_HEAD_DIM) ** -0.5 * DN_BETA)
    inp['moe_w_group'] = nrm((DEPTH, D, E_GROUPS), D ** -0.5)
    inp['moe_b_group'] = nrm((DEPTH, E_GROUPS), 0.01)
    inp['moe_w_router'] = nrm((DEPTH, D, N_EXPERTS), D ** -0.5)
    inp['moe_b_router'] = nrm((DEPTH, N_EXPERTS), 0.01)
    inp['moe_w1'] = nrm((DEPTH, N_EXPERTS, D, D_EXPERT), D ** -0.5)
    inp['moe_w3'] = nrm((DEPTH, N_EXPERTS, D, D_EXPERT), D ** -0.5)
    inp['moe_w2'] = nrm((DEPTH, N_EXPERTS, D_EXPERT, D), D_EXPERT ** -0.5 * DN_BETA)
    return inp


def reference(x, c, ada_w, ada_b, ln1_g, ln1_b, ln2_g, ln2_b,
              mlstm_w_in, mlstm_conv_w, mlstm_conv_b, mlstm_b_if, mlstm_norm_g, mlstm_w_out,
              s5_w_in, s5_lam_re, s5_lam_im, s5_log_dt, s5_b_re, s5_b_im, s5_c_re, s5_c_im, s5_d, s5_w_glu,
              swa_w_qkv, swa_b_qkv, swa_sinks, swa_w_o,
              moe_w_group, moe_b_group, moe_w_router, moe_b_router, moe_w1, moe_w3, moe_w2):
    cond = jax.nn.silu(c)
    for i in range(DEPTH):
        mod = cond @ ada_w[i] + ada_b[i]
        sh1, sc1, g1, sh2, sc2, g2 = jnp.split(mod, 6, axis=-1)
        hin = x * (1.0 + sc1[:, None]) + sh1[:, None]
        kind = i % N_MIXERS
        j = i // N_MIXERS
        if kind == 0:
            y = _mlstm_mixer(hin, mlstm_w_in[j], mlstm_conv_w[j], mlstm_conv_b[j], mlstm_b_if[j],
                             mlstm_norm_g[j], mlstm_w_out[j])
        elif kind == 1:
            y = _s5_mixer(hin, s5_w_in[j], s5_lam_re[j], s5_lam_im[j], s5_log_dt[j], s5_b_re[j], s5_b_im[j],
                          s5_c_re[j], s5_c_im[j], s5_d[j], s5_w_glu[j])
        else:
            y = _swa_mixer(hin, swa_w_qkv[j], swa_b_qkv[j], swa_sinks[j], swa_w_o[j])
        x = _layer_norm(DN_ALPHA * x + g1[:, None] * y, ln1_g[i], ln1_b[i])
        hin = x * (1.0 + sc2[:, None]) + sh2[:, None]
        y = _hier_moe(hin, moe_w_group[i], moe_b_group[i], moe_w_router[i], moe_b_router[i],
                      moe_w1[i], moe_w3[i], moe_w2[i])
        x = _layer_norm(DN_ALPHA * x + g2[:, None] * y, ln2_g[i], ln2_b[i])
    return x
```

```cpp
#include <hip/hip_runtime.h>
#include <cstdio>
#include <cstdint>

#define DI __device__ __forceinline__
#define GAS __attribute__((address_space(1)))
#define LAS __attribute__((address_space(3)))
typedef unsigned short bf16;
typedef short bf16x8 __attribute__((ext_vector_type(8)));
typedef short s16x4 __attribute__((ext_vector_type(4)));
typedef float f32x4 __attribute__((ext_vector_type(4)));
typedef float f32x2 __attribute__((ext_vector_type(2)));
typedef unsigned u32x4 __attribute__((ext_vector_type(4)));
typedef unsigned u32x2 __attribute__((ext_vector_type(2)));

constexpr int BATCH = 2, SEQ = 16384, D = 1024, T = BATCH * SEQ, DEPTH = 4;
constexpr float DN_ALPHA = 1.681792830507429f;
constexpr float LN_EPS = 1e-5f;
constexpr int M_HEADS = 4, M_DQK = 128, M_DV = 256, M_CHUNK = 64, M_NIN = 3072  , M_IN = 3080;
constexpr int M_NSEG = 32, M_SEGT = SEQ / M_NSEG  , M_SEGC = M_SEGT / M_CHUNK  ;
constexpr int M_STATE = M_DQK * M_DV + M_DQK;
constexpr int S5_G = 64, S5_P = 64, S5_NSEG = 16, S5_SEGT = SEQ / S5_NSEG  ;
constexpr int A_HEADS = 16, A_KV = 4, A_GRP = 4, A_HD = 64, A_NQKV = 1536, A_WIN = 128;
constexpr int E_GROUPS = 4, E_PER = 8, N_EXP = 32, D_EXP = 512;
constexpr int MOE_P = 2 * T + N_EXP * 256;

constexpr size_t MiB = 1u << 20;
constexpr size_t WS_CTL = 0, CTL_ZERO_BYTES = 1 * MiB;
constexpr size_t WS_MOD = 1 * MiB;
constexpr size_t WS_S5ABAR = 2 * MiB;
constexpr size_t WS_S5BBT = WS_S5ABAR + 64 * 1024;
constexpr size_t WS_S5CMT = WS_S5BBT + 256 * 1024;
constexpr size_t WS_RWH = 3 * MiB;
constexpr size_t WS_RWL = WS_RWH + 512 * 1024;
constexpr size_t WS_GWH = 4 * MiB;
constexpr size_t WS_GWL = WS_GWH + 64 * 1024;
constexpr size_t WS_RB = WS_GWL + 64 * 1024;
constexpr size_t WS_SEGF = WS_RB + 4096;
constexpr size_t WS_SEGM = WS_SEGF + 4096;
constexpr size_t WS_S5END = 5 * MiB;
constexpr size_t WS_TOKES = 6 * MiB;
constexpr size_t WS_TOKW = WS_TOKES + 256 * 1024;
constexpr size_t WS_TOKPOS = WS_TOKW + 256 * 1024;
constexpr size_t WS_GATES = 7 * MiB;
constexpr size_t WS_WMIN = 8 * MiB;
constexpr size_t WS_WMOUT = 20 * MiB;
constexpr size_t WS_WS5IN = 24 * MiB;
constexpr size_t WS_WS5GLU = 26 * MiB;
constexpr size_t WS_WQKV = 30 * MiB;
constexpr size_t WS_WWO = 33 * MiB;
constexpr size_t WS_W13 = 36 * MiB;
constexpr size_t WS_W2 = WS_W13 + 256 * MiB;
constexpr size_t WS_SLOC = WS_W2 + 128 * MiB;
constexpr size_t WS_SINIT = WS_SLOC + 34 * MiB;
constexpr size_t WS_HIN = WS_SINIT + 34 * MiB;
constexpr size_t WS_R1 = WS_HIN + 64 * MiB;
constexpr size_t WS_PROJ = WS_R1, WS_MIXA = WS_R1 + 192 * MiB;
constexpr size_t WS_BUFX = WS_R1, WS_HID = WS_R1 + 144 * MiB;
constexpr size_t WS_R2 = WS_R1 + 256 * MiB;
constexpr size_t WS_YEXP = WS_R2, WS_YMIX = WS_R2;
constexpr size_t WS_END = WS_R2 + 144 * MiB;
constexpr int CW_BAR = 4096;
constexpr int CW_GCNT = 16384;

constexpr int RING_BYTES = 131072;
constexpr int MISC_OFF = RING_BYTES;
constexpr int LDS_BYTES = 147456;

DI unsigned f2bf(float f) { unsigned u = __builtin_bit_cast(unsigned, f); return (u + 0x7fffu + ((u >> 16) & 1u)) >> 16; }
DI unsigned pk2(float lo, float hi) { return f2bf(lo) | (f2bf(hi) << 16); }
DI float bf2f(unsigned b) { return __builtin_bit_cast(float, b << 16); }
DI float bflo(unsigned w) { return __builtin_bit_cast(float, w << 16); }
DI float bfhi(unsigned w) { return __builtin_bit_cast(float, w & 0xffff0000u); }
DI f32x4 MMA(bf16x8 a, bf16x8 b, f32x4 c) { return __builtin_amdgcn_mfma_f32_16x16x32_bf16(a, b, c, 0, 0, 0); }
DI float wave_sum(float v) {
#pragma unroll
    for (int o = 1; o < 64; o <<= 1) v += __shfl_xor(v, o);
    return v;
}
DI float sigmoidf_(float x) { return 1.0f / (1.0f + __expf(-x)); }
#define LDS_WAIT() asm volatile("s_waitcnt lgkmcnt(0)" ::: "memory")
#define VM_WAIT() asm volatile("s_waitcnt vmcnt(0)" ::: "memory")

namespace pg8 {
#define PG8_LAS __attribute__((address_space(3)))
typedef unsigned short bf16_t;
typedef short bf16x8 __attribute__((ext_vector_type(8)));
typedef float f32x4 __attribute__((ext_vector_type(4)));
typedef unsigned u32x4 __attribute__((ext_vector_type(4)));
constexpr int BM = 256, BK = 64, HALF = 128, HTB = HALF * BK * 2  , STAGE_BYTES = 8 * HTB, NXCD = 8, WGM = 8;

__host__ __device__ __forceinline__ int lds_byte(int r, int c) { const int st = (r >> 4) * 2 + (c >> 5), rr = r & 15, cc = c & 31, ob = rr * 64 + cc * 2; return st * 1024 + (ob ^ (((ob >> 9) & 1) << 5)); }
__host__ __device__ __forceinline__ void stage_rc(int b, int& R, int& C) { const int st = b / 1024, sb = b % 1024, swz = sb ^ (((sb >> 9) & 1) << 5); R = (st >> 1) * 16 + swz / 64; C = (st & 1) * 32 + (swz % 64) / 2; }
__host__ __device__ __forceinline__ int perm32(int rho) { const int n = rho >> 4, i = rho & 15; return 8 * (i >> 2) + 4 * n + (i & 3); }

struct Unit { int pm, pn; };
struct Gemm { const bf16_t* A; const bf16_t* Bt; int M, N, K; };

struct StaticOrder {
    int nM, nN, nwg, G, c;
    __host__ __device__ void init(int M, int N, int G_, int c_) { nM = M / BM; nN = N / BM; nwg = nM * nN; G = G_; c = c_; }
    __host__ __device__ bool next(int i, Unit& u) const {
        const long L = (long)i * G + c; if (L >= nwg) return false;
        int wgid = (int)L; { const int q = nwg / NXCD, r = nwg % NXCD, xcd = wgid % NXCD, off = wgid / NXCD; wgid = (xcd < r ? xcd * (q + 1) : r * (q + 1) + (xcd - r) * q) + off; }
        const int nig = WGM * nN, gid = wgid / nig, fm = gid * WGM, gsz = (nM - fm) < WGM ? (nM - fm) : WGM;
        u.pm = fm + ((wgid % nig) % gsz); u.pn = (wgid % nig) / gsz; return true;
    }
    __device__ __forceinline__ void a_ready(const Unit&) const {}
    __device__ __forceinline__ void done(const Unit&) const {}
};
struct MoeOrder {
    const PG8_LAS int* tbl; int G, c, nunits;
    __device__ __forceinline__ bool next(int i, Unit& u) const {
        const long L = (long)i * G + c; if (L >= nunits) return false;
        int wgid = (int)L; { const int q = nunits / NXCD, r = nunits % NXCD, xcd = wgid % NXCD, off = wgid / NXCD; wgid = (xcd < r ? xcd * (q + 1) : r * (q + 1) + (xcd - r) * q) + off; }
        int e = 0;
#pragma unroll
        for (int j = 1; j < 32; ++j) e += (wgid >= tbl[j]) ? 1 : 0;
        const int local = wgid - tbl[e], tb = tbl[33 + e], nt = tbl[34 + e] - tb;
        const int pn = local / nt, tl = local - pn * nt;
        u.pm = __builtin_amdgcn_readfirstlane(tb + tl); u.pn = __builtin_amdgcn_readfirstlane(e * 4 + pn); return true;
    }
    __device__ __forceinline__ void a_ready(const Unit&) const {}
    __device__ __forceinline__ void done(const Unit&) const {}
};

__device__ __forceinline__ unsigned cvt_pk_bf16(float lo, float hi) { unsigned r; asm volatile("v_cvt_pk_bf16_f32 %0, %1, %2" : "=v"(r) : "v"(lo), "v"(hi)); return r; }

struct EpiStore {
    static constexpr bool PERM = true, AFTER_DRAIN = false;
    bf16_t* O; int ldc; const float* bias; int pn_mask;
    __device__ __forceinline__ void operator()(const f32x4 (&acc)[2][2][4][2], const Unit& u, int wr, int wc, int fr, int fq) const {
        const int row0 = u.pm * BM + wr * 64 + fr; const int col0 = (u.pn & pn_mask) * BM + wc * 32 + 8 * fq;
        f32x4 bv[2][2];
#pragma unroll
        for (int bj = 0; bj < 2; ++bj)
#pragma unroll
            for (int n = 0; n < 2; ++n) bv[bj][n] = bias ? *(const f32x4*)(bias + col0 + bj * HALF + 4 * n) : (f32x4){0.f, 0.f, 0.f, 0.f};
#pragma unroll
        for (int ai = 0; ai < 2; ++ai)
#pragma unroll
            for (int m = 0; m < 4; ++m) { bf16_t* rowp = O + (size_t)(row0 + ai * HALF + m * 16) * ldc + col0;
#pragma unroll
                for (int bj = 0; bj < 2; ++bj) { const f32x4 v0 = acc[ai][bj][m][0] + bv[bj][0], v1 = acc[ai][bj][m][1] + bv[bj][1];
                    u32x4 w; w.x = cvt_pk_bf16(v0[0], v0[1]); w.y = cvt_pk_bf16(v0[2], v0[3]); w.z = cvt_pk_bf16(v1[0], v1[1]); w.w = cvt_pk_bf16(v1[2], v1[3]);
                    *(u32x4*)(rowp + bj * HALF) = w; } }
    }
};
template <int MODE> struct EpiPair {
    static constexpr bool PERM = true, AFTER_DRAIN = false;
    bf16_t* O; int ldc; int pn_mask;
    __device__ __forceinline__ void operator()(const f32x4 (&acc)[2][2][4][2], const Unit& u, int wr, int wc, int fr, int fq) const {
        const int row0 = u.pm * BM + wr * 64 + fr; const int col0 = (u.pn & pn_mask) * HALF + wc * 32 + 8 * fq;
#pragma unroll
        for (int ai = 0; ai < 2; ++ai)
#pragma unroll
            for (int m = 0; m < 4; ++m) { bf16_t* rowp = O + (size_t)(row0 + ai * HALF + m * 16) * ldc + col0;
                float r[8];
#pragma unroll
                for (int n = 0; n < 2; ++n)
#pragma unroll
                    for (int j = 0; j < 4; ++j) { const float a = acc[ai][0][m][n][j], b = acc[ai][1][m][n][j];
                        r[n * 4 + j] = (MODE == 0) ? (a * b) / (1.0f + __expf(-a)) : a / (1.0f + __expf(-b)); }
                u32x4 w; w.x = cvt_pk_bf16(r[0], r[1]); w.y = cvt_pk_bf16(r[2], r[3]); w.z = cvt_pk_bf16(r[4], r[5]); w.w = cvt_pk_bf16(r[6], r[7]);
                *(u32x4*)rowp = w; }
    }
};
template <class Epi, class Sched, bool ALIGN_EPI = false, bool SP2 = false>
__device__ __forceinline__ void gemm_phase(PG8_LAS unsigned char* lds, const Gemm g, const Sched& S, const Epi& E) {
    const int tid = threadIdx.x, wid = __builtin_amdgcn_readfirstlane(tid >> 6), lane = tid & 63, wr = wid >> 2, wc = wid & 3, fr = lane & 15, fq = lane >> 4;
    const int K = g.K, nt = K / BK;
    unsigned voffA[2], voffB[2];
#pragma unroll
    for (int i = 0; i < 2; ++i) { int R, C; stage_rc(tid * 16 + i * 8192, R, C); const int Rb = Epi::PERM ? ((R & ~31) + perm32(R & 31)) : R;
        voffA[i] = (unsigned)(R * K + C) * 2u; voffB[i] = (unsigned)(Rb * K + C) * 2u; }
    const size_t kstep = (size_t)(BK * 2);
    const size_t hstep = (size_t)HALF * K * 2;
    const size_t tstep = 2 * hstep;
    const unsigned ldsw = (unsigned)wid * 1024u;
    const int aoff = lds_byte(wr * 64 + fr, fq * 8), boff = lds_byte(wc * 32 + fr, fq * 8);
#define PG8_SA(b, h) (((b) * 2 + (h)) * HTB)
#define PG8_SB(b, h) ((4 + (b) * 2 + (h)) * HTB)
#define PG8_STAGE(bufoff, gbase, voff) do { _Pragma("unroll") for (int _i = 0; _i < 2; ++_i) \
        __builtin_amdgcn_global_load_lds((const unsigned*)((const char*)(gbase) + (voff)[_i]), (PG8_LAS unsigned*)(lds + (bufoff) + ldsw + _i * 8192), 16, 0, 0); } while (0)
#define PG8_LDA(dst, b, h) do { _Pragma("unroll") for (int m = 0; m < 4; ++m) _Pragma("unroll") for (int k = 0; k < 2; ++k) dst[m][k] = *(const PG8_LAS bf16x8*)(lds + PG8_SA(b, h) + aoff + m * 2048 + k * 1024); } while (0)
#define PG8_LDB(dst, b, h) do { _Pragma("unroll") for (int n = 0; n < 2; ++n) _Pragma("unroll") for (int k = 0; k < 2; ++k) dst[n][k] = *(const PG8_LAS bf16x8*)(lds + PG8_SB(b, h) + boff + n * 2048 + k * 1024); } while (0)
#define PG8_MMA(ai, bj, At, Bt) do { __builtin_amdgcn_s_setprio(1); _Pragma("unroll") for (int m = 0; m < 4; ++m) _Pragma("unroll") for (int n = 0; n < 2; ++n) _Pragma("unroll") for (int k = 0; k < 2; ++k) \
        acc[ai][bj][m][n] = __builtin_amdgcn_mfma_f32_16x16x32_bf16(Bt[n][k], At[m][k], acc[ai][bj][m][n], 0, 0, 0); __builtin_amdgcn_s_setprio(0); } while (0)
#define PG8_WAIT_V(n) asm volatile("s_waitcnt vmcnt(" #n ")" ::: "memory")
#define PG8_WAIT_L(n) asm volatile("s_waitcnt lgkmcnt(" #n ")" ::: "memory")
#define PG8_BAR __builtin_amdgcn_s_barrier()
#define PG8_SCHED __builtin_amdgcn_sched_barrier(0)
    Unit cur, nxt; int ui = 0;
    if (!S.next(0, cur)) return;
    f32x4 acc[2][2][4][2];
#pragma unroll
    for (int a = 0; a < 2; ++a)
#pragma unroll
        for (int b = 0; b < 2; ++b)
#pragma unroll
            for (int m = 0; m < 4; ++m)
#pragma unroll
                for (int n = 0; n < 2; ++n) acc[a][b][m][n] = (f32x4){0.f, 0.f, 0.f, 0.f};
    bf16x8 At[4][2], B0[2][2], B1[2][2];
    const char* cA = (const char*)g.A + (size_t)cur.pm * tstep; const char* cB = (const char*)g.Bt + (size_t)cur.pn * tstep;
    S.a_ready(cur);
    if constexpr (SP2) {
        PG8_STAGE(PG8_SB(0, 0), cB, voffB); PG8_STAGE(PG8_SB(0, 1), cB + hstep, voffB); PG8_STAGE(PG8_SA(0, 0), cA, voffA); PG8_STAGE(PG8_SA(0, 1), cA + hstep, voffA);
        if (wr == 1) PG8_BAR;
        PG8_WAIT_V(2); PG8_BAR;
        PG8_STAGE(PG8_SB(1, 0), cB + kstep, voffB); PG8_STAGE(PG8_SA(1, 0), cA + kstep, voffA); PG8_STAGE(PG8_SB(1, 1), cB + hstep + kstep, voffB);
        PG8_WAIT_V(6); PG8_BAR;
    } else {
        PG8_STAGE(PG8_SB(0, 0), cB, voffB); PG8_STAGE(PG8_SA(0, 0), cA, voffA); PG8_STAGE(PG8_SB(0, 1), cB + hstep, voffB); PG8_STAGE(PG8_SA(0, 1), cA + hstep, voffA);
        if (wr == 1) PG8_BAR;
        PG8_WAIT_V(4); PG8_BAR;
        PG8_STAGE(PG8_SB(1, 0), cB + kstep, voffB); PG8_STAGE(PG8_SA(1, 0), cA + kstep, voffA); PG8_STAGE(PG8_SB(1, 1), cB + hstep + kstep, voffB);
        PG8_WAIT_V(6); PG8_BAR;
    }
    for (;;) {
        const bool has_next = S.next(ui + 1, nxt);
        const char* nA = has_next ? (const char*)g.A + (size_t)nxt.pm * tstep : cA; const char* nB = has_next ? (const char*)g.Bt + (size_t)nxt.pn * tstep : cB;
        for (int t = 0; t < nt; t += 2) {
            const bool last = (t == nt - 2);
            const char* a1 = cA + (size_t)(t + 1) * kstep;
            const char* a2 = last ? nA : cA + (size_t)(t + 2) * kstep; const char* b2 = last ? nB : cB + (size_t)(t + 2) * kstep;
            const char* a3 = a2 + kstep; const char* b3 = b2 + kstep;
            if (last && has_next) S.a_ready(nxt);
            if constexpr (SP2) {
            PG8_LDB(B0, 0, 0); PG8_LDB(B1, 0, 1); PG8_SCHED; PG8_LDA(At, 0, 0); PG8_STAGE(PG8_SA(1, 1), a1 + hstep, voffA);
            PG8_WAIT_V(8); PG8_WAIT_L(0); PG8_BAR; PG8_MMA(0, 0, At, B0); PG8_MMA(0, 1, At, B1); PG8_BAR; PG8_SCHED;
            PG8_LDA(At, 0, 1); PG8_STAGE(PG8_SB(0, 0), b2, voffB); PG8_STAGE(PG8_SB(0, 1), b2 + hstep, voffB); PG8_STAGE(PG8_SA(0, 0), a2, voffA);
            PG8_WAIT_V(8); PG8_WAIT_L(0); PG8_BAR; PG8_MMA(1, 0, At, B0); PG8_MMA(1, 1, At, B1); PG8_BAR; PG8_SCHED;
            PG8_LDB(B0, 1, 0); PG8_LDB(B1, 1, 1); PG8_SCHED; PG8_LDA(At, 1, 0); PG8_STAGE(PG8_SA(0, 1), a2 + hstep, voffA);
            PG8_WAIT_V(8); PG8_WAIT_L(0); PG8_BAR; PG8_MMA(0, 0, At, B0); PG8_MMA(0, 1, At, B1); PG8_BAR; PG8_SCHED;
            PG8_LDA(At, 1, 1); PG8_STAGE(PG8_SB(1, 0), b3, voffB); PG8_STAGE(PG8_SB(1, 1), b3 + hstep, voffB); PG8_STAGE(PG8_SA(1, 0), a3, voffA);
            PG8_WAIT_V(8); PG8_WAIT_L(0); PG8_BAR; PG8_MMA(1, 0, At, B0); PG8_MMA(1, 1, At, B1); PG8_BAR; PG8_SCHED;
            } else {
            PG8_LDB(B0, 0, 0); PG8_SCHED; PG8_LDA(At, 0, 0); PG8_STAGE(PG8_SA(1, 1), a1 + hstep, voffA);
            PG8_WAIT_L(8); PG8_BAR; PG8_WAIT_L(0); PG8_MMA(0, 0, At, B0); PG8_BAR; PG8_SCHED;
            PG8_LDB(B1, 0, 1); PG8_STAGE(PG8_SB(0, 0), b2, voffB);
            PG8_BAR; PG8_WAIT_L(0); PG8_MMA(0, 1, At, B1); PG8_BAR;
            PG8_LDA(At, 0, 1); PG8_STAGE(PG8_SA(0, 0), a2, voffA);
            PG8_BAR; PG8_WAIT_L(0); PG8_MMA(1, 0, At, B0); PG8_BAR; PG8_SCHED;
            PG8_STAGE(PG8_SB(0, 1), b2 + hstep, voffB);
            PG8_WAIT_V(6); PG8_BAR; PG8_MMA(1, 1, At, B1); PG8_BAR;
            PG8_LDB(B0, 1, 0); PG8_SCHED; PG8_LDA(At, 1, 0); PG8_STAGE(PG8_SA(0, 1), a2 + hstep, voffA);
            PG8_WAIT_L(8); PG8_BAR; PG8_WAIT_L(0); PG8_MMA(0, 0, At, B0); PG8_BAR; PG8_SCHED;
            PG8_LDB(B1, 1, 1); PG8_STAGE(PG8_SB(1, 0), b3, voffB);
            PG8_BAR; PG8_WAIT_L(0); PG8_MMA(0, 1, At, B1); PG8_BAR;
            PG8_LDA(At, 1, 1); PG8_STAGE(PG8_SA(1, 0), a3, voffA);
            PG8_BAR; PG8_WAIT_L(0); PG8_MMA(1, 0, At, B0); PG8_BAR; PG8_SCHED;
            PG8_STAGE(PG8_SB(1, 1), b3 + hstep, voffB);
            PG8_WAIT_V(6); PG8_BAR; PG8_MMA(1, 1, At, B1); PG8_BAR;
            }
        }
        if constexpr (ALIGN_EPI) { if (wr == 0) PG8_BAR; }
        if constexpr (!Epi::AFTER_DRAIN) { E(acc, cur, wr, wc, fr, fq); S.done(cur); }
        if (!has_next) break;
#pragma unroll
        for (int a = 0; a < 2; ++a)
#pragma unroll
            for (int b = 0; b < 2; ++b)
#pragma unroll
                for (int m = 0; m < 4; ++m)
#pragma unroll
                    for (int n = 0; n < 2; ++n) acc[a][b][m][n] = (f32x4){0.f, 0.f, 0.f, 0.f};
        cur = nxt; cA = nA; cB = nB; ++ui;
        if constexpr (ALIGN_EPI) { if (wr == 1) PG8_BAR; }
    }
    PG8_WAIT_V(0);
    if constexpr (!ALIGN_EPI) { if (wr == 0) PG8_BAR; }
    PG8_BAR;
    if constexpr (Epi::AFTER_DRAIN) { E.fused(acc, cur, wr, wc, fr, fq, lds, wid, lane); S.done(cur); }
#undef PG8_SA
#undef PG8_SB
#undef PG8_STAGE
#undef PG8_LDA
#undef PG8_LDB
#undef PG8_MMA
#undef PG8_WAIT_V
#undef PG8_WAIT_L
#undef PG8_BAR
#undef PG8_SCHED
}
}

#define XB_TMO      128
#define XB_XCNT(j)  (256  + 64 * (j))
#define XB_XSUB(j)  (1280 + 64 * (j))
#define XB_XGEN(j)  (2304 + 64 * (j))
#define XB_TOP      3328
#define XB_TOPGEN   3392
#define XCD_BAR_WORDS 3456
#define XB_SPIN_CAP (1u << 18)

__device__ __forceinline__ unsigned xb_ld(unsigned* p)              { return __hip_atomic_load(p, __ATOMIC_RELAXED, __HIP_MEMORY_SCOPE_AGENT); }
__device__ __forceinline__ unsigned xb_add(unsigned* p, unsigned v) { return __hip_atomic_fetch_add(p, v, __ATOMIC_RELAXED, __HIP_MEMORY_SCOPE_AGENT); }
__device__ __forceinline__ unsigned xb_xcc_id() { return (unsigned)__builtin_amdgcn_s_getreg((3 << 11) | 20) & 0xFu; }
#define XB_SPIN(cond, bar) do { unsigned _sp = 0; while (cond) { __builtin_amdgcn_s_sleep(1); \
    if ((++_sp & 255u) == 0u) { if (xb_ld(&(bar)[XB_TMO])) break; if (_sp > XB_SPIN_CAP) { atomicAdd(&(bar)[XB_TMO], 1u); break; } } } } while (0)

struct XcdBarrier {
    unsigned* bar; unsigned x;
    volatile LAS unsigned* st;
};

__device__ __forceinline__ XcdBarrier xcd_barrier_post(unsigned* bar, volatile LAS unsigned* st) {
    XcdBarrier b; b.bar = bar; b.x = xb_xcc_id(); b.st = st;
    if (threadIdx.x == 0) (void)xb_add(&bar[XB_XCNT(b.x)], 1u);
    return b;
}
__device__ __forceinline__ void xcd_barrier_complete(unsigned* bar, unsigned x, unsigned& nloc, unsigned& nx) {
    const unsigned G = gridDim.x * gridDim.y * gridDim.z;
    unsigned sum, cnt, mine, sp = 0u;
    for (;;) {
        sum = 0u; cnt = 0u; mine = 0u;
#pragma unroll
        for (unsigned j = 0; j < 16; ++j) { const unsigned c = xb_ld(&bar[XB_XCNT(j)]); sum += c; cnt += (c > 0u) ? 1u : 0u; mine = (j == x) ? c : mine; }
        if (sum == G) break;
        __builtin_amdgcn_s_sleep(1);
        if ((++sp & 255u) == 0u) { if (xb_ld(&bar[XB_TMO])) break; if (sp > XB_SPIN_CAP) { atomicAdd(&bar[XB_TMO], 1u); break; } }
    }
    nloc = mine > 0u ? mine : 1u; nx = cnt > 0u ? cnt : 1u;
}

__device__ __forceinline__ void xcd_barrier(const XcdBarrier& b) {
    asm volatile("s_waitcnt vmcnt(0)" ::: "memory");
    __syncthreads();
    if (threadIdx.x == 0) {
        unsigned* bar = b.bar;
        __builtin_amdgcn_s_waitcnt(0);
        unsigned nloc = b.st[0], nx = b.st[1];
        if (nloc == 0u) { xcd_barrier_complete(bar, b.x, nloc, nx); b.st[0] = nloc; b.st[1] = nx; }
        const unsigned old = xb_add(&bar[XB_XSUB(b.x)], 1u);
        const unsigned gen = old / nloc;
        if (old + 1u == (gen + 1u) * nloc) {
            __builtin_amdgcn_fence(__ATOMIC_RELEASE, "agent");
            asm volatile("s_waitcnt vmcnt(0)" ::: "memory");
            const unsigned og = xb_add(&bar[XB_TOP], 1u);
            const unsigned tg = og / nx;
            if (og + 1u == (tg + 1u) * nx) xb_add(&bar[XB_TOPGEN], 1u);
            else XB_SPIN(xb_ld(&bar[XB_TOPGEN]) == tg, bar);
            __builtin_amdgcn_fence(__ATOMIC_ACQUIRE, "agent");
            xb_add(&bar[XB_XGEN(b.x)], 1u);
            asm volatile("s_waitcnt vmcnt(0)" ::: "memory");
        } else {
            XB_SPIN(xb_ld(&bar[XB_XGEN(b.x)]) == gen, bar);
            __builtin_amdgcn_fence(__ATOMIC_ACQUIRE, "agent");
            asm volatile("s_waitcnt vmcnt(0)" ::: "memory");
        }
    }
    __syncthreads();
}

struct Ctx {
    LAS unsigned char* lds;
    unsigned* ctl;
    unsigned char* ws;
    const float* in[35];
    float* out;
    int tid, lane, wave, G, vcu;
};
#define WSP(T_, off) ((T_*)(C.ws + (off)))

DI void transpose_item(const float* W, int ldw, int K, int k0, int n0, bf16* WT, int drow0, LAS float* scr, int lane) {
#pragma unroll 8
    for (int i = 0; i < 32; ++i) { const int kk = 2 * i + (lane >> 5); scr[kk * 33 + (lane & 31)] = W[(size_t)(k0 + kk) * ldw + n0 + (lane & 31)]; }
    LDS_WAIT(); asm volatile("" ::: "memory");
    const int c = lane & 7;
#pragma unroll
    for (int j = 0; j < 4; ++j) { const int n = (lane >> 3) + 8 * j; const LAS float* s = scr + (8 * c) * 33 + n;
        u32x4 o; o.x = pk2(s[0 * 33], s[1 * 33]); o.y = pk2(s[2 * 33], s[3 * 33]); o.z = pk2(s[4 * 33], s[5 * 33]); o.w = pk2(s[6 * 33], s[7 * 33]);
        *(u32x4*)(WT + (size_t)(drow0 + n) * K + k0 + 8 * c) = o; }
    LDS_WAIT(); asm volatile("" ::: "memory");
}
DI int pair_row(int n, int half) { return (n >> 7) * 256 + half * 128 + (n & 127); }

DI void p0a_weights(Ctx& C) {
    LAS float* scr = (LAS float*)(C.lds + C.wave * 8448);
    const int gw = C.vcu * 8 + C.wave, NGW = C.G * 8, lane = C.lane;
    constexpr int I_MIN = 16 * 96, I_SQ = 16 * 32, I_GLU = 16 * 64, I_QKV = 16 * 48;
    constexpr int NDENSE = 2 * I_MIN + 2 * I_SQ + I_SQ + I_GLU + I_QKV + I_SQ;
    for (int it = gw; it < NDENSE; it += NGW) {
        int r = it;
        if (r < 2 * I_MIN) { const int j = r / I_MIN; r -= j * I_MIN; const int kb = r / 96, nb = r % 96;
            transpose_item(C.in[8] + (size_t)j * D * M_IN, M_IN, D, kb * 64, nb * 32, WSP(bf16, WS_WMIN) + (size_t)j * M_NIN * D, nb * 32, scr, lane); continue; } r -= 2 * I_MIN;
        if (r < 2 * I_SQ) { const int j = r / I_SQ; r -= j * I_SQ; const int kb = r / 32, nb = r % 32;
            transpose_item(C.in[13] + (size_t)j * D * D, D, D, kb * 64, nb * 32, WSP(bf16, WS_WMOUT) + (size_t)j * D * D, nb * 32, scr, lane); continue; } r -= 2 * I_SQ;
        if (r < I_SQ) { const int kb = r / 32, nb = r % 32; transpose_item(C.in[14], D, D, kb * 64, nb * 32, WSP(bf16, WS_WS5IN), nb * 32, scr, lane); continue; } r -= I_SQ;
        if (r < I_GLU) { const int kb = r / 64, nb = r % 64; const int n0 = nb * 32; transpose_item(C.in[23], 2 * D, D, kb * 64, n0, WSP(bf16, WS_WS5GLU), pair_row(n0 & 1023, n0 >> 10), scr, lane); continue; } r -= I_GLU;
        if (r < I_QKV) { const int kb = r / 48, nb = r % 48; transpose_item(C.in[24], A_NQKV, D, kb * 64, nb * 32, WSP(bf16, WS_WQKV), nb * 32, scr, lane); continue; } r -= I_QKV;
        { const int kb = r / 32, nb = r % 32; transpose_item(C.in[27], D, D, kb * 64, nb * 32, WSP(bf16, WS_WWO), nb * 32, scr, lane); }
    }
    constexpr int I_E = 256;
    constexpr int NMOE = DEPTH * N_EXP * 3 * I_E;
    for (int it = gw; it < NMOE; it += NGW) {
        const int le = it / (3 * I_E); int r = it - le * 3 * I_E; const int which = r / I_E; r -= which * I_E;
        if (which < 2) { const int kb = r / 16, nb = r % 16; const int n0 = nb * 32;
            transpose_item(C.in[which == 0 ? 32 : 33] + (size_t)le * D * D_EXP, D_EXP, D, kb * 64, n0, WSP(bf16, WS_W13) + (size_t)le * D * D, pair_row(n0, which), scr, lane); }
        else { const int kb = r / 32, nb = r % 32;
            transpose_item(C.in[34] + (size_t)le * D_EXP * D, D, D_EXP, kb * 64, nb * 32, WSP(bf16, WS_W2) + (size_t)le * D * D_EXP, nb * 32, scr, lane); }
    }
    const int gt = C.vcu * 512 + C.tid, NGT = C.G * 512;
    for (int i = gt; i < DEPTH * 48 * D; i += NGT) { const int l = i / (48 * D), c = (i / D) % 48, k = i % D; float w = 0.f;
        if (c < 4) w = C.in[28][((size_t)l * D + k) * E_GROUPS + c]; else if (c >= 16) w = C.in[30][((size_t)l * D + k) * N_EXP + (c - 16)];
        const unsigned h = f2bf(w); WSP(bf16, WS_RWH)[i] = (bf16)h; WSP(bf16, WS_RWL)[i] = (bf16)f2bf(w - bf2f(h)); }
    for (int i = gt; i < DEPTH * 48; i += NGT) { const int l = i / 48, c = i % 48; float b = 0.f;
        if (c < 4) b = C.in[29][l * E_GROUPS + c]; else if (c >= 16) b = C.in[31][l * N_EXP + (c - 16)]; WSP(float, WS_RB)[i] = b; }
    for (int i = gt; i < 2 * 16 * D; i += NGT) { const int j = i / (16 * D), c = (i / D) % 16, k = i % D; float w = 0.f;
        if (c < 8) w = C.in[8][((size_t)j * D + k) * M_IN + M_NIN + c];
        const unsigned h = f2bf(w); WSP(bf16, WS_GWH)[i] = (bf16)h; WSP(bf16, WS_GWL)[i] = (bf16)f2bf(w - bf2f(h)); }
    for (int i = gt; i < S5_G * S5_P; i += NGT) { const int g = i / S5_P, p = i % S5_P;
        const float dt = expf(C.in[17][g]), lr = C.in[15][i], li = C.in[16][i];
        const float mag = expf(lr * dt); float sn, cs; sincosf(li * dt, &sn, &cs);
        const float are = mag * cs, aim = mag * sn; WSP(float, WS_S5ABAR)[2 * i] = are; WSP(float, WS_S5ABAR)[2 * i + 1] = aim;
        const float lsq = lr * lr + li * li, tre = ((are - 1.0f) * lr + aim * li) / lsq, tim = (aim * lr - (are - 1.0f) * li) / lsq;
        bf16* bbt = WSP(bf16, WS_S5BBT) + (size_t)g * 128 * 16;
        for (int q = 0; q < 16; ++q) { const float br = C.in[18][(size_t)i * 16 + q], bi = C.in[19][(size_t)i * 16 + q];
            bbt[p * 16 + q] = (bf16)f2bf(tre * br - tim * bi); bbt[(64 + p) * 16 + q] = (bf16)f2bf(tre * bi + tim * br); }
        bf16* cmt = WSP(bf16, WS_S5CMT) + (size_t)g * 16 * 128;
        for (int q = 0; q < 16; ++q) { cmt[q * 128 + p] = (bf16)f2bf(C.in[20][((size_t)g * 16 + q) * S5_P + p]); cmt[q * 128 + 64 + p] = (bf16)f2bf(-C.in[21][((size_t)g * 16 + q) * S5_P + p]); } }
    __syncthreads();
    LAS float* cs = (LAS float*)C.lds;
    LAS float* red = cs + 2048;
    for (int i = C.tid; i < 2 * D; i += 512) { const float v = C.in[1][i]; cs[i] = v / (1.0f + __expf(-v)); }
    __syncthreads();
    for (int it = C.vcu; it < DEPTH * 96; it += C.G) { const int l = it / 96, cg = it % 96;
        const float* w = C.in[2] + (size_t)l * D * 6 * D + cg * 64 + lane; float a0 = 0.f, a1 = 0.f;
#pragma unroll 8
        for (int k = C.wave * 128; k < C.wave * 128 + 128; ++k) { const float wv = w[(size_t)k * 6 * D]; a0 += cs[k] * wv; a1 += cs[D + k] * wv; }
        red[(C.wave * 2 + 0) * 64 + lane] = a0; red[(C.wave * 2 + 1) * 64 + lane] = a1;
        __syncthreads();
        if (C.tid < 128) { const int b = C.tid >> 6, c = C.tid & 63; float s = 0.f;
#pragma unroll
            for (int w8 = 0; w8 < 8; ++w8) s += red[(w8 * 2 + b) * 64 + c];
            WSP(float, WS_MOD)[((size_t)l * 2 + b) * 6 * D + cg * 64 + c] = s + C.in[3][(size_t)l * 6 * D + cg * 64 + c]; }
        __syncthreads();
    }
}

constexpr int RP_XSTR = 1032;
constexpr int RP_XH = 0, RP_XL = RP_XH + 16 * RP_XSTR * 2, RP_PART = RP_XL + 16 * RP_XSTR * 2, RP_LOG = RP_PART + 8 * 16 * 48 * 4, RP_REC = RP_LOG + 16 * 48 * 4,
              RP_LCNT = RP_REC + 128 * 6 * 4, RP_END = RP_LCNT + 64 * 4;
static_assert(RP_END <= RING_BYTES, "row phase LDS");

template <int MODE, int NT, bool WRITE_HIN>
DI void row_phase(Ctx& C, const float* xsrc, const int layer, const int gate_idx, const float* lng, const float* lnb, const int mlayer, const int sc_idx, const int sh_idx, const int gj) {
    const int lane = C.lane, wave = C.wave, tid = C.tid, q = lane >> 4, fr = lane & 15;
    LAS bf16* XH = (LAS bf16*)(C.lds + RP_XH); LAS bf16* XL = (LAS bf16*)(C.lds + RP_XL);
    LAS float* PART = (LAS float*)(C.lds + RP_PART); LAS float* LOG = (LAS float*)(C.lds + RP_LOG);
    LAS int* REC = (LAS int*)(C.lds + RP_REC); LAS int* LCNT = (LAS int*)(C.lds + RP_LCNT);
    const float* MOD = WSP(float, WS_MOD);
    bf16x8 wh[NT > 0 ? NT : 1][4], wl[NT > 0 ? NT : 1][4];
    if constexpr (NT > 0) {
        const bf16* th = (NT == 3) ? WSP(bf16, WS_RWH) + (size_t)layer * 48 * D : WSP(bf16, WS_GWH) + (size_t)gj * 16 * D;
        const bf16* tl = (NT == 3) ? WSP(bf16, WS_RWL) + (size_t)layer * 48 * D : WSP(bf16, WS_GWL) + (size_t)gj * 16 * D;
#pragma unroll
        for (int nt = 0; nt < NT; ++nt)
#pragma unroll
            for (int ks = 0; ks < 4; ++ks) { const size_t o = (size_t)(nt * 16 + fr) * D + wave * 128 + ks * 32 + 8 * q;
                wh[nt][ks] = *(const bf16x8*)(th + o); wl[nt][ks] = *(const bf16x8*)(tl + o); }
    }
    for (int rb = C.vcu; rb < T / 128; rb += C.G) {
        const int b = (rb * 128) / SEQ;
        f32x4 vg[4], vlg[4], vlb[4], vsc[4], vsh[4];
#pragma unroll
        for (int j = 0; j < 4; ++j) { const int c = 4 * lane + 256 * j;
            if constexpr (MODE != 0) { vg[j] = *(const f32x4*)(MOD + ((size_t)layer * 2 + b) * 6 * D + gate_idx * D + c); vlg[j] = *(const f32x4*)(lng + c); vlb[j] = *(const f32x4*)(lnb + c); }
            if constexpr (WRITE_HIN) { vsc[j] = *(const f32x4*)(MOD + ((size_t)mlayer * 2 + b) * 6 * D + sc_idx * D + c) + 1.0f; vsh[j] = *(const f32x4*)(MOD + ((size_t)mlayer * 2 + b) * 6 * D + sh_idx * D + c); } }
        if constexpr (NT == 3) { if (tid < 32) LCNT[tid] = 0; }
        __syncthreads();
        for (int grp = 0; grp < 8; ++grp) {
#pragma unroll
            for (int rr = 0; rr < 2; ++rr) {
                const int lr = 2 * wave + rr; const size_t t = (size_t)rb * 128 + grp * 16 + lr;
                f32x4 v[4];
#pragma unroll
                for (int j = 0; j < 4; ++j) v[j] = *(const f32x4*)(xsrc + t * D + 4 * lane + 256 * j);
                if constexpr (MODE == 1) {
                    const bf16* yr = WSP(bf16, WS_YMIX) + t * D + 4 * lane;
#pragma unroll
                    for (int j = 0; j < 4; ++j) { const u32x2 w = *(const u32x2*)(yr + 256 * j); const f32x4 y = {bflo(w.x), bfhi(w.x), bflo(w.y), bfhi(w.y)}; v[j] = v[j] * DN_ALPHA + vg[j] * y; }
                }
                if constexpr (MODE == 2) {
                    const int p0 = WSP(int, WS_TOKPOS)[2 * t], p1 = WSP(int, WS_TOKPOS)[2 * t + 1]; const float w0 = WSP(float, WS_TOKW)[2 * t], w1 = WSP(float, WS_TOKW)[2 * t + 1];
                    const bf16* y0 = WSP(bf16, WS_YEXP) + (size_t)p0 * D + 4 * lane; const bf16* y1 = WSP(bf16, WS_YEXP) + (size_t)p1 * D + 4 * lane;
#pragma unroll
                    for (int j = 0; j < 4; ++j) { const u32x2 a = *(const u32x2*)(y0 + 256 * j), c2 = *(const u32x2*)(y1 + 256 * j);
                        const f32x4 y = (f32x4){bflo(a.x), bfhi(a.x), bflo(a.y), bfhi(a.y)} * w0 + (f32x4){bflo(c2.x), bfhi(c2.x), bflo(c2.y), bfhi(c2.y)} * w1;
                        v[j] = v[j] * DN_ALPHA + vg[j] * y; }
                }
                if constexpr (MODE != 0) {
                    float s = 0.f;
#pragma unroll
                    for (int j = 0; j < 4; ++j) s += (v[j].x + v[j].y) + (v[j].z + v[j].w);
                    const float mean = wave_sum(s) * (1.0f / D); float s2 = 0.f;
#pragma unroll
                    for (int j = 0; j < 4; ++j) { v[j] = v[j] - mean; s2 += (v[j].x * v[j].x + v[j].y * v[j].y) + (v[j].z * v[j].z + v[j].w * v[j].w); }
                    const float rstd = 1.0f / sqrtf(wave_sum(s2) * (1.0f / D) + LN_EPS);
#pragma unroll
                    for (int j = 0; j < 4; ++j) { v[j] = v[j] * rstd * vlg[j] + vlb[j]; *(f32x4*)(C.out + t * D + 4 * lane + 256 * j) = v[j]; }
                }
                if constexpr (WRITE_HIN) {
#pragma unroll
                    for (int j = 0; j < 4; ++j) { const f32x4 h = v[j] * vsc[j] + vsh[j];
                        const unsigned h0 = f2bf(h.x), h1 = f2bf(h.y), h2 = f2bf(h.z), h3 = f2bf(h.w);
                        u32x2 hw; hw.x = h0 | (h1 << 16); hw.y = h2 | (h3 << 16);
                        *(u32x2*)(WSP(bf16, WS_HIN) + t * D + 4 * lane + 256 * j) = hw;
                        if constexpr (NT > 0) {
                            u32x2 lw; lw.x = pk2(h.x - bf2f(h0), h.y - bf2f(h1)); lw.y = pk2(h.z - bf2f(h2), h.w - bf2f(h3));
                            *(LAS u32x2*)(XH + lr * RP_XSTR + 4 * lane + 256 * j) = hw; *(LAS u32x2*)(XL + lr * RP_XSTR + 4 * lane + 256 * j) = lw; } }
                }
            }
            if constexpr (NT > 0) {
                __syncthreads();
                f32x4 acc[NT];
#pragma unroll
                for (int nt = 0; nt < NT; ++nt) acc[nt] = (f32x4){0.f, 0.f, 0.f, 0.f};
#pragma unroll
                for (int ks = 0; ks < 4; ++ks) { const int o = fr * RP_XSTR + wave * 128 + ks * 32 + 8 * q;
                    const bf16x8 ah = *(const LAS bf16x8*)(XH + o), al = *(const LAS bf16x8*)(XL + o);
#pragma unroll
                    for (int nt = 0; nt < NT; ++nt) { acc[nt] = MMA(ah, wh[nt][ks], acc[nt]); acc[nt] = MMA(al, wh[nt][ks], acc[nt]); acc[nt] = MMA(ah, wl[nt][ks], acc[nt]); } }
#pragma unroll
                for (int nt = 0; nt < NT; ++nt)
#pragma unroll
                    for (int r = 0; r < 4; ++r) PART[(wave * 16 + 4 * q + r) * 48 + nt * 16 + fr] = acc[nt][r];
                __syncthreads();
                if constexpr (NT == 1) {
                    if (tid < 128) { const int row = tid >> 3, c = tid & 7; float s = 0.f;
#pragma unroll
                        for (int w8 = 0; w8 < 8; ++w8) s += PART[(w8 * 16 + row) * 48 + c];
                        WSP(float, WS_GATES)[((size_t)rb * 128 + grp * 16 + row) * 8 + c] = s; }
                } else {
                    const float* rbias = WSP(float, WS_RB) + layer * 48;
                    for (int idx = tid; idx < 16 * 48; idx += 512) { const int row = idx / 48, c = idx % 48; float s = 0.f;
#pragma unroll
                        for (int w8 = 0; w8 < 8; ++w8) s += PART[(w8 * 16 + row) * 48 + c];
                        LOG[idx] = s + rbias[c]; }
                    __syncthreads();
                    if (tid < 16) {
                        const LAS float* lg = LOG + tid * 48; int gs = 0; float gm = lg[0];
#pragma unroll
                        for (int g = 1; g < 4; ++g) if (lg[g] > gm) { gm = lg[g]; gs = g; }
                        float den = 0.f;
#pragma unroll
                        for (int g = 0; g < 4; ++g) den += __expf(lg[g] - gm);
                        const float pg = 1.0f / den;
                        const LAS float* el = lg + 16 + gs * 8; int i0 = 0; float v0 = el[0];
#pragma unroll
                        for (int i = 1; i < 8; ++i) if (el[i] > v0) { v0 = el[i]; i0 = i; }
                        int i1 = -1; float v1 = -3.0e38f;
#pragma unroll
                        for (int i = 0; i < 8; ++i) if (i != i0 && el[i] > v1) { v1 = el[i]; i1 = i; }
                        const float e1 = __expf(v1 - v0), w0 = pg / (1.0f + e1), w1 = pg * e1 / (1.0f + e1);
                        const int ex0 = gs * 8 + i0, ex1 = gs * 8 + i1;
                        const int ls0 = __hip_atomic_fetch_add(&LCNT[ex0], 1, __ATOMIC_RELAXED, __HIP_MEMORY_SCOPE_WORKGROUP), ls1 = __hip_atomic_fetch_add(&LCNT[ex1], 1, __ATOMIC_RELAXED, __HIP_MEMORY_SCOPE_WORKGROUP);
                        const int rloc = grp * 16 + tid;
                        REC[rloc * 6 + 0] = ex0; REC[rloc * 6 + 1] = ex1; REC[rloc * 6 + 2] = ls0; REC[rloc * 6 + 3] = ls1;
                        REC[rloc * 6 + 4] = __builtin_bit_cast(int, w0); REC[rloc * 6 + 5] = __builtin_bit_cast(int, w1);
                    }
                }
                __syncthreads();
            }
        }
        if constexpr (NT == 3) {
            __syncthreads();
            if (tid < 32) { const int n = LCNT[tid]; const unsigned gb = n ? atomicAdd(C.ctl + CW_GCNT + layer * 32 + tid, (unsigned)n) : 0u; LCNT[32 + tid] = (int)gb; }
            __syncthreads();
            if (tid < 256) { const int rloc = tid >> 1, k = tid & 1; const int e = REC[rloc * 6 + k], ls = REC[rloc * 6 + 2 + k]; const size_t t = (size_t)rb * 128 + rloc;
                WSP(int, WS_TOKES)[2 * t + k] = e | ((LCNT[32 + e] + ls) << 8); WSP(int, WS_TOKW)[2 * t + k] = REC[rloc * 6 + 4 + k]; }
            __syncthreads();
        }
    }
}

DI int moe_tables(Ctx& C, int layer) {
    LAS int* tbl = (LAS int*)(C.lds + MISC_OFF);
    if (C.tid == 0) { int tb = 0;
        for (int e = 0; e < N_EXP; ++e) { const unsigned n = __hip_atomic_load(C.ctl + CW_GCNT + layer * 32 + e, __ATOMIC_RELAXED, __HIP_MEMORY_SCOPE_AGENT);
            tbl[e] = tb * 4; tbl[33 + e] = tb; tb += (int)((n + 255u) >> 8); }
        tbl[32] = tb * 4; tbl[65] = tb; }
    __syncthreads();
    return tbl[32];
}
DI void moe_scatter(Ctx& C, int layer) {
    (void)moe_tables(C, layer);
    const LAS int* tbl = (const LAS int*)(C.lds + MISC_OFF);
    const int gw = C.vcu * 8 + C.wave, NGW = C.G * 8, lane = C.lane;
    for (int t = gw; t < T; t += NGW) {
        const int es0 = WSP(int, WS_TOKES)[2 * t], es1 = WSP(int, WS_TOKES)[2 * t + 1];
        const int p0 = tbl[33 + (es0 & 255)] * 256 + (es0 >> 8), p1 = tbl[33 + (es1 & 255)] * 256 + (es1 >> 8);
        if (lane == 0) { WSP(int, WS_TOKPOS)[2 * t] = p0; WSP(int, WS_TOKPOS)[2 * t + 1] = p1; }
        const u32x4* src = (const u32x4*)(WSP(bf16, WS_HIN) + (size_t)t * D) + lane;
        const u32x4 a = src[0], b2 = src[64];
        u32x4* d0 = (u32x4*)(WSP(bf16, WS_BUFX) + (size_t)p0 * D) + lane; u32x4* d1 = (u32x4*)(WSP(bf16, WS_BUFX) + (size_t)p1 * D) + lane;
        d0[0] = a; d0[64] = b2; d1[0] = a; d1[64] = b2;
    }
}

constexpr int ML_QSTR = 136, ML_TSTR = 72, ML_HSTR = 264;
constexpr int ML_QS = 0, ML_KS = ML_QS + 64 * ML_QSTR * 2, ML_VT = ML_KS + 64 * ML_QSTR * 2, ML_KWT = ML_VT + 256 * ML_TSTR * 2, ML_WM = ML_KWT + 128 * ML_TSTR * 2,
              ML_CW = ML_WM + 64 * ML_TSTR * 2, ML_AP = ML_CW + 2 * 5 * 128 * 4, ML_FL = ML_AP + 2048, ML_MR = ML_FL + 2048, ML_CH = ML_MR + 2048  ,
              ML_NS = ML_CH + 8 * 256, ML_STP = ML_NS + 512, ML_MRS = ML_STP + 64 * 8 * 8, ML_TMP = ML_MRS + 512, ML_END = ML_TMP + 256;
static_assert(ML_END <= RING_BYTES && 64 * ML_HSTR * 2 <= ML_VT, "mlstm LDS");

DI void mlstm_seg_scalars(Ctx& C, int mj, int bh, int seg) {
    LAS float* AP = (LAS float*)(C.lds + ML_AP); LAS float* FL = (LAS float*)(C.lds + ML_FL); LAS float* MR = (LAS float*)(C.lds + ML_MR); LAS float* TMP = (LAS float*)(C.lds + ML_TMP);
    const int b = bh >> 2, h = bh & 3, lane = C.lane, wave = C.wave; const size_t t = (size_t)b * SEQ + seg * M_SEGT + C.tid;
    const float* g = WSP(float, WS_GATES) + t * 8; const float* bif = C.in[11] + mj * 8;
    const float li = g[h] + bif[h], x = g[4 + h] + bif[4 + h];
    const float lf = fminf(x, 0.f) - log1pf(expf(-fabsf(x)));
    float s = lf;
#pragma unroll
    for (int o = 1; o < 64; o <<= 1) { const float n = __shfl_up(s, o); if (lane >= o) s += n; }
    if (lane == 63) TMP[wave] = s;
    __syncthreads();
    float off = 0.f;
    for (int w = 0; w < wave; ++w) off += TMP[w];
    s += off;
    const float ap = li - s; float m = ap;
#pragma unroll
    for (int o = 1; o < 64; o <<= 1) { const float n = __shfl_up(m, o); if (lane >= o) m = fmaxf(m, n); }
    if (lane == 63) TMP[16 + wave] = m;
    __syncthreads();
    for (int w = 0; w < wave; ++w) m = fmaxf(m, TMP[16 + w]);
    AP[C.tid] = ap; FL[C.tid] = s; MR[C.tid] = m;
    __syncthreads();
}
DI void mlstm_load_cw(Ctx& C, int mj, int h) {
    LAS float* CW = (LAS float*)(C.lds + ML_CW);
    for (int i = C.tid; i < 2 * 5 * 128; i += 512) { const int which = i / 640, r = (i % 640) / 128, d = i % 128; const int col = which * 512 + h * 128 + d;
        CW[i] = (r < 4) ? C.in[9][((size_t)mj * 4 + r) * 1024 + col] : C.in[10][(size_t)mj * 1024 + col]; }
}
DI void mlstm_conv16(const bf16* proj, size_t tok, int pos, int col0, const LAS float* cwp, float (&o)[16]) {
#pragma unroll
    for (int dd = 0; dd < 16; ++dd) o[dd] = cwp[4 * 128 + dd];
#pragma unroll
    for (int jj = 0; jj < 4; ++jj) {
        if (pos - 3 + jj >= 0) { const u32x4* p = (const u32x4*)(proj + (tok - 3 + jj) * M_NIN + col0); const u32x4 a = p[0], b2 = p[1];
            const unsigned w[8] = {a.x, a.y, a.z, a.w, b2.x, b2.y, b2.z, b2.w};
#pragma unroll
            for (int e = 0; e < 8; ++e) { o[2 * e] += cwp[jj * 128 + 2 * e] * bflo(w[e]); o[2 * e + 1] += cwp[jj * 128 + 2 * e + 1] * bfhi(w[e]); } }
    }
#pragma unroll
    for (int dd = 0; dd < 16; ++dd) o[dd] = o[dd] / (1.0f + __expf(-o[dd]));
}
DI void mlstm_load_vt(Ctx& C, const bf16* proj, size_t tok0, int h, int lane) {
    LAS bf16* VT = (LAS bf16*)(C.lds + ML_VT); const int s = lane, v0 = C.wave * 32;
    const u32x4* p = (const u32x4*)(proj + (tok0 + s) * M_NIN + 1024 + h * 256 + v0);
#pragma unroll
    for (int i = 0; i < 4; ++i) { const u32x4 a = p[i]; const unsigned w[4] = {a.x, a.y, a.z, a.w};
#pragma unroll
        for (int e = 0; e < 4; ++e) { VT[(v0 + i * 8 + 2 * e) * ML_TSTR + s] = (bf16)(w[e] & 0xffffu); VT[(v0 + i * 8 + 2 * e + 1) * ML_TSTR + s] = (bf16)(w[e] >> 16); } }
}
DI void mlstm_state_update(Ctx& C, f32x4 (&acc)[8][2], float decay, int lane) {
    const LAS bf16* VT = (const LAS bf16*)(C.lds + ML_VT); const LAS bf16* KWT = (const LAS bf16*)(C.lds + ML_KWT);
    const int fr = lane & 15, q = lane >> 4, w = C.wave;
#pragma unroll
    for (int dt = 0; dt < 8; ++dt) { acc[dt][0] = acc[dt][0] * decay; acc[dt][1] = acc[dt][1] * decay; }
#pragma unroll
    for (int ks = 0; ks < 2; ++ks) {
        const bf16x8 b0 = *(const LAS bf16x8*)(VT + ((2 * w) * 16 + fr) * ML_TSTR + ks * 32 + 8 * q), b1 = *(const LAS bf16x8*)(VT + ((2 * w + 1) * 16 + fr) * ML_TSTR + ks * 32 + 8 * q);
#pragma unroll
        for (int dt = 0; dt < 8; ++dt) { const bf16x8 a = *(const LAS bf16x8*)(KWT + (dt * 16 + fr) * ML_TSTR + ks * 32 + 8 * q);
            acc[dt][0] = MMA(a, b0, acc[dt][0]); acc[dt][1] = MMA(a, b1, acc[dt][1]); }
    }
}
DI void mlstm_n_update(Ctx& C, float decay, int tid) {
    if (tid < 128) { LAS float* NS = (LAS float*)(C.lds + ML_NS); const LAS bf16* KWT = (const LAS bf16*)(C.lds + ML_KWT); float s = 0.f;
#pragma unroll
        for (int i = 0; i < 8; ++i) { const u32x4 a = *(const LAS u32x4*)(KWT + tid * ML_TSTR + 8 * i); s += (bflo(a.x) + bfhi(a.x)) + (bflo(a.y) + bfhi(a.y)) + (bflo(a.z) + bfhi(a.z)) + (bflo(a.w) + bfhi(a.w)); }
        NS[tid] = decay * NS[tid] + s; }
}

DI void mlstm_m1(Ctx& C, int mj) {
    const bf16* proj = WSP(bf16, WS_PROJ);
    LAS float* AP = (LAS float*)(C.lds + ML_AP); LAS float* FL = (LAS float*)(C.lds + ML_FL); LAS float* MR = (LAS float*)(C.lds + ML_MR); LAS float* NS = (LAS float*)(C.lds + ML_NS);
    LAS float* CW = (LAS float*)(C.lds + ML_CW); LAS bf16* KWT = (LAS bf16*)(C.lds + ML_KWT);
    const int wave = C.wave;
    for (int item = C.vcu; item < 8 * M_NSEG; item += C.G) {
        const int bh = item / M_NSEG, seg = item % M_NSEG, b = bh >> 2, h = bh & 3; const size_t tok_seg = (size_t)b * SEQ + seg * M_SEGT;
        __syncthreads();
        mlstm_load_cw(C, mj, h);
        if (C.tid < 128) NS[C.tid] = 0.f;
        mlstm_seg_scalars(C, mj, bh, seg);
        f32x4 acc[8][2];
#pragma unroll
        for (int dt = 0; dt < 8; ++dt) { acc[dt][0] = (f32x4){0.f, 0.f, 0.f, 0.f}; acc[dt][1] = (f32x4){0.f, 0.f, 0.f, 0.f}; }
        for (int c = 0; c < M_SEGC; ++c) {
            int tz = threadIdx.x; asm volatile("" : "+v"(tz)); const int lane = tz & 63;
            const float mnew = MR[64 * c + 63], mold = (c == 0) ? -1.0e30f : MR[64 * c - 1];
            const float decay = __expf(mold - mnew);
            { const int s = lane; const float wgt = __expf(AP[64 * c + s] - mnew); float o[16];
              mlstm_conv16(proj, tok_seg + 64 * c + s, seg * M_SEGT + 64 * c + s, 512 + h * 128 + wave * 16, CW + 640 + wave * 16, o);
#pragma unroll
              for (int dd = 0; dd < 16; ++dd) KWT[(wave * 16 + dd) * ML_TSTR + s] = (bf16)f2bf(o[dd] * 0.08838834764831845f * wgt); }
            mlstm_load_vt(C, proj, tok_seg + 64 * c, h, lane);
            __syncthreads();
            mlstm_n_update(C, decay, tz);
            mlstm_state_update(C, acc, decay, lane);
            __syncthreads();
        }
        float* dst = WSP(float, WS_SLOC) + (size_t)item * M_STATE;
#pragma unroll
        for (int dt = 0; dt < 8; ++dt)
#pragma unroll
            for (int vtl = 0; vtl < 2; ++vtl)
#pragma unroll
                for (int r = 0; r < 4; ++r) dst[(((wave * 8 + dt) * 2 + vtl) * 4 + r) * 64 + C.lane] = acc[dt][vtl][r];
        if (C.tid < 128) dst[32768 + C.tid] = NS[C.tid];
        if (C.tid == 0) { WSP(float, WS_SEGF)[item] = FL[511]; WSP(float, WS_SEGM)[item] = MR[511]; }
    }
}
DI void mlstm_m15(Ctx& C) {
    LAS float* DEC = (LAS float*)C.lds; LAS float* SCL = DEC + 256;
    __syncthreads();
    if (C.tid < 8) { const int bh = C.tid; float F0 = 0.f, M0 = 0.f;
        for (int seg = 0; seg < M_NSEG; ++seg) { const float cand = WSP(float, WS_SEGM)[bh * M_NSEG + seg] - F0, mn = fmaxf(M0, cand);
            DEC[bh * 32 + seg] = __expf(M0 - mn); SCL[bh * 32 + seg] = __expf(cand - mn); F0 += WSP(float, WS_SEGF)[bh * M_NSEG + seg]; M0 = mn; } }
    __syncthreads();
    const int gt = C.vcu * 512 + C.tid, NGT = C.G * 512;
    for (int i = gt; i < 8 * M_STATE; i += NGT) { const int bh = i / M_STATE, e = i % M_STATE; float s = 0.f;
        const float* src = WSP(float, WS_SLOC) + (size_t)bh * M_NSEG * M_STATE + e; float* dst = WSP(float, WS_SINIT) + (size_t)bh * M_NSEG * M_STATE + e;
        for (int seg = 0; seg < M_NSEG; ++seg) { dst[(size_t)seg * M_STATE] = s; s = s * DEC[bh * 32 + seg] + SCL[bh * 32 + seg] * src[(size_t)seg * M_STATE]; } }
}
DI void mlstm_m2(Ctx& C, int mj) {
    const bf16* proj = WSP(bf16, WS_PROJ);
    LAS bf16* QS = (LAS bf16*)(C.lds + ML_QS); LAS bf16* KS = (LAS bf16*)(C.lds + ML_KS); LAS bf16* VT = (LAS bf16*)(C.lds + ML_VT); LAS bf16* KWT = (LAS bf16*)(C.lds + ML_KWT);
    LAS bf16* WM = (LAS bf16*)(C.lds + ML_WM); LAS bf16* HOUT = (LAS bf16*)(C.lds + ML_QS);
    LAS float* CW = (LAS float*)(C.lds + ML_CW); LAS float* AP = (LAS float*)(C.lds + ML_AP); LAS float* FL = (LAS float*)(C.lds + ML_FL); LAS float* MR = (LAS float*)(C.lds + ML_MR);
    LAS float* AG = (LAS float*)(C.lds + ML_CH); LAS float* MG = AG + 64; LAS float* FAC = AG + 128; LAS float* EMT = AG + 192; LAS float* DEN = AG + 256; LAS float* QN = AG + 320;
    LAS float* NS = (LAS float*)(C.lds + ML_NS); LAS f32x2* STP = (LAS f32x2*)(C.lds + ML_STP); LAS f32x2* MRS = (LAS f32x2*)(C.lds + ML_MRS); LAS float* TMP = (LAS float*)(C.lds + ML_TMP);
    const int wave = C.wave;
    for (int item = C.vcu; item < 8 * M_NSEG; item += C.G) {
        const int bh = item / M_NSEG, seg = item % M_NSEG, b = bh >> 2, h = bh & 3; const size_t tok_seg = (size_t)b * SEQ + seg * M_SEGT;
        __syncthreads();
        mlstm_load_cw(C, mj, h);
        if (C.tid == 0) { float F0 = 0.f, M0 = 0.f;
            for (int sg = 0; sg < seg; ++sg) { M0 = fmaxf(M0, WSP(float, WS_SEGM)[bh * M_NSEG + sg] - F0); F0 += WSP(float, WS_SEGF)[bh * M_NSEG + sg]; }
            TMP[32] = F0; TMP[33] = M0; }
        mlstm_seg_scalars(C, mj, bh, seg);
        const float Fseg0 = TMP[32], Mseg0 = TMP[33];
        f32x4 acc[8][2];
        { const float* src = WSP(float, WS_SINIT) + (size_t)item * M_STATE;
#pragma unroll
          for (int dt = 0; dt < 8; ++dt)
#pragma unroll
              for (int vtl = 0; vtl < 2; ++vtl)
#pragma unroll
                  for (int r = 0; r < 4; ++r) acc[dt][vtl][r] = src[(((wave * 8 + dt) * 2 + vtl) * 4 + r) * 64 + C.lane];
          if (C.tid < 128) NS[C.tid] = src[32768 + C.tid]; }
        for (int c = 0; c < M_SEGC; ++c) {
            int tz = threadIdx.x; asm volatile("" : "+v"(tz)); const int tid = tz, lane = tz & 63, fr = lane & 15, q = lane >> 4;
            const size_t tok0 = tok_seg + 64 * c;
            const float Mc0 = (c == 0) ? Mseg0 : fmaxf(Mseg0, MR[64 * c - 1] - Fseg0);
            const float Mend = fmaxf(Mseg0, MR[64 * c + 63] - Fseg0);
            const float decay = __expf(Mc0 - Mend);
            { const int s = lane; const float ag = AP[64 * c + s] - Fseg0; const float wgt = __expf(ag - Mend); float o[16];
              if (wave == 0) { const float mt = fmaxf(Mseg0, MR[64 * c + s] - Fseg0); AG[s] = ag; MG[s] = mt; FAC[s] = __expf(Mc0 - mt); EMT[s] = __expf(-(Fseg0 + FL[64 * c + s] + mt)); DEN[s] = 0.f; }
              mlstm_conv16(proj, tok0 + s, seg * M_SEGT + 64 * c + s, h * 128 + wave * 16, CW + wave * 16, o);
              { u32x4 w0, w1; w0.x = pk2(o[0], o[1]); w0.y = pk2(o[2], o[3]); w0.z = pk2(o[4], o[5]); w0.w = pk2(o[6], o[7]); w1.x = pk2(o[8], o[9]); w1.y = pk2(o[10], o[11]); w1.z = pk2(o[12], o[13]); w1.w = pk2(o[14], o[15]);
                *(LAS u32x4*)(QS + s * ML_QSTR + wave * 16) = w0; *(LAS u32x4*)(QS + s * ML_QSTR + wave * 16 + 8) = w1; }
              asm volatile("" ::: "memory");
              mlstm_conv16(proj, tok0 + s, seg * M_SEGT + 64 * c + s, 512 + h * 128 + wave * 16, CW + 640 + wave * 16, o);
#pragma unroll
              for (int dd = 0; dd < 16; ++dd) o[dd] *= 0.08838834764831845f;
              { u32x4 w0, w1; w0.x = pk2(o[0], o[1]); w0.y = pk2(o[2], o[3]); w0.z = pk2(o[4], o[5]); w0.w = pk2(o[6], o[7]); w1.x = pk2(o[8], o[9]); w1.y = pk2(o[10], o[11]); w1.z = pk2(o[12], o[13]); w1.w = pk2(o[14], o[15]);
                *(LAS u32x4*)(KS + s * ML_QSTR + wave * 16) = w0; *(LAS u32x4*)(KS + s * ML_QSTR + wave * 16 + 8) = w1; }
#pragma unroll
              for (int dd = 0; dd < 16; ++dd) KWT[(wave * 16 + dd) * ML_TSTR + s] = (bf16)f2bf(o[dd] * wgt); }
            asm volatile("" ::: "memory");
            mlstm_load_vt(C, proj, tok0, h, lane);
            __syncthreads();
            { const int tt = wave >> 1, st0 = (wave & 1) * 2; f32x4 d0 = {0.f, 0.f, 0.f, 0.f}, d1 = {0.f, 0.f, 0.f, 0.f};
#pragma unroll
              for (int ks = 0; ks < 4; ++ks) { const bf16x8 a = *(const LAS bf16x8*)(QS + (tt * 16 + fr) * ML_QSTR + ks * 32 + 8 * q);
                  const bf16x8 b0 = *(const LAS bf16x8*)(KS + (st0 * 16 + fr) * ML_QSTR + ks * 32 + 8 * q), b1 = *(const LAS bf16x8*)(KS + ((st0 + 1) * 16 + fr) * ML_QSTR + ks * 32 + 8 * q);
                  d0 = MMA(a, b0, d0); d1 = MMA(a, b1, d1); }
              const int s0 = st0 * 16 + fr, s1 = s0 + 16; const float a0 = AG[s0], a1 = AG[s1];
#pragma unroll
              for (int r = 0; r < 4; ++r) { const int t = tt * 16 + 4 * q + r; const float mt = MG[t];
                  const float w0 = (s0 <= t) ? __expf(a0 - mt) * d0[r] : 0.f, w1 = (s1 <= t) ? __expf(a1 - mt) * d1[r] : 0.f;
                  WM[t * ML_TSTR + s0] = (bf16)f2bf(w0); WM[t * ML_TSTR + s1] = (bf16)f2bf(w1);
                  float ps = w0 + w1; ps += __shfl_xor(ps, 1); ps += __shfl_xor(ps, 2); ps += __shfl_xor(ps, 4); ps += __shfl_xor(ps, 8);
                  if (fr == 0) __hip_atomic_fetch_add(DEN + t, ps, __ATOMIC_RELAXED, __HIP_MEMORY_SCOPE_WORKGROUP); } }
            { const int t = tid >> 3, part = tid & 7; float s = 0.f;
              const u32x4 a = *(const LAS u32x4*)(QS + t * ML_QSTR + part * 16), b2 = *(const LAS u32x4*)(QS + t * ML_QSTR + part * 16 + 8); const LAS float* np = NS + part * 16;
              s += bflo(a.x) * np[0] + bfhi(a.x) * np[1] + bflo(a.y) * np[2] + bfhi(a.y) * np[3] + bflo(a.z) * np[4] + bfhi(a.z) * np[5] + bflo(a.w) * np[6] + bfhi(a.w) * np[7];
              s += bflo(b2.x) * np[8] + bfhi(b2.x) * np[9] + bflo(b2.y) * np[10] + bfhi(b2.y) * np[11] + bflo(b2.z) * np[12] + bfhi(b2.z) * np[13] + bflo(b2.w) * np[14] + bfhi(b2.w) * np[15];
              s += __shfl_xor(s, 1); s += __shfl_xor(s, 2); s += __shfl_xor(s, 4);
              if (part == 0) QN[t] = s; }
            __syncthreads();
            f32x4 num[4][2];
#pragma unroll
            for (int tt = 0; tt < 4; ++tt) { num[tt][0] = (f32x4){0.f, 0.f, 0.f, 0.f}; num[tt][1] = (f32x4){0.f, 0.f, 0.f, 0.f}; }
#pragma unroll
            for (int ks = 0; ks < 4; ++ks) {
                u32x4 p0, p1;
                p0.x = pk2(acc[2 * ks][0][0], acc[2 * ks][0][1]); p0.y = pk2(acc[2 * ks][0][2], acc[2 * ks][0][3]); p0.z = pk2(acc[2 * ks + 1][0][0], acc[2 * ks + 1][0][1]); p0.w = pk2(acc[2 * ks + 1][0][2], acc[2 * ks + 1][0][3]);
                p1.x = pk2(acc[2 * ks][1][0], acc[2 * ks][1][1]); p1.y = pk2(acc[2 * ks][1][2], acc[2 * ks][1][3]); p1.z = pk2(acc[2 * ks + 1][1][0], acc[2 * ks + 1][1][1]); p1.w = pk2(acc[2 * ks + 1][1][2], acc[2 * ks + 1][1][3]);
                const bf16x8 b0 = __builtin_bit_cast(bf16x8, p0), b1 = __builtin_bit_cast(bf16x8, p1);
#pragma unroll
                for (int tt = 0; tt < 4; ++tt) { const LAS bf16* qp = QS + (tt * 16 + fr) * ML_QSTR + 4 * q;
                    const u32x2 lo = *(const LAS u32x2*)(qp + (2 * ks) * 16), hi = *(const LAS u32x2*)(qp + (2 * ks + 1) * 16);
                    u32x4 av; av.x = lo.x; av.y = lo.y; av.z = hi.x; av.w = hi.y; const bf16x8 a = __builtin_bit_cast(bf16x8, av);
                    num[tt][0] = MMA(a, b0, num[tt][0]); num[tt][1] = MMA(a, b1, num[tt][1]); }
            }
#pragma unroll
            for (int tt = 0; tt < 4; ++tt)
#pragma unroll
                for (int r = 0; r < 4; ++r) { const float f = FAC[tt * 16 + 4 * q + r]; num[tt][0][r] *= f; num[tt][1][r] *= f; }
#pragma unroll
            for (int ks = 0; ks < 2; ++ks) {
                const bf16x8 b0 = *(const LAS bf16x8*)(VT + ((2 * wave) * 16 + fr) * ML_TSTR + ks * 32 + 8 * q), b1 = *(const LAS bf16x8*)(VT + ((2 * wave + 1) * 16 + fr) * ML_TSTR + ks * 32 + 8 * q);
#pragma unroll
                for (int tt = 0; tt < 4; ++tt) { const bf16x8 a = *(const LAS bf16x8*)(WM + (tt * 16 + fr) * ML_TSTR + ks * 32 + 8 * q);
                    num[tt][0] = MMA(a, b0, num[tt][0]); num[tt][1] = MMA(a, b1, num[tt][1]); }
            }
#pragma unroll
            for (int tt = 0; tt < 4; ++tt)
#pragma unroll
                for (int r = 0; r < 4; ++r) { const int t = tt * 16 + 4 * q + r; const float den = DEN[t] + FAC[t] * QN[t]; const float inv = 1.0f / fmaxf(fabsf(den), EMT[t]);
                    const float h0 = num[tt][0][r] * inv, h1 = num[tt][1][r] * inv; num[tt][0][r] = h0; num[tt][1][r] = h1;
                    float s1 = h0 + h1, s2 = h0 * h0 + h1 * h1;
                    s1 += __shfl_xor(s1, 1); s2 += __shfl_xor(s2, 1); s1 += __shfl_xor(s1, 2); s2 += __shfl_xor(s2, 2); s1 += __shfl_xor(s1, 4); s2 += __shfl_xor(s2, 4); s1 += __shfl_xor(s1, 8); s2 += __shfl_xor(s2, 8);
                    if (fr == 0) STP[t * 8 + wave] = (f32x2){s1, s2}; }
            mlstm_n_update(C, decay, tid);
            mlstm_state_update(C, acc, decay, lane);
            __syncthreads();
            if (tid < 64) { float s1 = 0.f, s2 = 0.f;
#pragma unroll
                for (int w = 0; w < 8; ++w) { const f32x2 p = STP[tid * 8 + w]; s1 += p.x; s2 += p.y; }
                const float mean = s1 * (1.0f / 256.0f), var = fmaxf(s2 * (1.0f / 256.0f) - mean * mean, 0.f); MRS[tid] = (f32x2){mean, 1.0f / sqrtf(var + LN_EPS)}; }
            __syncthreads();
#pragma unroll
            for (int tt = 0; tt < 4; ++tt)
#pragma unroll
                for (int r = 0; r < 4; ++r) { const int t = tt * 16 + 4 * q + r; const f32x2 mr = MRS[t];
                    HOUT[t * ML_HSTR + (2 * wave) * 16 + fr] = (bf16)f2bf((num[tt][0][r] - mr.x) * mr.y); HOUT[t * ML_HSTR + (2 * wave + 1) * 16 + fr] = (bf16)f2bf((num[tt][1][r] - mr.x) * mr.y); }
            __syncthreads();
            { const int t = tid >> 3, c8 = tid & 7; const float* ng = C.in[12] + (size_t)mj * 1024 + h * 256;
#pragma unroll
              for (int jj = 0; jj < 4; ++jj) { const int col = (c8 + 8 * jj) * 8;
                  const u32x4 hv = *(const LAS u32x4*)(HOUT + t * ML_HSTR + col); const u32x4 ov = *(const u32x4*)(proj + (tok0 + t) * M_NIN + 2048 + h * 256 + col);
                  const f32x4 g0 = *(const f32x4*)(ng + col), g1 = *(const f32x4*)(ng + col + 4);
                  u32x4 w;
                  w.x = pk2(bflo(hv.x) * g0.x * sigmoidf_(bflo(ov.x)), bfhi(hv.x) * g0.y * sigmoidf_(bfhi(ov.x))); w.y = pk2(bflo(hv.y) * g0.z * sigmoidf_(bflo(ov.y)), bfhi(hv.y) * g0.w * sigmoidf_(bfhi(ov.y)));
                  w.z = pk2(bflo(hv.z) * g1.x * sigmoidf_(bflo(ov.z)), bfhi(hv.z) * g1.y * sigmoidf_(bfhi(ov.z))); w.w = pk2(bflo(hv.w) * g1.z * sigmoidf_(bflo(ov.w)), bfhi(hv.w) * g1.w * sigmoidf_(bfhi(ov.w)));
                  *(u32x4*)(WSP(bf16, WS_MIXA) + (tok0 + t) * D + h * 256 + col) = w; } }
            __syncthreads();
        }
    }
}

constexpr int S5_BUSTR = 132, S5_XSTR = 136, S5_WAVE_LDS = 16 * S5_BUSTR * 4 + 16 * S5_XSTR * 2;
static_assert(8 * S5_WAVE_LDS <= RING_BYTES, "s5 LDS");
DI float gelu_tanh(float x) { const float z = 0.7978845608028654f * (x + 0.044715f * x * x * x); return x * (1.0f - 1.0f / (1.0f + __expf(2.0f * z))); }

template <int PASS> DI void s5_pass(Ctx& C) {
    const int lane = C.lane, wave = C.wave, fr = lane & 15, q = lane >> 4;
    LAS float* BU = (LAS float*)(C.lds + wave * S5_WAVE_LDS); LAS bf16* XS = (LAS bf16*)(C.lds + wave * S5_WAVE_LDS + 16 * S5_BUSTR * 4);
    const bf16* U = WSP(bf16, WS_PROJ);
    for (int wi = C.vcu; wi < 2 * S5_NSEG * 8; wi += C.G) {
        const int g = (wi & 7) * 8 + wave, bs = wi >> 3, b = bs / S5_NSEG, seg = bs % S5_NSEG; const size_t tokbase = (size_t)b * SEQ + seg * S5_SEGT;
        const float ar = WSP(float, WS_S5ABAR)[(g * 64 + lane) * 2], ai = WSP(float, WS_S5ABAR)[(g * 64 + lane) * 2 + 1];
        bf16x8 bB[8];
#pragma unroll
        for (int nt = 0; nt < 8; ++nt) { bB[nt] = (bf16x8){0, 0, 0, 0, 0, 0, 0, 0}; if (q < 2) bB[nt] = *(const bf16x8*)(WSP(bf16, WS_S5BBT) + ((size_t)g * 128 + nt * 16 + fr) * 16 + 8 * q); }
        bf16x8 cB[4]; float xr = 0.f, xi = 0.f, dsk = 0.f;
        if constexpr (PASS == 2) {
#pragma unroll
            for (int ks = 0; ks < 4; ++ks) cB[ks] = *(const bf16x8*)(WSP(bf16, WS_S5CMT) + ((size_t)g * 16 + fr) * 128 + ks * 32 + 8 * q);
            dsk = C.in[22][g * 16 + fr];
            if (seg > 0) { const float dt = expf(C.in[17][g]), lr = C.in[15][g * 64 + lane], li = C.in[16][g * 64 + lane];
                const float mg = expf(lr * dt * (float)S5_SEGT); float sn, cs; sincosf(li * dt * (float)S5_SEGT, &sn, &cs); const float pr = mg * cs, pi = mg * sn;
                const float* en = WSP(float, WS_S5END) + (((size_t)b * 64 + g) * S5_NSEG) * 128 + lane * 2;
                for (int sp = 0; sp < seg; ++sp) { const float er = en[sp * 128], ei = en[sp * 128 + 1]; const float nr = pr * xr - pi * xi + er, ni = pr * xi + pi * xr + ei; xr = nr; xi = ni; } }
        }
        for (int sub = 0; sub < S5_SEGT / 16; ++sub) {
            const size_t tok0 = tokbase + sub * 16;
            bf16x8 a = (bf16x8){0, 0, 0, 0, 0, 0, 0, 0};
            if (q < 2) a = *(const bf16x8*)(U + (tok0 + fr) * D + g * 16 + 8 * q);
#pragma unroll
            for (int nt = 0; nt < 8; ++nt) { const f32x4 d = MMA(a, bB[nt], (f32x4){0.f, 0.f, 0.f, 0.f});
#pragma unroll
                for (int r = 0; r < 4; ++r) BU[(4 * q + r) * S5_BUSTR + nt * 16 + fr] = d[r]; }
            asm volatile("s_waitcnt lgkmcnt(0)" ::: "memory");
#pragma unroll
            for (int t = 0; t < 16; ++t) { const float br = BU[t * S5_BUSTR + lane], bi = BU[t * S5_BUSTR + 64 + lane];
                const float nr = ar * xr - ai * xi + br, ni = ar * xi + ai * xr + bi; xr = nr; xi = ni;
                if constexpr (PASS == 2) { XS[t * S5_XSTR + lane] = (bf16)f2bf(xr); XS[t * S5_XSTR + 64 + lane] = (bf16)f2bf(xi); } }
            if constexpr (PASS == 2) {
                asm volatile("s_waitcnt lgkmcnt(0)" ::: "memory");
                f32x4 y = {0.f, 0.f, 0.f, 0.f};
#pragma unroll
                for (int ks = 0; ks < 4; ++ks) { const bf16x8 xa = *(const LAS bf16x8*)(XS + fr * S5_XSTR + ks * 32 + 8 * q); y = MMA(xa, cB[ks], y); }
#pragma unroll
                for (int r = 0; r < 4; ++r) { const size_t o = (tok0 + 4 * q + r) * D + g * 16 + fr; const float uv = bf2f(U[o]);
                    WSP(bf16, WS_MIXA)[o] = (bf16)f2bf(gelu_tanh(y[r] + dsk * uv)); }
            }
            asm volatile("s_waitcnt lgkmcnt(0)" ::: "memory");
        }
        if constexpr (PASS == 1) { float* en = WSP(float, WS_S5END) + ((((size_t)b * 64 + g) * S5_NSEG) + seg) * 128 + lane * 2; en[0] = xr; en[1] = xi; }
    }
}

constexpr int AT_KSTR = 72, AT_VSTR = 200, AT_KS = 0, AT_VT = 192 * AT_KSTR * 2, AT_END = AT_VT + 64 * AT_VSTR * 2;
static_assert(AT_END <= RING_BYTES, "attn LDS");
DI void swa_phase(Ctx& C) {
    const bf16* QKV = WSP(bf16, WS_PROJ);
    LAS bf16* KS = (LAS bf16*)(C.lds + AT_KS); LAS bf16* VT = (LAS bf16*)(C.lds + AT_VT);
    const int lane = C.lane, wave = C.wave, tid = C.tid, fr = lane & 15, q = lane >> 4;
    for (int item = C.vcu; item < BATCH * A_KV * (SEQ / 64); item += C.G) {
        const int qb = item % (SEQ / 64), kvh = (item / (SEQ / 64)) % A_KV, b = item / ((SEQ / 64) * A_KV); const int q0 = qb * 64; const size_t tokb = (size_t)b * SEQ;
        __syncthreads();
#pragma unroll
        for (int i = 0; i < 3; ++i) { const int kk = (tid >> 3) + 64 * i, ch = tid & 7, kp = q0 - 128 + kk; u32x4 v = {0u, 0u, 0u, 0u};
            if (kp >= 0) v = *(const u32x4*)(QKV + (tokb + kp) * A_NQKV + 1024 + kvh * 64 + ch * 8);
            *(LAS u32x4*)(KS + kk * AT_KSTR + ch * 8) = v; }
#pragma unroll
        for (int i = 0; i < 3; ++i) { const int kk = lane + 64 * i, kp = q0 - 128 + kk; u32x4 v = {0u, 0u, 0u, 0u};
            if (kp >= 0) v = *(const u32x4*)(QKV + (tokb + kp) * A_NQKV + 1280 + kvh * 64 + wave * 8);
            const unsigned w[4] = {v.x, v.y, v.z, v.w};
#pragma unroll
            for (int e = 0; e < 4; ++e) { VT[(wave * 8 + 2 * e) * AT_VSTR + kk] = (bf16)(w[e] & 0xffffu); VT[(wave * 8 + 2 * e + 1) * AT_VSTR + kk] = (bf16)(w[e] >> 16); } }
        __syncthreads();
        const int g = wave >> 1, head = kvh * 4 + g; const float sink = C.in[26][head];
#pragma unroll 1
        for (int rt = 0; rt < 2; ++rt) {
            const int r0 = (wave & 1) * 32 + rt * 16, kt0 = r0 >> 4; const size_t tq = tokb + q0 + r0 + fr;
            const bf16x8 qf0 = *(const bf16x8*)(QKV + tq * A_NQKV + head * 64 + 8 * q), qf1 = *(const bf16x8*)(QKV + tq * A_NQKV + head * 64 + 32 + 8 * q);
            f32x4 s[9];
#pragma unroll
            for (int kt = 0; kt < 9; ++kt) { const LAS bf16* kp_ = KS + ((kt0 + kt) * 16 + fr) * AT_KSTR + 8 * q;
                s[kt] = MMA(*(const LAS bf16x8*)kp_, qf0, (f32x4){0.f, 0.f, 0.f, 0.f}); s[kt] = MMA(*(const LAS bf16x8*)(kp_ + 32), qf1, s[kt]); }
            float m = sink;
#pragma unroll
            for (int kt = 0; kt < 9; ++kt)
#pragma unroll
                for (int r = 0; r < 4; ++r) { const int kk = (kt0 + kt) * 16 + 4 * q + r; const bool ok = (kk > r0 + fr) && (kk <= r0 + fr + 128) && (q0 - 128 + kk >= 0);
                    s[kt][r] = ok ? s[kt][r] * 0.125f : -3.0e38f; m = fmaxf(m, s[kt][r]); }
            m = fmaxf(m, __shfl_xor(m, 16)); m = fmaxf(m, __shfl_xor(m, 32));
            float l = 0.f;
#pragma unroll
            for (int kt = 0; kt < 9; ++kt)
#pragma unroll
                for (int r = 0; r < 4; ++r) { const float p = __expf(s[kt][r] - m); s[kt][r] = p; l += p; }
            l += __shfl_xor(l, 16); l += __shfl_xor(l, 32);
            const float inv = 1.0f / (l + __expf(sink - m));
            f32x4 o[4];
#pragma unroll
            for (int dt = 0; dt < 4; ++dt) o[dt] = (f32x4){0.f, 0.f, 0.f, 0.f};
#pragma unroll
            for (int pr = 0; pr < 5; ++pr) { const int ka = 2 * pr, kb = 2 * pr + 1;
                u32x4 pw; pw.x = pk2(s[ka][0] * inv, s[ka][1] * inv); pw.y = pk2(s[ka][2] * inv, s[ka][3] * inv);
                if (kb < 9) { pw.z = pk2(s[kb < 9 ? kb : 8][0] * inv, s[kb < 9 ? kb : 8][1] * inv); pw.w = pk2(s[kb < 9 ? kb : 8][2] * inv, s[kb < 9 ? kb : 8][3] * inv); } else { pw.z = 0u; pw.w = 0u; }
                const bf16x8 pb = __builtin_bit_cast(bf16x8, pw);
#pragma unroll
                for (int dt = 0; dt < 4; ++dt) { const LAS bf16* vp = VT + (dt * 16 + fr) * AT_VSTR + 4 * q;
                    const u32x2 lo = *(const LAS u32x2*)(vp + (kt0 + ka) * 16); u32x2 hi = {0u, 0u}; if (kb < 9) hi = *(const LAS u32x2*)(vp + (kt0 + (kb < 9 ? kb : 8)) * 16);
                    u32x4 av; av.x = lo.x; av.y = lo.y; av.z = hi.x; av.w = hi.y;
                    o[dt] = MMA(__builtin_bit_cast(bf16x8, av), pb, o[dt]); } }
            bf16* orow = WSP(bf16, WS_MIXA) + tq * D + head * 64 + 4 * q;
#pragma unroll
            for (int dt = 0; dt < 4; ++dt) { u32x2 w; w.x = pk2(o[dt][0], o[dt][1]); w.y = pk2(o[dt][2], o[dt][3]); *(u32x2*)(orow + dt * 16) = w; }
        }
    }
}

template <class Epi> DI void dense_gemm(Ctx& C, const bf16* A, const bf16* Bt, int N, int K, const Epi& E) {
    pg8::Gemm g{A, Bt, T, N, K}; pg8::StaticOrder S; S.init(T, N, C.G, (int)blockIdx.x);
    pg8::gemm_phase<Epi, pg8::StaticOrder, true, true>(C.lds, g, S, E);
}
DI void moe_gemm1(Ctx& C, int layer) {
    const int nunits = moe_tables(C, layer);
    pg8::Gemm g{WSP(bf16, WS_BUFX), WSP(bf16, WS_W13) + (size_t)layer * N_EXP * D * D, MOE_P, D, D};
    pg8::MoeOrder S{(const LAS int*)(C.lds + MISC_OFF), C.G, (int)blockIdx.x, nunits};
    pg8::EpiPair<0> E{WSP(bf16, WS_HID), D_EXP, 3};
    pg8::gemm_phase<pg8::EpiPair<0>, pg8::MoeOrder, true, true>(C.lds, g, S, E);
}
DI void moe_gemm2(Ctx& C, int layer) {
    const int nunits = moe_tables(C, layer);
    pg8::Gemm g{WSP(bf16, WS_HID), WSP(bf16, WS_W2) + (size_t)layer * N_EXP * D * D_EXP, MOE_P, D, D_EXP};
    pg8::MoeOrder S{(const LAS int*)(C.lds + MISC_OFF), C.G, (int)blockIdx.x, nunits};
    pg8::EpiStore E{WSP(bf16, WS_YEXP), D, nullptr, 3};
    pg8::gemm_phase<pg8::EpiStore, pg8::MoeOrder, true, true>(C.lds, g, S, E);
}

constexpr int N_PHASES = 39;
struct Args { const float* in[35]; float* out; unsigned char* ws; int ph_lo, ph_hi, li, pad; };
__global__ void __launch_bounds__(512, 2) fwd(Args args) {
    extern __shared__ __attribute__((aligned(16))) unsigned char lds_raw[];
    Ctx C;
    C.lds = (LAS unsigned char*)lds_raw; C.ws = args.ws; C.ctl = (unsigned*)(args.ws + WS_CTL); C.out = args.out;
#pragma unroll
    for (int i = 0; i < 35; ++i) C.in[i] = args.in[i];
    C.tid = threadIdx.x; C.lane = C.tid & 63; C.wave = __builtin_amdgcn_readfirstlane(C.tid >> 6);
    C.G = gridDim.x; { const int bx = blockIdx.x; C.vcu = (C.G % 8 == 0) ? (bx % 8) * (C.G / 8) + bx / 8 : bx; }
    volatile LAS unsigned* xbw = (volatile LAS unsigned*)(C.lds + MISC_OFF + 512);
    if (C.tid < 4) xbw[C.tid] = 0u;
    __syncthreads();
    const int lo = args.ph_lo, hi = args.ph_hi;
    XcdBarrier bar; bar.bar = C.ctl + CW_BAR + args.li * XCD_BAR_WORDS; bar.x = 0; bar.st = xbw;
    if (hi - lo > 1) bar = xcd_barrier_post(C.ctl + CW_BAR + args.li * XCD_BAR_WORDS, xbw);
#ifdef PH_ONLY
#define IN(k) ((k) == PH_ONLY && lo <= (k) && (k) < hi)
#else
#define IN(k) (lo <= (k) && (k) < hi)
#endif
#define SEAM(k) do { if (IN(k) && IN((k) + 1)) xcd_barrier(bar); else __syncthreads(); } while (0)
    bf16* HIN = WSP(bf16, WS_HIN); bf16* PROJ = WSP(bf16, WS_PROJ); bf16* MIXA = WSP(bf16, WS_MIXA); bf16* YMIX = WSP(bf16, WS_YMIX);

    if (IN(0)) { p0a_weights(C); } SEAM(0);
    if (IN(1)) { row_phase<0, 1, true>(C, C.in[0], 0, 0, nullptr, nullptr, 0, 1, 0, 0); } SEAM(1);

    if (IN(2)) { pg8::EpiStore E{PROJ, M_NIN, nullptr, -1}; dense_gemm(C, HIN, WSP(bf16, WS_WMIN), M_NIN, D, E); } SEAM(2);
    if (IN(3)) { mlstm_m1(C, 0); } SEAM(3);
    if (IN(4)) { mlstm_m15(C); } SEAM(4);
    if (IN(5)) { mlstm_m2(C, 0); } SEAM(5);
    if (IN(6)) { pg8::EpiStore E{YMIX, D, nullptr, -1}; dense_gemm(C, MIXA, WSP(bf16, WS_WMOUT), D, D, E); } SEAM(6);
    if (IN(7)) { row_phase<1, 3, true>(C, C.in[0], 0, 2, C.in[4], C.in[5], 0, 4, 3, 0); } SEAM(7);
    if (IN(8)) { moe_scatter(C, 0); } SEAM(8);
    if (IN(9)) { moe_gemm1(C, 0); } SEAM(9);
    if (IN(10)) { moe_gemm2(C, 0); } SEAM(10);
    if (IN(11)) { row_phase<2, 0, true>(C, C.out, 0, 5, C.in[6], C.in[7], 1, 1, 0, 0); } SEAM(11);

    if (IN(12)) { pg8::EpiStore E{PROJ, D, nullptr, -1}; dense_gemm(C, HIN, WSP(bf16, WS_WS5IN), D, D, E); } SEAM(12);
    if (IN(13)) { s5_pass<1>(C); } SEAM(13);
    if (IN(14)) { s5_pass<2>(C); } SEAM(14);
    if (IN(15)) { pg8::EpiPair<1> E{YMIX, D, -1}; dense_gemm(C, MIXA, WSP(bf16, WS_WS5GLU), 2 * D, D, E); } SEAM(15);
    if (IN(16)) { row_phase<1, 3, true>(C, C.out, 1, 2, C.in[4] + D, C.in[5] + D, 1, 4, 3, 0); } SEAM(16);
    if (IN(17)) { moe_scatter(C, 1); } SEAM(17);
    if (IN(18)) { moe_gemm1(C, 1); } SEAM(18);
    if (IN(19)) { moe_gemm2(C, 1); } SEAM(19);
    if (IN(20)) { row_phase<2, 0, true>(C, C.out, 1, 5, C.in[6] + D, C.in[7] + D, 2, 1, 0, 0); } SEAM(20);

    if (IN(21)) { pg8::EpiStore E{PROJ, A_NQKV, C.in[25], -1}; dense_gemm(C, HIN, WSP(bf16, WS_WQKV), A_NQKV, D, E); } SEAM(21);
    if (IN(22)) { swa_phase(C); } SEAM(22);
    if (IN(23)) { pg8::EpiStore E{YMIX, D, nullptr, -1}; dense_gemm(C, MIXA, WSP(bf16, WS_WWO), D, D, E); } SEAM(23);
    if (IN(24)) { row_phase<1, 3, true>(C, C.out, 2, 2, C.in[4] + 2 * D, C.in[5] + 2 * D, 2, 4, 3, 0); } SEAM(24);
    if (IN(25)) { moe_scatter(C, 2); } SEAM(25);
    if (IN(26)) { moe_gemm1(C, 2); } SEAM(26);
    if (IN(27)) { moe_gemm2(C, 2); } SEAM(27);
    if (IN(28)) { row_phase<2, 1, true>(C, C.out, 2, 5, C.in[6] + 2 * D, C.in[7] + 2 * D, 3, 1, 0, 1); } SEAM(28);

    if (IN(29)) { pg8::EpiStore E{PROJ, M_NIN, nullptr, -1}; dense_gemm(C, HIN, WSP(bf16, WS_WMIN) + (size_t)M_NIN * D, M_NIN, D, E); } SEAM(29);
    if (IN(30)) { mlstm_m1(C, 1); } SEAM(30);
    if (IN(31)) { mlstm_m15(C); } SEAM(31);
    if (IN(32)) { mlstm_m2(C, 1); } SEAM(32);
    if (IN(33)) { pg8::EpiStore E{YMIX, D, nullptr, -1}; dense_gemm(C, MIXA, WSP(bf16, WS_WMOUT) + (size_t)D * D, D, D, E); } SEAM(33);
    if (IN(34)) { row_phase<1, 3, true>(C, C.out, 3, 2, C.in[4] + 3 * D, C.in[5] + 3 * D, 3, 4, 3, 0); } SEAM(34);
    if (IN(35)) { moe_scatter(C, 3); } SEAM(35);
    if (IN(36)) { moe_gemm1(C, 3); } SEAM(36);
    if (IN(37)) { moe_gemm2(C, 3); } SEAM(37);
    if (IN(38)) { row_phase<2, 0, false>(C, C.out, 3, 5, C.in[6] + 3 * D, C.in[7] + 3 * D, 0, 0, 0, 0); }
#undef IN
#undef SEAM
}

#ifndef MK_LAUNCH_PER_PHASE
#define MK_LAUNCH_PER_PHASE 1
#endif
extern "C" void kernel_launch(void* const* d_in, const int* in_sizes, int n_in, void* d_out, int out_size, void* d_ws, size_t ws_size, hipStream_t stream) {
    static int grid = 0;
    if (grid == 0) {
        if (n_in != 35 || out_size != T * D || ws_size < WS_END) { fprintf(stderr, "kernel_launch: unexpected shapes (n_in %d, out %d, ws %zu < %zu)\n", n_in, out_size, ws_size, (size_t)WS_END); grid = -1; return; }
        int dev = 0, cus = 0, per_cu = 0;
        if (hipGetDevice(&dev) != hipSuccess || hipDeviceGetAttribute(&cus, hipDeviceAttributeMultiprocessorCount, dev) != hipSuccess) { grid = -1; return; }
        if (hipFuncSetAttribute((const void*)fwd, hipFuncAttributeMaxDynamicSharedMemorySize, LDS_BYTES) != hipSuccess) { fprintf(stderr, "kernel_launch: hipFuncSetAttribute failed\n"); grid = -1; return; }
        if (hipOccupancyMaxActiveBlocksPerMultiprocessor(&per_cu, (const void*)fwd, 512, LDS_BYTES) != hipSuccess || per_cu < 1) fprintf(stderr, "kernel_launch: occupancy query says %d\n", per_cu);
        (void)hipGetLastError();
        grid = cus;
    }
    if (grid < 0) return;
    (void)hipMemsetAsync((char*)d_ws + WS_CTL, 0, CTL_ZERO_BYTES, stream);
    Args a{};
    for (int i = 0; i < 35; ++i) a.in[i] = (const float*)d_in[i];
    a.out = (float*)d_out; a.ws = (unsigned char*)d_ws;
#if MK_LAUNCH_PER_PHASE
    for (int p = 0; p < N_PHASES; ++p) { a.ph_lo = p; a.ph_hi = p + 1; a.li = 0; hipLaunchKernelGGL(fwd, dim3(grid), dim3(512), LDS_BYTES, stream, a); }
#else
    a.ph_lo = 0; a.ph_hi = N_PHASES; a.li = 0;
    hipLaunchKernelGGL(fwd, dim3(grid), dim3(512), LDS_BYTES, stream, a);
#endif
}
```

```cpp
#include <hip/hip_runtime.h>
#include <cstdio>
#include <cstdint>

#define DI __device__ __forceinline__
#define GAS __attribute__((address_space(1)))
#define LAS __attribute__((address_space(3)))
typedef unsigned short bf16;
typedef short bf16x8 __attribute__((ext_vector_type(8)));
typedef short s16x4 __attribute__((ext_vector_type(4)));
typedef float f32x4 __attribute__((ext_vector_type(4)));
typedef float f32x2 __attribute__((ext_vector_type(2)));
typedef unsigned u32x4 __attribute__((ext_vector_type(4)));
typedef unsigned u32x2 __attribute__((ext_vector_type(2)));

constexpr int BATCH = 2, SEQ = 16384, D = 1024, T = BATCH * SEQ, DEPTH = 4;
constexpr float DN_ALPHA = 1.681792830507429f;
constexpr float LN_EPS = 1e-5f;
constexpr int M_HEADS = 4, M_DQK = 128, M_DV = 256, M_CHUNK = 64, M_NIN = 3072  , M_IN = 3080;
constexpr int M_NSEG = 32, M_SEGT = SEQ / M_NSEG  , M_SEGC = M_SEGT / M_CHUNK  ;
constexpr int M_STATE = M_DQK * M_DV + M_DQK;
constexpr int S5_G = 64, S5_P = 64, S5_NSEG = 16, S5_SEGT = SEQ / S5_NSEG  ;
constexpr int A_HEADS = 16, A_KV = 4, A_GRP = 4, A_HD = 64, A_NQKV = 1536, A_WIN = 128;
constexpr int E_GROUPS = 4, E_PER = 8, N_EXP = 32, D_EXP = 512;
constexpr int MOE_P = 2 * T + N_EXP * 256;

constexpr size_t MiB = 1u << 20;
constexpr size_t WS_CTL = 0, CTL_ZERO_BYTES = 1 * MiB;
constexpr size_t WS_MOD = 1 * MiB;
constexpr size_t WS_S5ABAR = 2 * MiB;
constexpr size_t WS_S5BBT = WS_S5ABAR + 64 * 1024;
constexpr size_t WS_S5CMT = WS_S5BBT + 256 * 1024;
constexpr size_t WS_RWH = 3 * MiB;
constexpr size_t WS_RWL = WS_RWH + 512 * 1024;
constexpr size_t WS_GWH = 4 * MiB;
constexpr size_t WS_GWL = WS_GWH + 64 * 1024;
constexpr size_t WS_RB = WS_GWL + 64 * 1024;
constexpr size_t WS_SEGF = WS_RB + 4096;
constexpr size_t WS_SEGM = WS_SEGF + 4096;
constexpr size_t WS_S5END = 5 * MiB;
constexpr size_t WS_TOKES = 6 * MiB;
constexpr size_t WS_TOKW = WS_TOKES + 256 * 1024;
constexpr size_t WS_TOKPOS = WS_TOKW + 256 * 1024;
constexpr size_t WS_GATES = 7 * MiB;
constexpr size_t WS_WMIN = 8 * MiB;
constexpr size_t WS_WMOUT = 20 * MiB;
constexpr size_t WS_WS5IN = 24 * MiB;
constexpr size_t WS_WS5GLU = 26 * MiB;
constexpr size_t WS_WQKV = 30 * MiB;
constexpr size_t WS_WWO = 33 * MiB;
constexpr size_t WS_W13 = 36 * MiB;
constexpr size_t WS_W2 = WS_W13 + 256 * MiB;
constexpr size_t WS_SLOC = WS_W2 + 128 * MiB;
constexpr size_t WS_SINIT = WS_SLOC + 34 * MiB;
constexpr size_t WS_HIN = WS_SINIT + 34 * MiB;
constexpr size_t WS_R1 = WS_HIN + 64 * MiB;
constexpr size_t WS_PROJ = WS_R1, WS_MIXA = WS_R1 + 192 * MiB;
constexpr size_t WS_BUFX = WS_R1, WS_HID = WS_R1 + 144 * MiB;
constexpr size_t WS_R2 = WS_R1 + 256 * MiB;
constexpr size_t WS_YEXP = WS_R2, WS_YMIX = WS_R2;
constexpr size_t WS_END = WS_R2 + 144 * MiB;
constexpr int CW_BAR = 4096;
constexpr int CW_GCNT = 16384;

constexpr int RING_BYTES = 131072;
constexpr int MISC_OFF = RING_BYTES;
constexpr int LDS_BYTES = 147456;

DI unsigned f2bf(float f) { unsigned u = __builtin_bit_cast(unsigned, f); return (u + 0x7fffu + ((u >> 16) & 1u)) >> 16; }
DI unsigned pk2(float lo, float hi) { return f2bf(lo) | (f2bf(hi) << 16); }
DI float bf2f(unsigned b) { return __builtin_bit_cast(float, b << 16); }
DI float bflo(unsigned w) { return __builtin_bit_cast(float, w << 16); }
DI float bfhi(unsigned w) { return __builtin_bit_cast(float, w & 0xffff0000u); }
DI f32x4 MMA(bf16x8 a, bf16x8 b, f32x4 c) { return __builtin_amdgcn_mfma_f32_16x16x32_bf16(a, b, c, 0, 0, 0); }
DI float wave_sum(float v) {
#pragma unroll
    for (int o = 1; o < 64; o <<= 1) v += __shfl_xor(v, o);
    return v;
}
DI float sigmoidf_(float x) { return 1.0f / (1.0f + __expf(-x)); }
#define LDS_WAIT() asm volatile("s_waitcnt lgkmcnt(0)" ::: "memory")
#define VM_WAIT() asm volatile("s_waitcnt vmcnt(0)" ::: "memory")

namespace pg8 {
#define PG8_LAS __attribute__((address_space(3)))
typedef unsigned short bf16_t;
typedef short bf16x8 __attribute__((ext_vector_type(8)));
typedef float f32x4 __attribute__((ext_vector_type(4)));
typedef unsigned u32x4 __attribute__((ext_vector_type(4)));
constexpr int BM = 256, BK = 64, HALF = 128, HTB = HALF * BK * 2  , STAGE_BYTES = 8 * HTB, NXCD = 8, WGM = 8;

__host__ __device__ __forceinline__ int lds_byte(int r, int c) { const int st = (r >> 4) * 2 + (c >> 5), rr = r & 15, cc = c & 31, ob = rr * 64 + cc * 2; return st * 1024 + (ob ^ (((ob >> 9) & 1) << 5)); }
__host__ __device__ __forceinline__ void stage_rc(int b, int& R, int& C) { const int st = b / 1024, sb = b % 1024, swz = sb ^ (((sb >> 9) & 1) << 5); R = (st >> 1) * 16 + swz / 64; C = (st & 1) * 32 + (swz % 64) / 2; }
__host__ __device__ __forceinline__ int perm32(int rho) { const int n = rho >> 4, i = rho & 15; return 8 * (i >> 2) + 4 * n + (i & 3); }

struct Unit { int pm, pn; };
struct Gemm { const bf16_t* A; const bf16_t* Bt; int M, N, K; };

struct StaticOrder {
    int nM, nN, nwg, G, c;
    __host__ __device__ void init(int M, int N, int G_, int c_) { nM = M / BM; nN = N / BM; nwg = nM * nN; G = G_; c = c_; }
    __host__ __device__ bool next(int i, Unit& u) const {
        const long L = (long)i * G + c; if (L >= nwg) return false;
        int wgid = (int)L; { const int q = nwg / NXCD, r = nwg % NXCD, xcd = wgid % NXCD, off = wgid / NXCD; wgid = (xcd < r ? xcd * (q + 1) : r * (q + 1) + (xcd - r) * q) + off; }
        const int nig = WGM * nN, gid = wgid / nig, fm = gid * WGM, gsz = (nM - fm) < WGM ? (nM - fm) : WGM;
        u.pm = fm + ((wgid % nig) % gsz); u.pn = (wgid % nig) / gsz; return true;
    }
    __device__ __forceinline__ void a_ready(const Unit&) const {}
    __device__ __forceinline__ void done(const Unit&) const {}
};
struct MoeOrder {
    const PG8_LAS int* tbl; int G, c, nunits;
    __device__ __forceinline__ bool next(int i, Unit& u) const {
        const long L = (long)i * G + c; if (L >= nunits) return false;
        int wgid = (int)L; { const int q = nunits / NXCD, r = nunits % NXCD, xcd = wgid % NXCD, off = wgid / NXCD; wgid = (xcd < r ? xcd * (q + 1) : r * (q + 1) + (xcd - r) * q) + off; }
        int e = 0;
#pragma unroll
        for (int j = 1; j < 32; ++j) e += (wgid >= tbl[j]) ? 1 : 0;
        const int local = wgid - tbl[e], tb = tbl[33 + e], nt = tbl[34 + e] - tb;
        const int pn = local / nt, tl = local - pn * nt;
        u.pm = __builtin_amdgcn_readfirstlane(tb + tl); u.pn = __builtin_amdgcn_readfirstlane(e * 4 + pn); return true;
    }
    __device__ __forceinline__ void a_ready(const Unit&) const {}
    __device__ __forceinline__ void done(const Unit&) const {}
};

__device__ __forceinline__ unsigned cvt_pk_bf16(float lo, float hi) { unsigned r; asm volatile("v_cvt_pk_bf16_f32 %0, %1, %2" : "=v"(r) : "v"(lo), "v"(hi)); return r; }

struct EpiStore {
    static constexpr bool PERM = true, AFTER_DRAIN = false;
    bf16_t* O; int ldc; const float* bias; int pn_mask;
    __device__ __forceinline__ void operator()(const f32x4 (&acc)[2][2][4][2], const Unit& u, int wr, int wc, int fr, int fq) const {
        const int row0 = u.pm * BM + wr * 64 + fr; const int col0 = (u.pn & pn_mask) * BM + wc * 32 + 8 * fq;
        f32x4 bv[2][2];
#pragma unroll
        for (int bj = 0; bj < 2; ++bj)
#pragma unroll
            for (int n = 0; n < 2; ++n) bv[bj][n] = bias ? *(const f32x4*)(bias + col0 + bj * HALF + 4 * n) : (f32x4){0.f, 0.f, 0.f, 0.f};
#pragma unroll
        for (int ai = 0; ai < 2; ++ai)
#pragma unroll
            for (int m = 0; m < 4; ++m) { bf16_t* rowp = O + (size_t)(row0 + ai * HALF + m * 16) * ldc + col0;
#pragma unroll
                for (int bj = 0; bj < 2; ++bj) { const f32x4 v0 = acc[ai][bj][m][0] + bv[bj][0], v1 = acc[ai][bj][m][1] + bv[bj][1];
                    u32x4 w; w.x = cvt_pk_bf16(v0[0], v0[1]); w.y = cvt_pk_bf16(v0[2], v0[3]); w.z = cvt_pk_bf16(v1[0], v1[1]); w.w = cvt_pk_bf16(v1[2], v1[3]);
                    *(u32x4*)(rowp + bj * HALF) = w; } }
    }
};
template <int MODE> struct EpiPair {
    static constexpr bool PERM = true, AFTER_DRAIN = false;
    bf16_t* O; int ldc; int pn_mask;
    __device__ __forceinline__ void operator()(const f32x4 (&acc)[2][2][4][2], const Unit& u, int wr, int wc, int fr, int fq) const {
        const int row0 = u.pm * BM + wr * 64 + fr; const int col0 = (u.pn & pn_mask) * HALF + wc * 32 + 8 * fq;
#pragma unroll
        for (int ai = 0; ai < 2; ++ai)
#pragma unroll
            for (int m = 0; m < 4; ++m) { bf16_t* rowp = O + (size_t)(row0 + ai * HALF + m * 16) * ldc + col0;
                float r[8];
#pragma unroll
                for (int n = 0; n < 2; ++n)
#pragma unroll
                    for (int j = 0; j < 4; ++j) { const float a = acc[ai][0][m][n][j], b = acc[ai][1][m][n][j];
                        r[n * 4 + j] = (MODE == 0) ? (a * b) / (1.0f + __expf(-a)) : a / (1.0f + __expf(-b)); }
                u32x4 w; w.x = cvt_pk_bf16(r[0], r[1]); w.y = cvt_pk_bf16(r[2], r[3]); w.z = cvt_pk_bf16(r[4], r[5]); w.w = cvt_pk_bf16(r[6], r[7]);
                *(u32x4*)rowp = w; }
    }
};
template <class Epi, class Sched, bool ALIGN_EPI = false, bool SP2 = false>
__device__ __forceinline__ void gemm_phase(PG8_LAS unsigned char* lds, const Gemm g, const Sched& S, const Epi& E) {
    const int tid = threadIdx.x, wid = __builtin_amdgcn_readfirstlane(tid >> 6), lane = tid & 63, wr = wid >> 2, wc = wid & 3, fr = lane & 15, fq = lane >> 4;
    const int K = g.K, nt = K / BK;
    unsigned voffA[2], voffB[2];
#pragma unroll
    for (int i = 0; i < 2; ++i) { int R, C; stage_rc(tid * 16 + i * 8192, R, C); const int Rb = Epi::PERM ? ((R & ~31) + perm32(R & 31)) : R;
        voffA[i] = (unsigned)(R * K + C) * 2u; voffB[i] = (unsigned)(Rb * K + C) * 2u; }
    const size_t kstep = (size_t)(BK * 2);
    const size_t hstep = (size_t)HALF * K * 2;
    const size_t tstep = 2 * hstep;
    const unsigned ldsw = (unsigned)wid * 1024u;
    const int aoff = lds_byte(wr * 64 + fr, fq * 8), boff = lds_byte(wc * 32 + fr, fq * 8);
#define PG8_SA(b, h) (((b) * 2 + (h)) * HTB)
#define PG8_SB(b, h) ((4 + (b) * 2 + (h)) * HTB)
#define PG8_STAGE(bufoff, gbase, voff) do { _Pragma("unroll") for (int _i = 0; _i < 2; ++_i) \
        __builtin_amdgcn_global_load_lds((const unsigned*)((const char*)(gbase) + (voff)[_i]), (PG8_LAS unsigned*)(lds + (bufoff) + ldsw + _i * 8192), 16, 0, 0); } while (0)
#define PG8_LDA(dst, b, h) do { _Pragma("unroll") for (int m = 0; m < 4; ++m) _Pragma("unroll") for (int k = 0; k < 2; ++k) dst[m][k] = *(const PG8_LAS bf16x8*)(lds + PG8_SA(b, h) + aoff + m * 2048 + k * 1024); } while (0)
#define PG8_LDB(dst, b, h) do { _Pragma("unroll") for (int n = 0; n < 2; ++n) _Pragma("unroll") for (int k = 0; k < 2; ++k) dst[n][k] = *(const PG8_LAS bf16x8*)(lds + PG8_SB(b, h) + boff + n * 2048 + k * 1024); } while (0)
#define PG8_MMA(ai, bj, At, Bt) do { __builtin_amdgcn_s_setprio(1); _Pragma("unroll") for (int m = 0; m < 4; ++m) _Pragma("unroll") for (int n = 0; n < 2; ++n) _Pragma("unroll") for (int k = 0; k < 2; ++k) \
        acc[ai][bj][m][n] = __builtin_amdgcn_mfma_f32_16x16x32_bf16(Bt[n][k], At[m][k], acc[ai][bj][m][n], 0, 0, 0); __builtin_amdgcn_s_setprio(0); } while (0)
#define PG8_WAIT_V(n) asm volatile("s_waitcnt vmcnt(" #n ")" ::: "memory")
#define PG8_WAIT_L(n) asm volatile("s_waitcnt lgkmcnt(" #n ")" ::: "memory")
#define PG8_BAR __builtin_amdgcn_s_barrier()
#define PG8_SCHED __builtin_amdgcn_sched_barrier(0)
    Unit cur, nxt; int ui = 0;
    if (!S.next(0, cur)) return;
    f32x4 acc[2][2][4][2];
#pragma unroll
    for (int a = 0; a < 2; ++a)
#pragma unroll
        for (int b = 0; b < 2; ++b)
#pragma unroll
            for (int m = 0; m < 4; ++m)
#pragma unroll
                for (int n = 0; n < 2; ++n) acc[a][b][m][n] = (f32x4){0.f, 0.f, 0.f, 0.f};
    bf16x8 At[4][2], B0[2][2], B1[2][2];
    const char* cA = (const char*)g.A + (size_t)cur.pm * tstep; const char* cB = (const char*)g.Bt + (size_t)cur.pn * tstep;
    S.a_ready(cur);
    if constexpr (SP2) {
        PG8_STAGE(PG8_SB(0, 0), cB, voffB); PG8_STAGE(PG8_SB(0, 1), cB + hstep, voffB); PG8_STAGE(PG8_SA(0, 0), cA, voffA); PG8_STAGE(PG8_SA(0, 1), cA + hstep, voffA);
        if (wr == 1) PG8_BAR;
        PG8_WAIT_V(2); PG8_BAR;
        PG8_STAGE(PG8_SB(1, 0), cB + kstep, voffB); PG8_STAGE(PG8_SA(1, 0), cA + kstep, voffA); PG8_STAGE(PG8_SB(1, 1), cB + hstep + kstep, voffB);
        PG8_WAIT_V(6); PG8_BAR;
    } else {
        PG8_STAGE(PG8_SB(0, 0), cB, voffB); PG8_STAGE(PG8_SA(0, 0), cA, voffA); PG8_STAGE(PG8_SB(0, 1), cB + hstep, voffB); PG8_STAGE(PG8_SA(0, 1), cA + hstep, voffA);
        if (wr == 1) PG8_BAR;
        PG8_WAIT_V(4); PG8_BAR;
        PG8_STAGE(PG8_SB(1, 0), cB + kstep, voffB); PG8_STAGE(PG8_SA(1, 0), cA + kstep, voffA); PG8_STAGE(PG8_SB(1, 1), cB + hstep + kstep, voffB);
        PG8_WAIT_V(6); PG8_BAR;
    }
    for (;;) {
        const bool has_next = S.next(ui + 1, nxt);
        const char* nA = has_next ? (const char*)g.A + (size_t)nxt.pm * tstep : cA; const char* nB = has_next ? (const char*)g.Bt + (size_t)nxt.pn * tstep : cB;
        for (int t = 0; t < nt; t += 2) {
            const bool last = (t == nt - 2);
            const char* a1 = cA + (size_t)(t + 1) * kstep;
            const char* a2 = last ? nA : cA + (size_t)(t + 2) * kstep; const char* b2 = last ? nB : cB + (size_t)(t + 2) * kstep;
            const char* a3 = a2 + kstep; const char* b3 = b2 + kstep;
            if (last && has_next) S.a_ready(nxt);
            if constexpr (SP2) {
            PG8_LDB(B0, 0, 0); PG8_LDB(B1, 0, 1); PG8_SCHED; PG8_LDA(At, 0, 0); PG8_STAGE(PG8_SA(1, 1), a1 + hstep, voffA);
            PG8_WAIT_V(8); PG8_WAIT_L(0); PG8_BAR; PG8_MMA(0, 0, At, B0); PG8_MMA(0, 1, At, B1); PG8_BAR; PG8_SCHED;
            PG8_LDA(At, 0, 1); PG8_STAGE(PG8_SB(0, 0), b2, voffB); PG8_STAGE(PG8_SB(0, 1), b2 + hstep, voffB); PG8_STAGE(PG8_SA(0, 0), a2, voffA);
            PG8_WAIT_V(8); PG8_WAIT_L(0); PG8_BAR; PG8_MMA(1, 0, At, B0); PG8_MMA(1, 1, At, B1); PG8_BAR; PG8_SCHED;
            PG8_LDB(B0, 1, 0); PG8_LDB(B1, 1, 1); PG8_SCHED; PG8_LDA(At, 1, 0); PG8_STAGE(PG8_SA(0, 1), a2 + hstep, voffA);
            PG8_WAIT_V(8); PG8_WAIT_L(0); PG8_BAR; PG8_MMA(0, 0, At, B0); PG8_MMA(0, 1, At, B1); PG8_BAR; PG8_SCHED;
            PG8_LDA(At, 1, 1); PG8_STAGE(PG8_SB(1, 0), b3, voffB); PG8_STAGE(PG8_SB(1, 1), b3 + hstep, voffB); PG8_STAGE(PG8_SA(1, 0), a3, voffA);
            PG8_WAIT_V(8); PG8_WAIT_L(0); PG8_BAR; PG8_MMA(1, 0, At, B0); PG8_MMA(1, 1, At, B1); PG8_BAR; PG8_SCHED;
            } else {
            PG8_LDB(B0, 0, 0); PG8_SCHED; PG8_LDA(At, 0, 0); PG8_STAGE(PG8_SA(1, 1), a1 + hstep, voffA);
            PG8_WAIT_L(8); PG8_BAR; PG8_WAIT_L(0); PG8_MMA(0, 0, At, B0); PG8_BAR; PG8_SCHED;
            PG8_LDB(B1, 0, 1); PG8_STAGE(PG8_SB(0, 0), b2, voffB);
            PG8_BAR; PG8_WAIT_L(0); PG8_MMA(0, 1, At, B1); PG8_BAR;
            PG8_LDA(At, 0, 1); PG8_STAGE(PG8_SA(0, 0), a2, voffA);
            PG8_BAR; PG8_WAIT_L(0); PG8_MMA(1, 0, At, B0); PG8_BAR; PG8_SCHED;
            PG8_STAGE(PG8_SB(0, 1), b2 + hstep, voffB);
            PG8_WAIT_V(6); PG8_BAR; PG8_MMA(1, 1, At, B1); PG8_BAR;
            PG8_LDB(B0, 1, 0); PG8_SCHED; PG8_LDA(At, 1, 0); PG8_STAGE(PG8_SA(0, 1), a2 + hstep, voffA);
            PG8_WAIT_L(8); PG8_BAR; PG8_WAIT_L(0); PG8_MMA(0, 0, At, B0); PG8_BAR; PG8_SCHED;
            PG8_LDB(B1, 1, 1); PG8_STAGE(PG8_SB(1, 0), b3, voffB);
            PG8_BAR; PG8_WAIT_L(0); PG8_MMA(0, 1, At, B1); PG8_BAR;
            PG8_LDA(At, 1, 1); PG8_STAGE(PG8_SA(1, 0), a3, voffA);
            PG8_BAR; PG8_WAIT_L(0); PG8_MMA(1, 0, At, B0); PG8_BAR; PG8_SCHED;
            PG8_STAGE(PG8_SB(1, 1), b3 + hstep, voffB);
            PG8_WAIT_V(6); PG8_BAR; PG8_MMA(1, 1, At, B1); PG8_BAR;
            }
        }
        if constexpr (ALIGN_EPI) { if (wr == 0) PG8_BAR; }
        if constexpr (!Epi::AFTER_DRAIN) { E(acc, cur, wr, wc, fr, fq); S.done(cur); }
        if (!has_next) break;
#pragma unroll
        for (int a = 0; a < 2; ++a)
#pragma unroll
            for (int b = 0; b < 2; ++b)
#pragma unroll
                for (int m = 0; m < 4; ++m)
#pragma unroll
                    for (int n = 0; n < 2; ++n) acc[a][b][m][n] = (f32x4){0.f, 0.f, 0.f, 0.f};
        cur = nxt; cA = nA; cB = nB; ++ui;
        if constexpr (ALIGN_EPI) { if (wr == 1) PG8_BAR; }
    }
    PG8_WAIT_V(0);
    if constexpr (!ALIGN_EPI) { if (wr == 0) PG8_BAR; }
    PG8_BAR;
    if constexpr (Epi::AFTER_DRAIN) { E.fused(acc, cur, wr, wc, fr, fq, lds, wid, lane); S.done(cur); }
#undef PG8_SA
#undef PG8_SB
#undef PG8_STAGE
#undef PG8_LDA
#undef PG8_LDB
#undef PG8_MMA
#undef PG8_WAIT_V
#undef PG8_WAIT_L
#undef PG8_BAR
#undef PG8_SCHED
}
}

#define XB_TMO      128
#define XB_XCNT(j)  (256  + 64 * (j))
#define XB_XSUB(j)  (1280 + 64 * (j))
#define XB_XGEN(j)  (2304 + 64 * (j))
#define XB_TOP      3328
#define XB_TOPGEN   3392
#define XCD_BAR_WORDS 3456
#define XB_SPIN_CAP (1u << 18)

__device__ __forceinline__ unsigned xb_ld(unsigned* p)              { return __hip_atomic_load(p, __ATOMIC_RELAXED, __HIP_MEMORY_SCOPE_AGENT); }
__device__ __forceinline__ unsigned xb_add(unsigned* p, unsigned v) { return __hip_atomic_fetch_add(p, v, __ATOMIC_RELAXED, __HIP_MEMORY_SCOPE_AGENT); }
__device__ __forceinline__ unsigned xb_xcc_id() { return (unsigned)__builtin_amdgcn_s_getreg((3 << 11) | 20) & 0xFu; }
#define XB_SPIN(cond, bar) do { unsigned _sp = 0; while (cond) { __builtin_amdgcn_s_sleep(1); \
    if ((++_sp & 255u) == 0u) { if (xb_ld(&(bar)[XB_TMO])) break; if (_sp > XB_SPIN_CAP) { atomicAdd(&(bar)[XB_TMO], 1u); break; } } } } while (0)

struct XcdBarrier {
    unsigned* bar; unsigned x;
    volatile LAS unsigned* st;
};

__device__ __forceinline__ XcdBarrier xcd_barrier_post(unsigned* bar, volatile LAS unsigned* st) {
    XcdBarrier b; b.bar = bar; b.x = xb_xcc_id(); b.st = st;
    if (threadIdx.x == 0) (void)xb_add(&bar[XB_XCNT(b.x)], 1u);
    return b;
}
__device__ __forceinline__ void xcd_barrier_complete(unsigned* bar, unsigned x, unsigned& nloc, unsigned& nx) {
    const unsigned G = gridDim.x * gridDim.y * gridDim.z;
    unsigned sum, cnt, mine, sp = 0u;
    for (;;) {
        sum = 0u; cnt = 0u; mine = 0u;
#pragma unroll
        for (unsigned j = 0; j < 16; ++j) { const unsigned c = xb_ld(&bar[XB_XCNT(j)]); sum += c; cnt += (c > 0u) ? 1u : 0u; mine = (j == x) ? c : mine; }
        if (sum == G) break;
        __builtin_amdgcn_s_sleep(1);
        if ((++sp & 255u) == 0u) { if (xb_ld(&bar[XB_TMO])) break; if (sp > XB_SPIN_CAP) { atomicAdd(&bar[XB_TMO], 1u); break; } }
    }
    nloc = mine > 0u ? mine : 1u; nx = cnt > 0u ? cnt : 1u;
}

__device__ __forceinline__ void xcd_barrier(const XcdBarrier& b) {
    asm volatile("s_waitcnt vmcnt(0)" ::: "memory");
    __syncthreads();
    if (threadIdx.x == 0) {
        unsigned* bar = b.bar;
        __builtin_amdgcn_s_waitcnt(0);
        unsigned nloc = b.st[0], nx = b.st[1];
        if (nloc == 0u) { xcd_barrier_complete(bar, b.x, nloc, nx); b.st[0] = nloc; b.st[1] = nx; }
        const unsigned old = xb_add(&bar[XB_XSUB(b.x)], 1u);
        const unsigned gen = old / nloc;
        if (old + 1u == (gen + 1u) * nloc) {
            __builtin_amdgcn_fence(__ATOMIC_RELEASE, "agent");
            asm volatile("s_waitcnt vmcnt(0)" ::: "memory");
            const unsigned og = xb_add(&bar[XB_TOP], 1u);
            const unsigned tg = og / nx;
            if (og + 1u == (tg + 1u) * nx) xb_add(&bar[XB_TOPGEN], 1u);
            else XB_SPIN(xb_ld(&bar[XB_TOPGEN]) == tg, bar);
            __builtin_amdgcn_fence(__ATOMIC_ACQUIRE, "agent");
            xb_add(&bar[XB_XGEN(b.x)], 1u);
            asm volatile("s_waitcnt vmcnt(0)" ::: "memory");
        } else {
            XB_SPIN(xb_ld(&bar[XB_XGEN(b.x)]) == gen, bar);
            __builtin_amdgcn_fence(__ATOMIC_ACQUIRE, "agent");
            asm volatile("s_waitcnt vmcnt(0)" ::: "memory");
        }
    }
    __syncthreads();
}

struct Ctx {
    LAS unsigned char* lds;
    unsigned* ctl;
    unsigned char* ws;
    const float* in[35];
    float* out;
    int tid, lane, wave, G, vcu;
};
#define WSP(T_, off) ((T_*)(C.ws + (off)))

DI void transpose_item(const float* W, int ldw, int K, int k0, int n0, bf16* WT, int drow0, LAS float* scr, int lane) {
#pragma unroll 8
    for (int i = 0; i < 32; ++i) { const int kk = 2 * i + (lane >> 5); scr[kk * 33 + (lane & 31)] = W[(size_t)(k0 + kk) * ldw + n0 + (lane & 31)]; }
    LDS_WAIT(); asm volatile("" ::: "memory");
    const int c = lane & 7;
#pragma unroll
    for (int j = 0; j < 4; ++j) { const int n = (lane >> 3) + 8 * j; const LAS float* s = scr + (8 * c) * 33 + n;
        u32x4 o; o.x = pk2(s[0 * 33], s[1 * 33]); o.y = pk2(s[2 * 33], s[3 * 33]); o.z = pk2(s[4 * 33], s[5 * 33]); o.w = pk2(s[6 * 33], s[7 * 33]);
        *(u32x4*)(WT + (size_t)(drow0 + n) * K + k0 + 8 * c) = o; }
    LDS_WAIT(); asm volatile("" ::: "memory");
}
DI int pair_row(int n, int half) { return (n >> 7) * 256 + half * 128 + (n & 127); }

DI void p0a_weights(Ctx& C) {
    LAS float* scr = (LAS float*)(C.lds + C.wave * 8448);
    const int gw = C.vcu * 8 + C.wave, NGW = C.G * 8, lane = C.lane;
    constexpr int I_MIN = 16 * 96, I_SQ = 16 * 32, I_GLU = 16 * 64, I_QKV = 16 * 48;
    constexpr int NDENSE = 2 * I_MIN + 2 * I_SQ + I_SQ + I_GLU + I_QKV + I_SQ;
    for (int it = gw; it < NDENSE; it += NGW) {
        int r = it;
        if (r < 2 * I_MIN) { const int j = r / I_MIN; r -= j * I_MIN; const int kb = r / 96, nb = r % 96;
            transpose_item(C.in[8] + (size_t)j * D * M_IN, M_IN, D, kb * 64, nb * 32, WSP(bf16, WS_WMIN) + (size_t)j * M_NIN * D, nb * 32, scr, lane); continue; } r -= 2 * I_MIN;
        if (r < 2 * I_SQ) { const int j = r / I_SQ; r -= j * I_SQ; const int kb = r / 32, nb = r % 32;
            transpose_item(C.in[13] + (size_t)j * D * D, D, D, kb * 64, nb * 32, WSP(bf16, WS_WMOUT) + (size_t)j * D * D, nb * 32, scr, lane); continue; } r -= 2 * I_SQ;
        if (r < I_SQ) { const int kb = r / 32, nb = r % 32; transpose_item(C.in[14], D, D, kb * 64, nb * 32, WSP(bf16, WS_WS5IN), nb * 32, scr, lane); continue; } r -= I_SQ;
        if (r < I_GLU) { const int kb = r / 64, nb = r % 64; const int n0 = nb * 32; transpose_item(C.in[23], 2 * D, D, kb * 64, n0, WSP(bf16, WS_WS5GLU), pair_row(n0 & 1023, n0 >> 10), scr, lane); continue; } r -= I_GLU;
        if (r < I_QKV) { const int kb = r / 48, nb = r % 48; transpose_item(C.in[24], A_NQKV, D, kb * 64, nb * 32, WSP(bf16, WS_WQKV), nb * 32, scr, lane); continue; } r -= I_QKV;
        { const int kb = r / 32, nb = r % 32; transpose_item(C.in[27], D, D, kb * 64, nb * 32, WSP(bf16, WS_WWO), nb * 32, scr, lane); }
    }
    constexpr int I_E = 256;
    constexpr int NMOE = DEPTH * N_EXP * 3 * I_E;
    for (int it = gw; it < NMOE; it += NGW) {
        const int le = it / (3 * I_E); int r = it - le * 3 * I_E; const int which = r / I_E; r -= which * I_E;
        if (which < 2) { const int kb = r / 16, nb = r % 16; const int n0 = nb * 32;
            transpose_item(C.in[which == 0 ? 32 : 33] + (size_t)le * D * D_EXP, D_EXP, D, kb * 64, n0, WSP(bf16, WS_W13) + (size_t)le * D * D, pair_row(n0, which), scr, lane); }
        else { const int kb = r / 32, nb = r % 32;
            transpose_item(C.in[34] + (size_t)le * D_EXP * D, D, D_EXP, kb * 64, nb * 32, WSP(bf16, WS_W2) + (size_t)le * D * D_EXP, nb * 32, scr, lane); }
    }
    const int gt = C.vcu * 512 + C.tid, NGT = C.G * 512;
    for (int i = gt; i < DEPTH * 48 * D; i += NGT) { const int l = i / (48 * D), c = (i / D) % 48, k = i % D; float w = 0.f;
        if (c < 4) w = C.in[28][((size_t)l * D + k) * E_GROUPS + c]; else if (c >= 16) w = C.in[30][((size_t)l * D + k) * N_EXP + (c - 16)];
        const unsigned h = f2bf(w); WSP(bf16, WS_RWH)[i] = (bf16)h; WSP(bf16, WS_RWL)[i] = (bf16)f2bf(w - bf2f(h)); }
    for (int i = gt; i < DEPTH * 48; i += NGT) { const int l = i / 48, c = i % 48; float b = 0.f;
        if (c < 4) b = C.in[29][l * E_GROUPS + c]; else if (c >= 16) b = C.in[31][l * N_EXP + (c - 16)]; WSP(float, WS_RB)[i] = b; }
    for (int i = gt; i < 2 * 16 * D; i += NGT) { const int j = i / (16 * D), c = (i / D) % 16, k = i % D; float w = 0.f;
        if (c < 8) w = C.in[8][((size_t)j * D + k) * M_IN + M_NIN + c];
        const unsigned h = f2bf(w); WSP(bf16, WS_GWH)[i] = (bf16)h; WSP(bf16, WS_GWL)[i] = (bf16)f2bf(w - bf2f(h)); }
    for (int i = gt; i < S5_G * S5_P; i += NGT) { const int g = i / S5_P, p = i % S5_P;
        const float dt = expf(C.in[17][g]), lr = C.in[15][i], li = C.in[16][i];
        const float mag = expf(lr * dt); float sn, cs; sincosf(li * dt, &sn, &cs);
        const float are = mag * cs, aim = mag * sn; WSP(float, WS_S5ABAR)[2 * i] = are; WSP(float, WS_S5ABAR)[2 * i + 1] = aim;
        const float lsq = lr * lr + li * li, tre = ((are - 1.0f) * lr + aim * li) / lsq, tim = (aim * lr - (are - 1.0f) * li) / lsq;
        bf16* bbt = WSP(bf16, WS_S5BBT) + (size_t)g * 128 * 16;
        for (int q = 0; q < 16; ++q) { const float br = C.in[18][(size_t)i * 16 + q], bi = C.in[19][(size_t)i * 16 + q];
            bbt[p * 16 + q] = (bf16)f2bf(tre * br - tim * bi); bbt[(64 + p) * 16 + q] = (bf16)f2bf(tre * bi + tim * br); }
        bf16* cmt = WSP(bf16, WS_S5CMT) + (size_t)g * 16 * 128;
        for (int q = 0; q < 16; ++q) { cmt[q * 128 + p] = (bf16)f2bf(C.in[20][((size_t)g * 16 + q) * S5_P + p]); cmt[q * 128 + 64 + p] = (bf16)f2bf(-C.in[21][((size_t)g * 16 + q) * S5_P + p]); } }
    __syncthreads();
    LAS float* cs = (LAS float*)C.lds;
    LAS float* red = cs + 2048;
    for (int i = C.tid; i < 2 * D; i += 512) { const float v = C.in[1][i]; cs[i] = v / (1.0f + __expf(-v)); }
    __syncthreads();
    for (int it = C.vcu; it < DEPTH * 96; it += C.G) { const int l = it / 96, cg = it % 96;
        const float* w = C.in[2] + (size_t)l * D * 6 * D + cg * 64 + lane; float a0 = 0.f, a1 = 0.f;
#pragma unroll 8
        for (int k = C.wave * 128; k < C.wave * 128 + 128; ++k) { const float wv = w[(size_t)k * 6 * D]; a0 += cs[k] * wv; a1 += cs[D + k] * wv; }
        red[(C.wave * 2 + 0) * 64 + lane] = a0; red[(C.wave * 2 + 1) * 64 + lane] = a1;
        __syncthreads();
        if (C.tid < 128) { const int b = C.tid >> 6, c = C.tid & 63; float s = 0.f;
#pragma unroll
            for (int w8 = 0; w8 < 8; ++w8) s += red[(w8 * 2 + b) * 64 + c];
            WSP(float, WS_MOD)[((size_t)l * 2 + b) * 6 * D + cg * 64 + c] = s + C.in[3][(size_t)l * 6 * D + cg * 64 + c]; }
        __syncthreads();
    }
}

constexpr int RP_XSTR = 1032;
constexpr int RP_XH = 0, RP_XL = RP_XH + 16 * RP_XSTR * 2, RP_PART = RP_XL + 16 * RP_XSTR * 2, RP_LOG = RP_PART + 8 * 16 * 48 * 4, RP_REC = RP_LOG + 16 * 48 * 4,
              RP_LCNT = RP_REC + 128 * 6 * 4, RP_END = RP_LCNT + 64 * 4;
static_assert(RP_END <= RING_BYTES, "row phase LDS");

template <int MODE, int NT, bool WRITE_HIN>
DI void row_phase(Ctx& C, const float* xsrc, const int layer, const int gate_idx, const float* lng, const float* lnb, const int mlayer, const int sc_idx, const int sh_idx, const int gj) {
    const int lane = C.lane, wave = C.wave, tid = C.tid, q = lane >> 4, fr = lane & 15;
    LAS bf16* XH = (LAS bf16*)(C.lds + RP_XH); LAS bf16* XL = (LAS bf16*)(C.lds + RP_XL);
    LAS float* PART = (LAS float*)(C.lds + RP_PART); LAS float* LOG = (LAS float*)(C.lds + RP_LOG);
    LAS int* REC = (LAS int*)(C.lds + RP_REC); LAS int* LCNT = (LAS int*)(C.lds + RP_LCNT);
    const float* MOD = WSP(float, WS_MOD);
    bf16x8 wh[NT > 0 ? NT : 1][4], wl[NT > 0 ? NT : 1][4];
    if constexpr (NT > 0) {
        const bf16* th = (NT == 3) ? WSP(bf16, WS_RWH) + (size_t)layer * 48 * D : WSP(bf16, WS_GWH) + (size_t)gj * 16 * D;
        const bf16* tl = (NT == 3) ? WSP(bf16, WS_RWL) + (size_t)layer * 48 * D : WSP(bf16, WS_GWL) + (size_t)gj * 16 * D;
#pragma unroll
        for (int nt = 0; nt < NT; ++nt)
#pragma unroll
            for (int ks = 0; ks < 4; ++ks) { const size_t o = (size_t)(nt * 16 + fr) * D + wave * 128 + ks * 32 + 8 * q;
                wh[nt][ks] = *(const bf16x8*)(th + o); wl[nt][ks] = *(const bf16x8*)(tl + o); }
    }
    for (int rb = C.vcu; rb < T / 128; rb += C.G) {
        const int b = (rb * 128) / SEQ;
        f32x4 vg[4], vlg[4], vlb[4], vsc[4], vsh[4];
#pragma unroll
        for (int j = 0; j < 4; ++j) { const int c = 4 * lane + 256 * j;
            if constexpr (MODE != 0) { vg[j] = *(const f32x4*)(MOD + ((size_t)layer * 2 + b) * 6 * D + gate_idx * D + c); vlg[j] = *(const f32x4*)(lng + c); vlb[j] = *(const f32x4*)(lnb + c); }
            if constexpr (WRITE_HIN) { vsc[j] = *(const f32x4*)(MOD + ((size_t)mlayer * 2 + b) * 6 * D + sc_idx * D + c) + 1.0f; vsh[j] = *(const f32x4*)(MOD + ((size_t)mlayer * 2 + b) * 6 * D + sh_idx * D + c); } }
        if constexpr (NT == 3) { if (tid < 32) LCNT[tid] = 0; }
        __syncthreads();
        for (int grp = 0; grp < 8; ++grp) {
#pragma unroll
            for (int rr = 0; rr < 2; ++rr) {
                const int lr = 2 * wave + rr; const size_t t = (size_t)rb * 128 + grp * 16 + lr;
                f32x4 v[4];
#pragma unroll
                for (int j = 0; j < 4; ++j) v[j] = *(const f32x4*)(xsrc + t * D + 4 * lane + 256 * j);
                if constexpr (MODE == 1) {
                    const bf16* yr = WSP(bf16, WS_YMIX) + t * D + 4 * lane;
#pragma unroll
                    for (int j = 0; j < 4; ++j) { const u32x2 w = *(const u32x2*)(yr + 256 * j); const f32x4 y = {bflo(w.x), bfhi(w.x), bflo(w.y), bfhi(w.y)}; v[j] = v[j] * DN_ALPHA + vg[j] * y; }
                }
                if constexpr (MODE == 2) {
                    const int p0 = WSP(int, WS_TOKPOS)[2 * t], p1 = WSP(int, WS_TOKPOS)[2 * t + 1]; const float w0 = WSP(float, WS_TOKW)[2 * t], w1 = WSP(float, WS_TOKW)[2 * t + 1];
                    const bf16* y0 = WSP(bf16, WS_YEXP) + (size_t)p0 * D + 4 * lane; const bf16* y1 = WSP(bf16, WS_YEXP) + (size_t)p1 * D + 4 * lane;
#pragma unroll
                    for (int j = 0; j < 4; ++j) { const u32x2 a = *(const u32x2*)(y0 + 256 * j), c2 = *(const u32x2*)(y1 + 256 * j);
                        const f32x4 y = (f32x4){bflo(a.x), bfhi(a.x), bflo(a.y), bfhi(a.y)} * w0 + (f32x4){bflo(c2.x), bfhi(c2.x), bflo(c2.y), bfhi(c2.y)} * w1;
                        v[j] = v[j] * DN_ALPHA + vg[j] * y; }
                }
                if constexpr (MODE != 0) {
                    float s = 0.f;
#pragma unroll
                    for (int j = 0; j < 4; ++j) s += (v[j].x + v[j].y) + (v[j].z + v[j].w);
                    const float mean = wave_sum(s) * (1.0f / D); float s2 = 0.f;
#pragma unroll
                    for (int j = 0; j < 4; ++j) { v[j] = v[j] - mean; s2 += (v[j].x * v[j].x + v[j].y * v[j].y) + (v[j].z * v[j].z + v[j].w * v[j].w); }
                    const float rstd = 1.0f / sqrtf(wave_sum(s2) * (1.0f / D) + LN_EPS);
#pragma unroll
                    for (int j = 0; j < 4; ++j) { v[j] = v[j] * rstd * vlg[j] + vlb[j]; *(f32x4*)(C.out + t * D + 4 * lane + 256 * j) = v[j]; }
                }
                if constexpr (WRITE_HIN) {
#pragma unroll
                    for (int j = 0; j < 4; ++j) { const f32x4 h = v[j] * vsc[j] + vsh[j];
                        const unsigned h0 = f2bf(h.x), h1 = f2bf(h.y), h2 = f2bf(h.z), h3 = f2bf(h.w);
                        u32x2 hw; hw.x = h0 | (h1 << 16); hw.y = h2 | (h3 << 16);
                        *(u32x2*)(WSP(bf16, WS_HIN) + t * D + 4 * lane + 256 * j) = hw;
                        if constexpr (NT > 0) {
                            u32x2 lw; lw.x = pk2(h.x - bf2f(h0), h.y - bf2f(h1)); lw.y = pk2(h.z - bf2f(h2), h.w - bf2f(h3));
                            *(LAS u32x2*)(XH + lr * RP_XSTR + 4 * lane + 256 * j) = hw; *(LAS u32x2*)(XL + lr * RP_XSTR + 4 * lane + 256 * j) = lw; } }
                }
            }
            if constexpr (NT > 0) {
                __syncthreads();
                f32x4 acc[NT];
#pragma unroll
                for (int nt = 0; nt < NT; ++nt) acc[nt] = (f32x4){0.f, 0.f, 0.f, 0.f};
#pragma unroll
                for (int ks = 0; ks < 4; ++ks) { const int o = fr * RP_XSTR + wave * 128 + ks * 32 + 8 * q;
                    const bf16x8 ah = *(const LAS bf16x8*)(XH + o), al = *(const LAS bf16x8*)(XL + o);
#pragma unroll
                    for (int nt = 0; nt < NT; ++nt) { acc[nt] = MMA(ah, wh[nt][ks], acc[nt]); acc[nt] = MMA(al, wh[nt][ks], acc[nt]); acc[nt] = MMA(ah, wl[nt][ks], acc[nt]); } }
#pragma unroll
                for (int nt = 0; nt < NT; ++nt)
#pragma unroll
                    for (int r = 0; r < 4; ++r) PART[(wave * 16 + 4 * q + r) * 48 + nt * 16 + fr] = acc[nt][r];
                __syncthreads();
                if constexpr (NT == 1) {
                    if (tid < 128) { const int row = tid >> 3, c = tid & 7; float s = 0.f;
#pragma unroll
                        for (int w8 = 0; w8 < 8; ++w8) s += PART[(w8 * 16 + row) * 48 + c];
                        WSP(float, WS_GATES)[((size_t)rb * 128 + grp * 16 + row) * 8 + c] = s; }
                } else {
                    const float* rbias = WSP(float, WS_RB) + layer * 48;
                    for (int idx = tid; idx < 16 * 48; idx += 512) { const int row = idx / 48, c = idx % 48; float s = 0.f;
#pragma unroll
                        for (int w8 = 0; w8 < 8; ++w8) s += PART[(w8 * 16 + row) * 48 + c];
                        LOG[idx] = s + rbias[c]; }
                    __syncthreads();
                    if (tid < 16) {
                        const LAS float* lg = LOG + tid * 48; int gs = 0; float gm = lg[0];
#pragma unroll
                        for (int g = 1; g < 4; ++g) if (lg[g] > gm) { gm = lg[g]; gs = g; }
                        float den = 0.f;
#pragma unroll
                        for (int g = 0; g < 4; ++g) den += __expf(lg[g] - gm);
                        const float pg = 1.0f / den;
                        const LAS float* el = lg + 16 + gs * 8; int i0 = 0; float v0 = el[0];
#pragma unroll
                        for (int i = 1; i < 8; ++i) if (el[i] > v0) { v0 = el[i]; i0 = i; }
                        int i1 = -1; float v1 = -3.0e38f;
#pragma unroll
                        for (int i = 0; i < 8; ++i) if (i != i0 && el[i] > v1) { v1 = el[i]; i1 = i; }
                        const float e1 = __expf(v1 - v0), w0 = pg / (1.0f + e1), w1 = pg * e1 / (1.0f + e1);
                        const int ex0 = gs * 8 + i0, ex1 = gs * 8 + i1;
                        const int ls0 = __hip_atomic_fetch_add(&LCNT[ex0], 1, __ATOMIC_RELAXED, __HIP_MEMORY_SCOPE_WORKGROUP), ls1 = __hip_atomic_fetch_add(&LCNT[ex1], 1, __ATOMIC_RELAXED, __HIP_MEMORY_SCOPE_WORKGROUP);
                        const int rloc = grp * 16 + tid;
                        REC[rloc * 6 + 0] = ex0; REC[rloc * 6 + 1] = ex1; REC[rloc * 6 + 2] = ls0; REC[rloc * 6 + 3] = ls1;
                        REC[rloc * 6 + 4] = __builtin_bit_cast(int, w0); REC[rloc * 6 + 5] = __builtin_bit_cast(int, w1);
                    }
                }
                __syncthreads();
            }
        }
        if constexpr (NT == 3) {
            __syncthreads();
            if (tid < 32) { const int n = LCNT[tid]; const unsigned gb = n ? atomicAdd(C.ctl + CW_GCNT + layer * 32 + tid, (unsigned)n) : 0u; LCNT[32 + tid] = (int)gb; }
            __syncthreads();
            if (tid < 256) { const int rloc = tid >> 1, k = tid & 1; const int e = REC[rloc * 6 + k], ls = REC[rloc * 6 + 2 + k]; const size_t t = (size_t)rb * 128 + rloc;
                WSP(int, WS_TOKES)[2 * t + k] = e | ((LCNT[32 + e] + ls) << 8); WSP(int, WS_TOKW)[2 * t + k] = REC[rloc * 6 + 4 + k]; }
            __syncthreads();
        }
    }
}

DI int moe_tables(Ctx& C, int layer) {
    LAS int* tbl = (LAS int*)(C.lds + MISC_OFF);
    if (C.tid == 0) { int tb = 0;
        for (int e = 0; e < N_EXP; ++e) { const unsigned n = __hip_atomic_load(C.ctl + CW_GCNT + layer * 32 + e, __ATOMIC_RELAXED, __HIP_MEMORY_SCOPE_AGENT);
            tbl[e] = tb * 4; tbl[33 + e] = tb; tb += (int)((n + 255u) >> 8); }
        tbl[32] = tb * 4; tbl[65] = tb; }
    __syncthreads();
    return tbl[32];
}
DI void moe_scatter(Ctx& C, int layer) {
    (void)moe_tables(C, layer);
    const LAS int* tbl = (const LAS int*)(C.lds + MISC_OFF);
    const int gw = C.vcu * 8 + C.wave, NGW = C.G * 8, lane = C.lane;
    for (int t = gw; t < T; t += NGW) {
        const int es0 = WSP(int, WS_TOKES)[2 * t], es1 = WSP(int, WS_TOKES)[2 * t + 1];
        const int p0 = tbl[33 + (es0 & 255)] * 256 + (es0 >> 8), p1 = tbl[33 + (es1 & 255)] * 256 + (es1 >> 8);
        if (lane == 0) { WSP(int, WS_TOKPOS)[2 * t] = p0; WSP(int, WS_TOKPOS)[2 * t + 1] = p1; }
        const u32x4* src = (const u32x4*)(WSP(bf16, WS_HIN) + (size_t)t * D) + lane;
        const u32x4 a = src[0], b2 = src[64];
        u32x4* d0 = (u32x4*)(WSP(bf16, WS_BUFX) + (size_t)p0 * D) + lane; u32x4* d1 = (u32x4*)(WSP(bf16, WS_BUFX) + (size_t)p1 * D) + lane;
        d0[0] = a; d0[64] = b2; d1[0] = a; d1[64] = b2;
    }
}

constexpr int ML_QSTR = 136, ML_TSTR = 72, ML_HSTR = 264;
constexpr int ML_QS = 0, ML_KS = ML_QS + 64 * ML_QSTR * 2, ML_VT = ML_KS + 64 * ML_QSTR * 2, ML_KWT = ML_VT + 256 * ML_TSTR * 2, ML_WM = ML_KWT + 128 * ML_TSTR * 2,
              ML_CW = ML_WM + 64 * ML_TSTR * 2, ML_AP = ML_CW + 2 * 5 * 128 * 4, ML_FL = ML_AP + 2048, ML_MR = ML_FL + 2048, ML_CH = ML_MR + 2048  ,
              ML_NS = ML_CH + 8 * 256, ML_STP = ML_NS + 512, ML_MRS = ML_STP + 64 * 8 * 8, ML_TMP = ML_MRS + 512, ML_END = ML_TMP + 256;
static_assert(ML_END <= RING_BYTES && 64 * ML_HSTR * 2 <= ML_VT, "mlstm LDS");

DI void mlstm_seg_scalars(Ctx& C, int mj, int bh, int seg) {
    LAS float* AP = (LAS float*)(C.lds + ML_AP); LAS float* FL = (LAS float*)(C.lds + ML_FL); LAS float* MR = (LAS float*)(C.lds + ML_MR); LAS float* TMP = (LAS float*)(C.lds + ML_TMP);
    const int b = bh >> 2, h = bh & 3, lane = C.lane, wave = C.wave; const size_t t = (size_t)b * SEQ + seg * M_SEGT + C.tid;
    const float* g = WSP(float, WS_GATES) + t * 8; const float* bif = C.in[11] + mj * 8;
    const float li = g[h] + bif[h], x = g[4 + h] + bif[4 + h];
    const float lf = fminf(x, 0.f) - log1pf(expf(-fabsf(x)));
    float s = lf;
#pragma unroll
    for (int o = 1; o < 64; o <<= 1) { const float n = __shfl_up(s, o); if (lane >= o) s += n; }
    if (lane == 63) TMP[wave] = s;
    __syncthreads();
    float off = 0.f;
    for (int w = 0; w < wave; ++w) off += TMP[w];
    s += off;
    const float ap = li - s; float m = ap;
#pragma unroll
    for (int o = 1; o < 64; o <<= 1) { const float n = __shfl_up(m, o); if (lane >= o) m = fmaxf(m, n); }
    if (lane == 63) TMP[16 + wave] = m;
    __syncthreads();
    for (int w = 0; w < wave; ++w) m = fmaxf(m, TMP[16 + w]);
    AP[C.tid] = ap; FL[C.tid] = s; MR[C.tid] = m;
    __syncthreads();
}
DI void mlstm_load_cw(Ctx& C, int mj, int h) {
    LAS float* CW = (LAS float*)(C.lds + ML_CW);
    for (int i = C.tid; i < 2 * 5 * 128; i += 512) { const int which = i / 640, r = (i % 640) / 128, d = i % 128; const int col = which * 512 + h * 128 + d;
        CW[i] = (r < 4) ? C.in[9][((size_t)mj * 4 + r) * 1024 + col] : C.in[10][(size_t)mj * 1024 + col]; }
}
DI void mlstm_conv16(const bf16* proj, size_t tok, int pos, int col0, const LAS float* cwp, float (&o)[16]) {
#pragma unroll
    for (int dd = 0; dd < 16; ++dd) o[dd] = cwp[4 * 128 + dd];
#pragma unroll
    for (int jj = 0; jj < 4; ++jj) {
        if (pos - 3 + jj >= 0) { const u32x4* p = (const u32x4*)(proj + (tok - 3 + jj) * M_NIN + col0); const u32x4 a = p[0], b2 = p[1];
            const unsigned w[8] = {a.x, a.y, a.z, a.w, b2.x, b2.y, b2.z, b2.w};
#pragma unroll
            for (int e = 0; e < 8; ++e) { o[2 * e] += cwp[jj * 128 + 2 * e] * bflo(w[e]); o[2 * e + 1] += cwp[jj * 128 + 2 * e + 1] * bfhi(w[e]); } }
    }
#pragma unroll
    for (int dd = 0; dd < 16; ++dd) o[dd] = o[dd] / (1.0f + __expf(-o[dd]));
}
DI void mlstm_load_vt(Ctx& C, const bf16* proj, size_t tok0, int h, int lane) {
    LAS bf16* VT = (LAS bf16*)(C.lds + ML_VT); const int s = lane, v0 = C.wave * 32;
    const u32x4* p = (const u32x4*)(proj + (tok0 + s) * M_NIN + 1024 + h * 256 + v0);
#pragma unroll
    for (int i = 0; i < 4; ++i) { const u32x4 a = p[i]; const unsigned w[4] = {a.x, a.y, a.z, a.w};
#pragma unroll
        for (int e = 0; e < 4; ++e) { VT[(v0 + i * 8 + 2 * e) * ML_TSTR + s] = (bf16)(w[e] & 0xffffu); VT[(v0 + i * 8 + 2 * e + 1) * ML_TSTR + s] = (bf16)(w[e] >> 16); } }
}
DI void mlstm_state_update(Ctx& C, f32x4 (&acc)[8][2], float decay, int lane) {
    const LAS bf16* VT = (const LAS bf16*)(C.lds + ML_VT); const LAS bf16* KWT = (const LAS bf16*)(C.lds + ML_KWT);
    const int fr = lane & 15, q = lane >> 4, w = C.wave;
#pragma unroll
    for (int dt = 0; dt < 8; ++dt) { acc[dt][0] = acc[dt][0] * decay; acc[dt][1] = acc[dt][1] * decay; }
#pragma unroll
    for (int ks = 0; ks < 2; ++ks) {
        const bf16x8 b0 = *(const LAS bf16x8*)(VT + ((2 * w) * 16 + fr) * ML_TSTR + ks * 32 + 8 * q), b1 = *(const LAS bf16x8*)(VT + ((2 * w + 1) * 16 + fr) * ML_TSTR + ks * 32 + 8 * q);
#pragma unroll
        for (int dt = 0; dt < 8; ++dt) { const bf16x8 a = *(const LAS bf16x8*)(KWT + (dt * 16 + fr) * ML_TSTR + ks * 32 + 8 * q);
            acc[dt][0] = MMA(a, b0, acc[dt][0]); acc[dt][1] = MMA(a, b1, acc[dt][1]); }
    }
}
DI void mlstm_n_update(Ctx& C, float decay, int tid) {
    if (tid < 128) { LAS float* NS = (LAS float*)(C.lds + ML_NS); const LAS bf16* KWT = (const LAS bf16*)(C.lds + ML_KWT); float s = 0.f;
#pragma unroll
        for (int i = 0; i < 8; ++i) { const u32x4 a = *(const LAS u32x4*)(KWT + tid * ML_TSTR + 8 * i); s += (bflo(a.x) + bfhi(a.x)) + (bflo(a.y) + bfhi(a.y)) + (bflo(a.z) + bfhi(a.z)) + (bflo(a.w) + bfhi(a.w)); }
        NS[tid] = decay * NS[tid] + s; }
}

DI void mlstm_m1(Ctx& C, int mj) {
    const bf16* proj = WSP(bf16, WS_PROJ);
    LAS float* AP = (LAS float*)(C.lds + ML_AP); LAS float* FL = (LAS float*)(C.lds + ML_FL); LAS float* MR = (LAS float*)(C.lds + ML_MR); LAS float* NS = (LAS float*)(C.lds + ML_NS);
    LAS float* CW = (LAS float*)(C.lds + ML_CW); LAS bf16* KWT = (LAS bf16*)(C.lds + ML_KWT);
    const int wave = C.wave;
    for (int item = C.vcu; item < 8 * M_NSEG; item += C.G) {
        const int bh = item / M_NSEG, seg = item % M_NSEG, b = bh >> 2, h = bh & 3; const size_t tok_seg = (size_t)b * SEQ + seg * M_SEGT;
        __syncthreads();
        mlstm_load_cw(C, mj, h);
        if (C.tid < 128) NS[C.tid] = 0.f;
        mlstm_seg_scalars(C, mj, bh, seg);
        f32x4 acc[8][2];
#pragma unroll
        for (int dt = 0; dt < 8; ++dt) { acc[dt][0] = (f32x4){0.f, 0.f, 0.f, 0.f}; acc[dt][1] = (f32x4){0.f, 0.f, 0.f, 0.f}; }
        for (int c = 0; c < M_SEGC; ++c) {
            int tz = threadIdx.x; asm volatile("" : "+v"(tz)); const int lane = tz & 63;
            const float mnew = MR[64 * c + 63], mold = (c == 0) ? -1.0e30f : MR[64 * c - 1];
            const float decay = __expf(mold - mnew);
            { const int s = lane; const float wgt = __expf(AP[64 * c + s] - mnew); float o[16];
              mlstm_conv16(proj, tok_seg + 64 * c + s, seg * M_SEGT + 64 * c + s, 512 + h * 128 + wave * 16, CW + 640 + wave * 16, o);
#pragma unroll
              for (int dd = 0; dd < 16; ++dd) KWT[(wave * 16 + dd) * ML_TSTR + s] = (bf16)f2bf(o[dd] * 0.08838834764831845f * wgt); }
            mlstm_load_vt(C, proj, tok_seg + 64 * c, h, lane);
            __syncthreads();
            mlstm_n_update(C, decay, tz);
            mlstm_state_update(C, acc, decay, lane);
            __syncthreads();
        }
        float* dst = WSP(float, WS_SLOC) + (size_t)item * M_STATE;
#pragma unroll
        for (int dt = 0; dt < 8; ++dt)
#pragma unroll
            for (int vtl = 0; vtl < 2; ++vtl)
#pragma unroll
                for (int r = 0; r < 4; ++r) dst[(((wave * 8 + dt) * 2 + vtl) * 4 + r) * 64 + C.lane] = acc[dt][vtl][r];
        if (C.tid < 128) dst[32768 + C.tid] = NS[C.tid];
        if (C.tid == 0) { WSP(float, WS_SEGF)[item] = FL[511]; WSP(float, WS_SEGM)[item] = MR[511]; }
    }
}
DI void mlstm_m15(Ctx& C) {
    LAS float* DEC = (LAS float*)C.lds; LAS float* SCL = DEC + 256;
    __syncthreads();
    if (C.tid < 8) { const int bh = C.tid; float F0 = 0.f, M0 = 0.f;
        for (int seg = 0; seg < M_NSEG; ++seg) { const float cand = WSP(float, WS_SEGM)[bh * M_NSEG + seg] - F0, mn = fmaxf(M0, cand);
            DEC[bh * 32 + seg] = __expf(M0 - mn); SCL[bh * 32 + seg] = __expf(cand - mn); F0 += WSP(float, WS_SEGF)[bh * M_NSEG + seg]; M0 = mn; } }
    __syncthreads();
    const int gt = C.vcu * 512 + C.tid, NGT = C.G * 512;
    for (int i = gt; i < 8 * M_STATE; i += NGT) { const int bh = i / M_STATE, e = i % M_STATE; float s = 0.f;
        const float* src = WSP(float, WS_SLOC) + (size_t)bh * M_NSEG * M_STATE + e; float* dst = WSP(float, WS_SINIT) + (size_t)bh * M_NSEG * M_STATE + e;
        for (int seg = 0; seg < M_NSEG; ++seg) { dst[(size_t)seg * M_STATE] = s; s = s * DEC[bh * 32 + seg] + SCL[bh * 32 + seg] * src[(size_t)seg * M_STATE]; } }
}
DI void mlstm_m2(Ctx& C, int mj) {
    const bf16* proj = WSP(bf16, WS_PROJ);
    LAS bf16* QS = (LAS bf16*)(C.lds + ML_QS); LAS bf16* KS = (LAS bf16*)(C.lds + ML_KS); LAS bf16* VT = (LAS bf16*)(C.lds + ML_VT); LAS bf16* KWT = (LAS bf16*)(C.lds + ML_KWT);
    LAS bf16* WM = (LAS bf16*)(C.lds + ML_WM); LAS bf16* HOUT = (LAS bf16*)(C.lds + ML_QS);
    LAS float* CW = (LAS float*)(C.lds + ML_CW); LAS float* AP = (LAS float*)(C.lds + ML_AP); LAS float* FL = (LAS float*)(C.lds + ML_FL); LAS float* MR = (LAS float*)(C.lds + ML_MR);
    LAS float* AG = (LAS float*)(C.lds + ML_CH); LAS float* MG = AG + 64; LAS float* FAC = AG + 128; LAS float* EMT = AG + 192; LAS float* DEN = AG + 256; LAS float* QN = AG + 320;
    LAS float* NS = (LAS float*)(C.lds + ML_NS); LAS f32x2* STP = (LAS f32x2*)(C.lds + ML_STP); LAS f32x2* MRS = (LAS f32x2*)(C.lds + ML_MRS); LAS float* TMP = (LAS float*)(C.lds + ML_TMP);
    const int wave = C.wave;
    for (int item = C.vcu; item < 8 * M_NSEG; item += C.G) {
        const int bh = item / M_NSEG, seg = item % M_NSEG, b = bh >> 2, h = bh & 3; const size_t tok_seg = (size_t)b * SEQ + seg * M_SEGT;
        __syncthreads();
        mlstm_load_cw(C, mj, h);
        if (C.tid == 0) { float F0 = 0.f, M0 = 0.f;
            for (int sg = 0; sg < seg; ++sg) { M0 = fmaxf(M0, WSP(float, WS_SEGM)[bh * M_NSEG + sg] - F0); F0 += WSP(float, WS_SEGF)[bh * M_NSEG + sg]; }
            TMP[32] = F0; TMP[33] = M0; }
        mlstm_seg_scalars(C, mj, bh, seg);
        const float Fseg0 = TMP[32], Mseg0 = TMP[33];
        f32x4 acc[8][2];
        { const float* src = WSP(float, WS_SINIT) + (size_t)item * M_STATE;
#pragma unroll
          for (int dt = 0; dt < 8; ++dt)
#pragma unroll
              for (int vtl = 0; vtl < 2; ++vtl)
#pragma unroll
                  for (int r = 0; r < 4; ++r) acc[dt][vtl][r] = src[(((wave * 8 + dt) * 2 + vtl) * 4 + r) * 64 + C.lane];
          if (C.tid < 128) NS[C.tid] = src[32768 + C.tid]; }
        for (int c = 0; c < M_SEGC; ++c) {
            int tz = threadIdx.x; asm volatile("" : "+v"(tz)); const int tid = tz, lane = tz & 63, fr = lane & 15, q = lane >> 4;
            const size_t tok0 = tok_seg + 64 * c;
            const float Mc0 = (c == 0) ? Mseg0 : fmaxf(Mseg0, MR[64 * c - 1] - Fseg0);
            const float Mend = fmaxf(Mseg0, MR[64 * c + 63] - Fseg0);
            const float decay = __expf(Mc0 - Mend);
            { const int s = lane; const float ag = AP[64 * c + s] - Fseg0; const float wgt = __expf(ag - Mend); float o[16];
              if (wave == 0) { const float mt = fmaxf(Mseg0, MR[64 * c + s] - Fseg0); AG[s] = ag; MG[s] = mt; FAC[s] = __expf(Mc0 - mt); EMT[s] = __expf(-(Fseg0 + FL[64 * c + s] + mt)); DEN[s] = 0.f; }
              mlstm_conv16(proj, tok0 + s, seg * M_SEGT + 64 * c + s, h * 128 + wave * 16, CW + wave * 16, o);
              { u32x4 w0, w1; w0.x = pk2(o[0], o[1]); w0.y = pk2(o[2], o[3]); w0.z = pk2(o[4], o[5]); w0.w = pk2(o[6], o[7]); w1.x = pk2(o[8], o[9]); w1.y = pk2(o[10], o[11]); w1.z = pk2(o[12], o[13]); w1.w = pk2(o[14], o[15]);
                *(LAS u32x4*)(QS + s * ML_QSTR + wave * 16) = w0; *(LAS u32x4*)(QS + s * ML_QSTR + wave * 16 + 8) = w1; }
              asm volatile("" ::: "memory");
              mlstm_conv16(proj, tok0 + s, seg * M_SEGT + 64 * c + s, 512 + h * 128 + wave * 16, CW + 640 + wave * 16, o);
#pragma unroll
              for (int dd = 0; dd < 16; ++dd) o[dd] *= 0.08838834764831845f;
              { u32x4 w0, w1; w0.x = pk2(o[0], o[1]); w0.y = pk2(o[2], o[3]); w0.z = pk2(o[4], o[5]); w0.w = pk2(o[6], o[7]); w1.x = pk2(o[8], o[9]); w1.y = pk2(o[10], o[11]); w1.z = pk2(o[12], o[13]); w1.w = pk2(o[14], o[15]);
                *(LAS u32x4*)(KS + s * ML_QSTR + wave * 16) = w0; *(LAS u32x4*)(KS + s * ML_QSTR + wave * 16 + 8) = w1; }
#pragma unroll
              for (int dd = 0; dd < 16; ++dd) KWT[(wave * 16 + dd) * ML_TSTR + s] = (bf16)f2bf(o[dd] * wgt); }
            asm volatile("" ::: "memory");
            mlstm_load_vt(C, proj, tok0, h, lane);
            __syncthreads();
            { const int tt = wave >> 1, st0 = (wave & 1) * 2; f32x4 d0 = {0.f, 0.f, 0.f, 0.f}, d1 = {0.f, 0.f, 0.f, 0.f};
#pragma unroll
              for (int ks = 0; ks < 4; ++ks) { const bf16x8 a = *(const LAS bf16x8*)(QS + (tt * 16 + fr) * ML_QSTR + ks * 32 + 8 * q);
                  const bf16x8 b0 = *(const LAS bf16x8*)(KS + (st0 * 16 + fr) * ML_QSTR + ks * 32 + 8 * q), b1 = *(const LAS bf16x8*)(KS + ((st0 + 1) * 16 + fr) * ML_QSTR + ks * 32 + 8 * q);
                  d0 = MMA(a, b0, d0); d1 = MMA(a, b1, d1); }
              const int s0 = st0 * 16 + fr, s1 = s0 + 16; const float a0 = AG[s0], a1 = AG[s1];
#pragma unroll
              for (int r = 0; r < 4; ++r) { const int t = tt * 16 + 4 * q + r; const float mt = MG[t];
                  const float w0 = (s0 <= t) ? __expf(a0 - mt) * d0[r] : 0.f, w1 = (s1 <= t) ? __expf(a1 - mt) * d1[r] : 0.f;
                  WM[t * ML_TSTR + s0] = (bf16)f2bf(w0); WM[t * ML_TSTR + s1] = (bf16)f2bf(w1);
                  float ps = w0 + w1; ps += __shfl_xor(ps, 1); ps += __shfl_xor(ps, 2); ps += __shfl_xor(ps, 4); ps += __shfl_xor(ps, 8);
                  if (fr == 0) __hip_atomic_fetch_add(DEN + t, ps, __ATOMIC_RELAXED, __HIP_MEMORY_SCOPE_WORKGROUP); } }
            { const int t = tid >> 3, part = tid & 7; float s = 0.f;
              const u32x4 a = *(const LAS u32x4*)(QS + t * ML_QSTR + part * 16), b2 = *(const LAS u32x4*)(QS + t * ML_QSTR + part * 16 + 8); const LAS float* np = NS + part * 16;
              s += bflo(a.x) * np[0] + bfhi(a.x) * np[1] + bflo(a.y) * np[2] + bfhi(a.y) * np[3] + bflo(a.z) * np[4] + bfhi(a.z) * np[5] + bflo(a.w) * np[6] + bfhi(a.w) * np[7];
              s += bflo(b2.x) * np[8] + bfhi(b2.x) * np[9] + bflo(b2.y) * np[10] + bfhi(b2.y) * np[11] + bflo(b2.z) * np[12] + bfhi(b2.z) * np[13] + bflo(b2.w) * np[14] + bfhi(b2.w) * np[15];
              s += __shfl_xor(s, 1); s += __shfl_xor(s, 2); s += __shfl_xor(s, 4);
              if (part == 0) QN[t] = s; }
            __syncthreads();
            f32x4 num[4][2];
#pragma unroll
            for (int tt = 0; tt < 4; ++tt) { num[tt][0] = (f32x4){0.f, 0.f, 0.f, 0.f}; num[tt][1] = (f32x4){0.f, 0.f, 0.f, 0.f}; }
#pragma unroll
            for (int ks = 0; ks < 4; ++ks) {
                u32x4 p0, p1;
                p0.x = pk2(acc[2 * ks][0][0], acc[2 * ks][0][1]); p0.y = pk2(acc[2 * ks][0][2], acc[2 * ks][0][3]); p0.z = pk2(acc[2 * ks + 1][0][0], acc[2 * ks + 1][0][1]); p0.w = pk2(acc[2 * ks + 1][0][2], acc[2 * ks + 1][0][3]);
                p1.x = pk2(acc[2 * ks][1][0], acc[2 * ks][1][1]); p1.y = pk2(acc[2 * ks][1][2], acc[2 * ks][1][3]); p1.z = pk2(acc[2 * ks + 1][1][0], acc[2 * ks + 1][1][1]); p1.w = pk2(acc[2 * ks + 1][1][2], acc[2 * ks + 1][1][3]);
                const bf16x8 b0 = __builtin_bit_cast(bf16x8, p0), b1 = __builtin_bit_cast(bf16x8, p1);
#pragma unroll
                for (int tt = 0; tt < 4; ++tt) { const LAS bf16* qp = QS + (tt * 16 + fr) * ML_QSTR + 4 * q;
                    const u32x2 lo = *(const LAS u32x2*)(qp + (2 * ks) * 16), hi = *(const LAS u32x2*)(qp + (2 * ks + 1) * 16);
                    u32x4 av; av.x = lo.x; av.y = lo.y; av.z = hi.x; av.w = hi.y; const bf16x8 a = __builtin_bit_cast(bf16x8, av);
                    num[tt][0] = MMA(a, b0, num[tt][0]); num[tt][1] = MMA(a, b1, num[tt][1]); }
            }
#pragma unroll
            for (int tt = 0; tt < 4; ++tt)
#pragma unroll
                for (int r = 0; r < 4; ++r) { const float f = FAC[tt * 16 + 4 * q + r]; num[tt][0][r] *= f; num[tt][1][r] *= f; }
#pragma unroll
            for (int ks = 0; ks < 2; ++ks) {
                const bf16x8 b0 = *(const LAS bf16x8*)(VT + ((2 * wave) * 16 + fr) * ML_TSTR + ks * 32 + 8 * q), b1 = *(const LAS bf16x8*)(VT + ((2 * wave + 1) * 16 + fr) * ML_TSTR + ks * 32 + 8 * q);
#pragma unroll
                for (int tt = 0; tt < 4; ++tt) { const bf16x8 a = *(const LAS bf16x8*)(WM + (tt * 16 + fr) * ML_TSTR + ks * 32 + 8 * q);
                    num[tt][0] = MMA(a, b0, num[tt][0]); num[tt][1] = MMA(a, b1, num[tt][1]); }
            }
#pragma unroll
            for (int tt = 0; tt < 4; ++tt)
#pragma unroll
                for (int r = 0; r < 4; ++r) { const int t = tt * 16 + 4 * q + r; const float den = DEN[t] + FAC[t] * QN[t]; const float inv = 1.0f / fmaxf(fabsf(den), EMT[t]);
                    const float h0 = num[tt][0][r] * inv, h1 = num[tt][1][r] * inv; num[tt][0][r] = h0; num[tt][1][r] = h1;
                    float s1 = h0 + h1, s2 = h0 * h0 + h1 * h1;
                    s1 += __shfl_xor(s1, 1); s2 += __shfl_xor(s2, 1); s1 += __shfl_xor(s1, 2); s2 += __shfl_xor(s2, 2); s1 += __shfl_xor(s1, 4); s2 += __shfl_xor(s2, 4); s1 += __shfl_xor(s1, 8); s2 += __shfl_xor(s2, 8);
                    if (fr == 0) STP[t * 8 + wave] = (f32x2){s1, s2}; }
            mlstm_n_update(C, decay, tid);
            mlstm_state_update(C, acc, decay, lane);
            __syncthreads();
            if (tid < 64) { float s1 = 0.f, s2 = 0.f;
#pragma unroll
                for (int w = 0; w < 8; ++w) { const f32x2 p = STP[tid * 8 + w]; s1 += p.x; s2 += p.y; }
                const float mean = s1 * (1.0f / 256.0f), var = fmaxf(s2 * (1.0f / 256.0f) - mean * mean, 0.f); MRS[tid] = (f32x2){mean, 1.0f / sqrtf(var + LN_EPS)}; }
            __syncthreads();
#pragma unroll
            for (int tt = 0; tt < 4; ++tt)
#pragma unroll
                for (int r = 0; r < 4; ++r) { const int t = tt * 16 + 4 * q + r; const f32x2 mr = MRS[t];
                    HOUT[t * ML_HSTR + (2 * wave) * 16 + fr] = (bf16)f2bf((num[tt][0][r] - mr.x) * mr.y); HOUT[t * ML_HSTR + (2 * wave + 1) * 16 + fr] = (bf16)f2bf((num[tt][1][r] - mr.x) * mr.y); }
            __syncthreads();
            { const int t = tid >> 3, c8 = tid & 7; const float* ng = C.in[12] + (size_t)mj * 1024 + h * 256;
#pragma unroll
              for (int jj = 0; jj < 4; ++jj) { const int col = (c8 + 8 * jj) * 8;
                  const u32x4 hv = *(const LAS u32x4*)(HOUT + t * ML_HSTR + col); const u32x4 ov = *(const u32x4*)(proj + (tok0 + t) * M_NIN + 2048 + h * 256 + col);
                  const f32x4 g0 = *(const f32x4*)(ng + col), g1 = *(const f32x4*)(ng + col + 4);
                  u32x4 w;
                  w.x = pk2(bflo(hv.x) * g0.x * sigmoidf_(bflo(ov.x)), bfhi(hv.x) * g0.y * sigmoidf_(bfhi(ov.x))); w.y = pk2(bflo(hv.y) * g0.z * sigmoidf_(bflo(ov.y)), bfhi(hv.y) * g0.w * sigmoidf_(bfhi(ov.y)));
                  w.z = pk2(bflo(hv.z) * g1.x * sigmoidf_(bflo(ov.z)), bfhi(hv.z) * g1.y * sigmoidf_(bfhi(ov.z))); w.w = pk2(bflo(hv.w) * g1.z * sigmoidf_(bflo(ov.w)), bfhi(hv.w) * g1.w * sigmoidf_(bfhi(ov.w)));
                  *(u32x4*)(WSP(bf16, WS_MIXA) + (tok0 + t) * D + h * 256 + col) = w; } }
            __syncthreads();
        }
    }
}

constexpr int S5_BUSTR = 132, S5_XSTR = 136, S5_WAVE_LDS = 16 * S5_BUSTR * 4 + 16 * S5_XSTR * 2;
static_assert(8 * S5_WAVE_LDS <= RING_BYTES, "s5 LDS");
DI float gelu_tanh(float x) { const float z = 0.7978845608028654f * (x + 0.044715f * x * x * x); return x * (1.0f - 1.0f / (1.0f + __expf(2.0f * z))); }

template <int PASS> DI void s5_pass(Ctx& C) {
    const int lane = C.lane, wave = C.wave, fr = lane & 15, q = lane >> 4;
    LAS float* BU = (LAS float*)(C.lds + wave * S5_WAVE_LDS); LAS bf16* XS = (LAS bf16*)(C.lds + wave * S5_WAVE_LDS + 16 * S5_BUSTR * 4);
    const bf16* U = WSP(bf16, WS_PROJ);
    for (int wi = C.vcu; wi < 2 * S5_NSEG * 8; wi += C.G) {
        const int g = (wi & 7) * 8 + wave, bs = wi >> 3, b = bs / S5_NSEG, seg = bs % S5_NSEG; const size_t tokbase = (size_t)b * SEQ + seg * S5_SEGT;
        const float ar = WSP(float, WS_S5ABAR)[(g * 64 + lane) * 2], ai = WSP(float, WS_S5ABAR)[(g * 64 + lane) * 2 + 1];
        bf16x8 bB[8];
#pragma unroll
        for (int nt = 0; nt < 8; ++nt) { bB[nt] = (bf16x8){0, 0, 0, 0, 0, 0, 0, 0}; if (q < 2) bB[nt] = *(const bf16x8*)(WSP(bf16, WS_S5BBT) + ((size_t)g * 128 + nt * 16 + fr) * 16 + 8 * q); }
        bf16x8 cB[4]; float xr = 0.f, xi = 0.f, dsk = 0.f;
        if constexpr (PASS == 2) {
#pragma unroll
            for (int ks = 0; ks < 4; ++ks) cB[ks] = *(const bf16x8*)(WSP(bf16, WS_S5CMT) + ((size_t)g * 16 + fr) * 128 + ks * 32 + 8 * q);
            dsk = C.in[22][g * 16 + fr];
            if (seg > 0) { const float dt = expf(C.in[17][g]), lr = C.in[15][g * 64 + lane], li = C.in[16][g * 64 + lane];
                const float mg = expf(lr * dt * (float)S5_SEGT); float sn, cs; sincosf(li * dt * (float)S5_SEGT, &sn, &cs); const float pr = mg * cs, pi = mg * sn;
                const float* en = WSP(float, WS_S5END) + (((size_t)b * 64 + g) * S5_NSEG) * 128 + lane * 2;
                for (int sp = 0; sp < seg; ++sp) { const float er = en[sp * 128], ei = en[sp * 128 + 1]; const float nr = pr * xr - pi * xi + er, ni = pr * xi + pi * xr + ei; xr = nr; xi = ni; } }
        }
        for (int sub = 0; sub < S5_SEGT / 16; ++sub) {
            const size_t tok0 = tokbase + sub * 16;
            bf16x8 a = (bf16x8){0, 0, 0, 0, 0, 0, 0, 0};
            if (q < 2) a = *(const bf16x8*)(U + (tok0 + fr) * D + g * 16 + 8 * q);
#pragma unroll
            for (int nt = 0; nt < 8; ++nt) { const f32x4 d = MMA(a, bB[nt], (f32x4){0.f, 0.f, 0.f, 0.f});
#pragma unroll
                for (int r = 0; r < 4; ++r) BU[(4 * q + r) * S5_BUSTR + nt * 16 + fr] = d[r]; }
            asm volatile("s_waitcnt lgkmcnt(0)" ::: "memory");
#pragma unroll
            for (int t = 0; t < 16; ++t) { const float br = BU[t * S5_BUSTR + lane], bi = BU[t * S5_BUSTR + 64 + lane];
                const float nr = ar * xr - ai * xi + br, ni = ar * xi + ai * xr + bi; xr = nr; xi = ni;
                if constexpr (PASS == 2) { XS[t * S5_XSTR + lane] = (bf16)f2bf(xr); XS[t * S5_XSTR + 64 + lane] = (bf16)f2bf(xi); } }
            if constexpr (PASS == 2) {
                asm volatile("s_waitcnt lgkmcnt(0)" ::: "memory");
                f32x4 y = {0.f, 0.f, 0.f, 0.f};
#pragma unroll
                for (int ks = 0; ks < 4; ++ks) { const bf16x8 xa = *(const LAS bf16x8*)(XS + fr * S5_XSTR + ks * 32 + 8 * q); y = MMA(xa, cB[ks], y); }
#pragma unroll
                for (int r = 0; r < 4; ++r) { const size_t o = (tok0 + 4 * q + r) * D + g * 16 + fr; const float uv = bf2f(U[o]);
                    WSP(bf16, WS_MIXA)[o] = (bf16)f2bf(gelu_tanh(y[r] + dsk * uv)); }
            }
            asm volatile("s_waitcnt lgkmcnt(0)" ::: "memory");
        }
        if constexpr (PASS == 1) { float* en = WSP(float, WS_S5END) + ((((size_t)b * 64 + g) * S5_NSEG) + seg) * 128 + lane * 2; en[0] = xr; en[1] = xi; }
    }
}

constexpr int AT_KSTR = 72, AT_VSTR = 200, AT_KS = 0, AT_VT = 192 * AT_KSTR * 2, AT_END = AT_VT + 64 * AT_VSTR * 2;
static_assert(AT_END <= RING_BYTES, "attn LDS");
DI void swa_phase(Ctx& C) {
    const bf16* QKV = WSP(bf16, WS_PROJ);
    LAS bf16* KS = (LAS bf16*)(C.lds + AT_KS); LAS bf16* VT = (LAS bf16*)(C.lds + AT_VT);
    const int lane = C.lane, wave = C.wave, tid = C.tid, fr = lane & 15, q = lane >> 4;
    for (int item = C.vcu; item < BATCH * A_KV * (SEQ / 64); item += C.G) {
        const int qb = item % (SEQ / 64), kvh = (item / (SEQ / 64)) % A_KV, b = item / ((SEQ / 64) * A_KV); const int q0 = qb * 64; const size_t tokb = (size_t)b * SEQ;
        __syncthreads();
#pragma unroll
        for (int i = 0; i < 3; ++i) { const int kk = (tid >> 3) + 64 * i, ch = tid & 7, kp = q0 - 128 + kk; u32x4 v = {0u, 0u, 0u, 0u};
            if (kp >= 0) v = *(const u32x4*)(QKV + (tokb + kp) * A_NQKV + 1024 + kvh * 64 + ch * 8);
            *(LAS u32x4*)(KS + kk * AT_KSTR + ch * 8) = v; }
#pragma unroll
        for (int i = 0; i < 3; ++i) { const int kk = lane + 64 * i, kp = q0 - 128 + kk; u32x4 v = {0u, 0u, 0u, 0u};
            if (kp >= 0) v = *(const u32x4*)(QKV + (tokb + kp) * A_NQKV + 1280 + kvh * 64 + wave * 8);
            const unsigned w[4] = {v.x, v.y, v.z, v.w};
#pragma unroll
            for (int e = 0; e < 4; ++e) { VT[(wave * 8 + 2 * e) * AT_VSTR + kk] = (bf16)(w[e] & 0xffffu); VT[(wave * 8 + 2 * e + 1) * AT_VSTR + kk] = (bf16)(w[e] >> 16); } }
        __syncthreads();
        const int g = wave >> 1, head = kvh * 4 + g; const float sink = C.in[26][head];
#pragma unroll 1
        for (int rt = 0; rt < 2; ++rt) {
            const int r0 = (wave & 1) * 32 + rt * 16, kt0 = r0 >> 4; const size_t tq = tokb + q0 + r0 + fr;
            const bf16x8 qf0 = *(const bf16x8*)(QKV + tq * A_NQKV + head * 64 + 8 * q), qf1 = *(const bf16x8*)(QKV + tq * A_NQKV + head * 64 + 32 + 8 * q);
            f32x4 s[9];
#pragma unroll
            for (int kt = 0; kt < 9; ++kt) { const LAS bf16* kp_ = KS + ((kt0 + kt) * 16 + fr) * AT_KSTR + 8 * q;
                s[kt] = MMA(*(const LAS bf16x8*)kp_, qf0, (f32x4){0.f, 0.f, 0.f, 0.f}); s[kt] = MMA(*(const LAS bf16x8*)(kp_ + 32), qf1, s[kt]); }
            float m = sink;
#pragma unroll
            for (int kt = 0; kt < 9; ++kt)
#pragma unroll
                for (int r = 0; r < 4; ++r) { const int kk = (kt0 + kt) * 16 + 4 * q + r; const bool ok = (kk > r0 + fr) && (kk <= r0 + fr + 128) && (q0 - 128 + kk >= 0);
                    s[kt][r] = ok ? s[kt][r] * 0.125f : -3.0e38f; m = fmaxf(m, s[kt][r]); }
            m = fmaxf(m, __shfl_xor(m, 16)); m = fmaxf(m, __shfl_xor(m, 32));
            float l = 0.f;
#pragma unroll
            for (int kt = 0; kt < 9; ++kt)
#pragma unroll
                for (int r = 0; r < 4; ++r) { const float p = __expf(s[kt][r] - m); s[kt][r] = p; l += p; }
            l += __shfl_xor(l, 16); l += __shfl_xor(l, 32);
            const float inv = 1.0f / (l + __expf(sink - m));
            f32x4 o[4];
#pragma unroll
            for (int dt = 0; dt < 4; ++dt) o[dt] = (f32x4){0.f, 0.f, 0.f, 0.f};
#pragma unroll
            for (int pr = 0; pr < 5; ++pr) { const int ka = 2 * pr, kb = 2 * pr + 1;
                u32x4 pw; pw.x = pk2(s[ka][0] * inv, s[ka][1] * inv); pw.y = pk2(s[ka][2] * inv, s[ka][3] * inv);
                if (kb < 9) { pw.z = pk2(s[kb < 9 ? kb : 8][0] * inv, s[kb < 9 ? kb : 8][1] * inv); pw.w = pk2(s[kb < 9 ? kb : 8][2] * inv, s[kb < 9 ? kb : 8][3] * inv); } else { pw.z = 0u; pw.w = 0u; }
                const bf16x8 pb = __builtin_bit_cast(bf16x8, pw);
#pragma unroll
                for (int dt = 0; dt < 4; ++dt) { const LAS bf16* vp = VT + (dt * 16 + fr) * AT_VSTR + 4 * q;
                    const u32x2 lo = *(const LAS u32x2*)(vp + (kt0 + ka) * 16); u32x2 hi = {0u, 0u}; if (kb < 9) hi = *(const LAS u32x2*)(vp + (kt0 + (kb < 9 ? kb : 8)) * 16);
                    u32x4 av; av.x = lo.x; av.y = lo.y; av.z = hi.x; av.w = hi.y;
                    o[dt] = MMA(__builtin_bit_cast(bf16x8, av), pb, o[dt]); } }
            bf16* orow = WSP(bf16, WS_MIXA) + tq * D + head * 64 + 4 * q;
#pragma unroll
            for (int dt = 0; dt < 4; ++dt) { u32x2 w; w.x = pk2(o[dt][0], o[dt][1]); w.y = pk2(o[dt][2], o[dt][3]); *(u32x2*)(orow + dt * 16) = w; }
        }
    }
}

template <class Epi> DI void dense_gemm(Ctx& C, const bf16* A, const bf16* Bt, int N, int K, const Epi& E) {
    pg8::Gemm g{A, Bt, T, N, K}; pg8::StaticOrder S; S.init(T, N, C.G, (int)blockIdx.x);
    pg8::gemm_phase<Epi, pg8::StaticOrder, true, true>(C.lds, g, S, E);
}
DI void moe_gemm1(Ctx& C, int layer) {
    const int nunits = moe_tables(C, layer);
    pg8::Gemm g{WSP(bf16, WS_BUFX), WSP(bf16, WS_W13) + (size_t)layer * N_EXP * D * D, MOE_P, D, D};
    pg8::MoeOrder S{(const LAS int*)(C.lds + MISC_OFF), C.G, (int)blockIdx.x, nunits};
    pg8::EpiPair<0> E{WSP(bf16, WS_HID), D_EXP, 3};
    pg8::gemm_phase<pg8::EpiPair<0>, pg8::MoeOrder, true, true>(C.lds, g, S, E);
}
DI void moe_gemm2(Ctx& C, int layer) {
    const int nunits = moe_tables(C, layer);
    pg8::Gemm g{WSP(bf16, WS_HID), WSP(bf16, WS_W2) + (size_t)layer * N_EXP * D * D_EXP, MOE_P, D, D_EXP};
    pg8::MoeOrder S{(const LAS int*)(C.lds + MISC_OFF), C.G, (int)blockIdx.x, nunits};
    pg8::EpiStore E{WSP(bf16, WS_YEXP), D, nullptr, 3};
    pg8::gemm_phase<pg8::EpiStore, pg8::MoeOrder, true, true>(C.lds, g, S, E);
}

constexpr int N_PHASES = 39;
struct Args { const float* in[35]; float* out; unsigned char* ws; int ph_lo, ph_hi, li, pad; };
__global__ void __launch_bounds__(512, 2) fwd(Args args) {
    extern __shared__ __attribute__((aligned(16))) unsigned char lds_raw[];
    Ctx C;
    C.lds = (LAS unsigned char*)lds_raw; C.ws = args.ws; C.ctl = (unsigned*)(args.ws + WS_CTL); C.out = args.out;
#pragma unroll
    for (int i = 0; i < 35; ++i) C.in[i] = args.in[i];
    C.tid = threadIdx.x; C.lane = C.tid & 63; C.wave = __builtin_amdgcn_readfirstlane(C.tid >> 6);
    C.G = gridDim.x; { const int bx = blockIdx.x; C.vcu = (C.G % 8 == 0) ? (bx % 8) * (C.G / 8) + bx / 8 : bx; }
    volatile LAS unsigned* xbw = (volatile LAS unsigned*)(C.lds + MISC_OFF + 512);
    if (C.tid < 4) xbw[C.tid] = 0u;
    __syncthreads();
    const int lo = args.ph_lo, hi = args.ph_hi;
    XcdBarrier bar; bar.bar = C.ctl + CW_BAR + args.li * XCD_BAR_WORDS; bar.x = 0; bar.st = xbw;
    if (hi - lo > 1) bar = xcd_barrier_post(C.ctl + CW_BAR + args.li * XCD_BAR_WORDS, xbw);
#ifdef PH_ONLY
#define IN(k) ((k) == PH_ONLY && lo <= (k) && (k) < hi)
#else
#define IN(k) (lo <= (k) && (k) < hi)
#endif
#define SEAM(k) do { if (IN(k) && IN((k) + 1)) xcd_barrier(bar); else __syncthreads(); } while (0)
    bf16* HIN = WSP(bf16, WS_HIN); bf16* PROJ = WSP(bf16, WS_PROJ); bf16* MIXA = WSP(bf16, WS_MIXA); bf16* YMIX = WSP(bf16, WS_YMIX);

    if (IN(0)) { p0a_weights(C); } SEAM(0);
    if (IN(1)) { row_phase<0, 1, true>(C, C.in[0], 0, 0, nullptr, nullptr, 0, 1, 0, 0); } SEAM(1);

    if (IN(2)) { pg8::EpiStore E{PROJ, M_NIN, nullptr, -1}; dense_gemm(C, HIN, WSP(bf16, WS_WMIN), M_NIN, D, E); } SEAM(2);
    if (IN(3)) { mlstm_m1(C, 0); } SEAM(3);
    if (IN(4)) { mlstm_m15(C); } SEAM(4);
    if (IN(5)) { mlstm_m2(C, 0); } SEAM(5);
    if (IN(6)) { pg8::EpiStore E{YMIX, D, nullptr, -1}; dense_gemm(C, MIXA, WSP(bf16, WS_WMOUT), D, D, E); } SEAM(6);
    if (IN(7)) { row_phase<1, 3, true>(C, C.in[0], 0, 2, C.in[4], C.in[5], 0, 4, 3, 0); } SEAM(7);
    if (IN(8)) { moe_scatter(C, 0); } SEAM(8);
    if (IN(9)) { moe_gemm1(C, 0); } SEAM(9);
    if (IN(10)) { moe_gemm2(C, 0); } SEAM(10);
    if (IN(11)) { row_phase<2, 0, true>(C, C.out, 0, 5, C.in[6], C.in[7], 1, 1, 0, 0); } SEAM(11);

    if (IN(12)) { pg8::EpiStore E{PROJ, D, nullptr, -1}; dense_gemm(C, HIN, WSP(bf16, WS_WS5IN), D, D, E); } SEAM(12);
    if (IN(13)) { s5_pass<1>(C); } SEAM(13);
    if (IN(14)) { s5_pass<2>(C); } SEAM(14);
    if (IN(15)) { pg8::EpiPair<1> E{YMIX, D, -1}; dense_gemm(C, MIXA, WSP(bf16, WS_WS5GLU), 2 * D, D, E); } SEAM(15);
    if (IN(16)) { row_phase<1, 3, true>(C, C.out, 1, 2, C.in[4] + D, C.in[5] + D, 1, 4, 3, 0); } SEAM(16);
    if (IN(17)) { moe_scatter(C, 1); } SEAM(17);
    if (IN(18)) { moe_gemm1(C, 1); } SEAM(18);
    if (IN(19)) { moe_gemm2(C, 1); } SEAM(19);
    if (IN(20)) { row_phase<2, 0, true>(C, C.out, 1, 5, C.in[6] + D, C.in[7] + D, 2, 1, 0, 0); } SEAM(20);

    if (IN(21)) { pg8::EpiStore E{PROJ, A_NQKV, C.in[25], -1}; dense_gemm(C, HIN, WSP(bf16, WS_WQKV), A_NQKV, D, E); } SEAM(21);
    if (IN(22)) { swa_phase(C); } SEAM(22);
    if (IN(23)) { pg8::EpiStore E{YMIX, D, nullptr, -1}; dense_gemm(C, MIXA, WSP(bf16, WS_WWO), D, D, E); } SEAM(23);
    if (IN(24)) { row_phase<1, 3, true>(C, C.out, 2, 2, C.in[4] + 2 * D, C.in[5] + 2 * D, 2, 4, 3, 0); } SEAM(24);
    if (IN(25)) { moe_scatter(C, 2); } SEAM(25);
    if (IN(26)) { moe_gemm1(C, 2); } SEAM(26);
    if (IN(27)) { moe_gemm2(C, 2); } SEAM(27);
    if (IN(28)) { row_phase<2, 1, true>(C, C.out, 2, 5, C.in[6] + 2 * D, C.in[7] + 2 * D, 3, 1, 0, 1); } SEAM(28);

    if (IN(29)) { pg8::EpiStore E{PROJ, M_NIN, nullptr, -1}; dense_gemm(C, HIN, WSP(bf16, WS_WMIN) + (size_t)M_NIN * D, M_NIN, D, E); } SEAM(29);
    if (IN(30)) { mlstm_m1(C, 1); } SEAM(30);
    if (IN(31)) { mlstm_m15(C); } SEAM(31);
    if (IN(32)) { mlstm_m2(C, 1); } SEAM(32);
    if (IN(33)) { pg8::EpiStore E{YMIX, D, nullptr, -1}; dense_gemm(C, MIXA, WSP(bf16, WS_WMOUT) + (size_t)D * D, D, D, E); } SEAM(33);
    if (IN(34)) { row_phase<1, 3, true>(C, C.out, 3, 2, C.in[4] + 3 * D, C.in[5] + 3 * D, 3, 4, 3, 0); } SEAM(34);
    if (IN(35)) { moe_scatter(C, 3); } SEAM(35);
    if (IN(36)) { moe_gemm1(C, 3); } SEAM(36);
    if (IN(37)) { moe_gemm2(C, 3); } SEAM(37);
    if (IN(38)) { row_phase<2, 0, false>(C, C.out, 3, 5, C.in[6] + 3 * D, C.in[7] + 3 * D, 0, 0, 0, 0); }
#undef IN
#undef SEAM
}

#ifndef MK_LAUNCH_PER_PHASE
#define MK_LAUNCH_PER_PHASE 0
#endif
extern "C" void kernel_launch(void* const* d_in, const int* in_sizes, int n_in, void* d_out, int out_size, void* d_ws, size_t ws_size, hipStream_t stream) {
    static int grid = 0;
    if (grid == 0) {
        if (n_in != 35 || out_size != T * D || ws_size < WS_END) { fprintf(stderr, "kernel_launch: unexpected shapes (n_in %d, out %d, ws %zu < %zu)\n", n_in, out_size, ws_size, (size_t)WS_END); grid = -1; return; }
        int dev = 0, cus = 0, per_cu = 0;
        if (hipGetDevice(&dev) != hipSuccess || hipDeviceGetAttribute(&cus, hipDeviceAttributeMultiprocessorCount, dev) != hipSuccess) { grid = -1; return; }
        if (hipFuncSetAttribute((const void*)fwd, hipFuncAttributeMaxDynamicSharedMemorySize, LDS_BYTES) != hipSuccess) { fprintf(stderr, "kernel_launch: hipFuncSetAttribute failed\n"); grid = -1; return; }
        if (hipOccupancyMaxActiveBlocksPerMultiprocessor(&per_cu, (const void*)fwd, 512, LDS_BYTES) != hipSuccess || per_cu < 1) fprintf(stderr, "kernel_launch: occupancy query says %d\n", per_cu);
        (void)hipGetLastError();
        grid = cus;
    }
    if (grid < 0) return;
    (void)hipMemsetAsync((char*)d_ws + WS_CTL, 0, CTL_ZERO_BYTES, stream);
    Args a{};
    for (int i = 0; i < 35; ++i) a.in[i] = (const float*)d_in[i];
    a.out = (float*)d_out; a.ws = (unsigned char*)d_ws;
#if MK_LAUNCH_PER_PHASE
    for (int p = 0; p < N_PHASES; ++p) { a.ph_lo = p; a.ph_hi = p + 1; a.li = 0; hipLaunchKernelGGL(fwd, dim3(grid), dim3(512), LDS_BYTES, stream, a); }
#else
    a.ph_lo = 0; a.ph_hi = N_PHASES; a.li = 0;
    hipLaunchKernelGGL(fwd, dim3(grid), dim3(512), LDS_BYTES, stream, a);
#endif
}
```

```cpp
#include <hip/hip_runtime.h>
#include <cstdio>
#include <cstdint>

#define DI __device__ __forceinline__
#define GAS __attribute__((address_space(1)))
#define LAS __attribute__((address_space(3)))
typedef unsigned short bf16;
typedef short bf16x8 __attribute__((ext_vector_type(8)));
typedef short s16x4 __attribute__((ext_vector_type(4)));
typedef float f32x4 __attribute__((ext_vector_type(4)));
typedef float f32x2 __attribute__((ext_vector_type(2)));
typedef unsigned u32x4 __attribute__((ext_vector_type(4)));
typedef unsigned u32x2 __attribute__((ext_vector_type(2)));

constexpr int BATCH = 2, SEQ = 16384, D = 1024, T = BATCH * SEQ, DEPTH = 4;
constexpr float DN_ALPHA = 1.681792830507429f;
constexpr float LN_EPS = 1e-5f;
constexpr int M_HEADS = 4, M_DQK = 128, M_DV = 256, M_CHUNK = 64, M_NIN = 3072  , M_IN = 3080;
constexpr int M_NSEG = 32, M_SEGT = SEQ / M_NSEG  , M_SEGC = M_SEGT / M_CHUNK  ;
constexpr int M_STATE = M_DQK * M_DV + M_DQK;
constexpr int S5_G = 64, S5_P = 64, S5_NSEG = 16, S5_SEGT = SEQ / S5_NSEG  ;
constexpr int A_HEADS = 16, A_KV = 4, A_GRP = 4, A_HD = 64, A_NQKV = 1536, A_WIN = 128;
constexpr int E_GROUPS = 4, E_PER = 8, N_EXP = 32, D_EXP = 512;
constexpr int MOE_P = 2 * T + N_EXP * 256;

constexpr size_t MiB = 1u << 20;
constexpr size_t WS_CTL = 0, CTL_ZERO_BYTES = 1 * MiB;
constexpr size_t WS_MOD = 1 * MiB;
constexpr size_t WS_S5ABAR = 2 * MiB;
constexpr size_t WS_S5BBT = WS_S5ABAR + 64 * 1024;
constexpr size_t WS_S5CMT = WS_S5BBT + 256 * 1024;
constexpr size_t WS_RWH = 3 * MiB;
constexpr size_t WS_RWL = WS_RWH + 512 * 1024;
constexpr size_t WS_GWH = 4 * MiB;
constexpr size_t WS_GWL = WS_GWH + 64 * 1024;
constexpr size_t WS_RB = WS_GWL + 64 * 1024;
constexpr size_t WS_SEGF = WS_RB + 4096;
constexpr size_t WS_SEGM = WS_SEGF + 4096;
constexpr size_t WS_S5END = 5 * MiB;
constexpr size_t WS_TOKES = 6 * MiB;
constexpr size_t WS_TOKW = WS_TOKES + 256 * 1024;
constexpr size_t WS_TOKPOS = WS_TOKW + 256 * 1024;
constexpr size_t WS_GATES = 7 * MiB;
constexpr size_t WS_WMIN = 8 * MiB;
constexpr size_t WS_WMOUT = 20 * MiB;
constexpr size_t WS_WS5IN = 24 * MiB;
constexpr size_t WS_WS5GLU = 26 * MiB;
constexpr size_t WS_WQKV = 30 * MiB;
constexpr size_t WS_WWO = 33 * MiB;
constexpr size_t WS_W13 = 36 * MiB;
constexpr size_t WS_W2 = WS_W13 + 256 * MiB;
constexpr size_t WS_SLOC = WS_W2 + 128 * MiB;
constexpr size_t WS_SINIT = WS_SLOC + 34 * MiB;
constexpr size_t WS_HIN = WS_SINIT + 34 * MiB;
constexpr size_t WS_R1 = WS_HIN + 64 * MiB;
constexpr size_t WS_PROJ = WS_R1, WS_MIXA = WS_R1 + 192 * MiB;
constexpr size_t WS_ELIST = WS_R1  , WS_HID = WS_R1 + 144 * MiB;
constexpr size_t WS_R2 = WS_R1 + 256 * MiB;
constexpr size_t WS_YEXP = WS_R2, WS_YMIX = WS_R2;
constexpr size_t WS_END = WS_R2 + 144 * MiB;
constexpr int CW_BAR = 4096;
constexpr int CW_GCNT = 16384;

constexpr int RING_BYTES = 131072;
constexpr int MISC_OFF = RING_BYTES;
constexpr int LDS_BYTES = 147456;

DI unsigned f2bf(float f) { unsigned u = __builtin_bit_cast(unsigned, f); return (u + 0x7fffu + ((u >> 16) & 1u)) >> 16; }
DI unsigned pk2(float lo, float hi) { return f2bf(lo) | (f2bf(hi) << 16); }
DI float bf2f(unsigned b) { return __builtin_bit_cast(float, b << 16); }
DI float bflo(unsigned w) { return __builtin_bit_cast(float, w << 16); }
DI float bfhi(unsigned w) { return __builtin_bit_cast(float, w & 0xffff0000u); }
DI f32x4 MMA(bf16x8 a, bf16x8 b, f32x4 c) { return __builtin_amdgcn_mfma_f32_16x16x32_bf16(a, b, c, 0, 0, 0); }
DI float wave_sum(float v) {
#pragma unroll
    for (int o = 1; o < 64; o <<= 1) v += __shfl_xor(v, o);
    return v;
}
DI float sigmoidf_(float x) { return 1.0f / (1.0f + __expf(-x)); }
#define LDS_WAIT() asm volatile("s_waitcnt lgkmcnt(0)" ::: "memory")
#define VM_WAIT() asm volatile("s_waitcnt vmcnt(0)" ::: "memory")

namespace pg8 {
#define PG8_LAS __attribute__((address_space(3)))
typedef unsigned short bf16_t;
typedef short bf16x8 __attribute__((ext_vector_type(8)));
typedef float f32x4 __attribute__((ext_vector_type(4)));
typedef unsigned u32x4 __attribute__((ext_vector_type(4)));
constexpr int BM = 256, BK = 64, HALF = 128, HTB = HALF * BK * 2  , STAGE_BYTES = 8 * HTB, NXCD = 8, WGM = 8;

__host__ __device__ __forceinline__ int lds_byte(int r, int c) { const int st = (r >> 4) * 2 + (c >> 5), rr = r & 15, cc = c & 31, ob = rr * 64 + cc * 2; return st * 1024 + (ob ^ (((ob >> 9) & 1) << 5)); }
__host__ __device__ __forceinline__ void stage_rc(int b, int& R, int& C) { const int st = b / 1024, sb = b % 1024, swz = sb ^ (((sb >> 9) & 1) << 5); R = (st >> 1) * 16 + swz / 64; C = (st & 1) * 32 + (swz % 64) / 2; }
__host__ __device__ __forceinline__ int perm32(int rho) { const int n = rho >> 4, i = rho & 15; return 8 * (i >> 2) + 4 * n + (i & 3); }

struct Unit { int pm, pn; };
struct Gemm { const bf16_t* A; const bf16_t* Bt; int M, N, K; };

struct StaticOrder {
    int nM, nN, nwg, G, c;
    __host__ __device__ void init(int M, int N, int G_, int c_) { nM = M / BM; nN = N / BM; nwg = nM * nN; G = G_; c = c_; }
    __host__ __device__ bool next(int i, Unit& u) const {
        const long L = (long)i * G + c; if (L >= nwg) return false;
        int wgid = (int)L; { const int q = nwg / NXCD, r = nwg % NXCD, xcd = wgid % NXCD, off = wgid / NXCD; wgid = (xcd < r ? xcd * (q + 1) : r * (q + 1) + (xcd - r) * q) + off; }
        const int nig = WGM * nN, gid = wgid / nig, fm = gid * WGM, gsz = (nM - fm) < WGM ? (nM - fm) : WGM;
        u.pm = fm + ((wgid % nig) % gsz); u.pn = (wgid % nig) / gsz; return true;
    }
    __device__ __forceinline__ void a_ready(const Unit&) const {}
    __device__ __forceinline__ void done(const Unit&) const {}
    __device__ __forceinline__ int arow(const Unit& u, int r) const { return u.pm * BM + r; }
};
struct MoeOrder {
    const PG8_LAS int* tbl; int G, c, nunits; const int* elist;
    __device__ __forceinline__ int arow(const Unit& u, int r) const { const int e = u.pn >> 2; const int slot = (u.pm - tbl[33 + e]) * BM + r; return slot < tbl[66 + e] ? elist[e * 32768 + slot] : 0; }
    __device__ __forceinline__ bool next(int i, Unit& u) const {
        const long L = (long)i * G + c; if (L >= nunits) return false;
        int wgid = (int)L; { const int q = nunits / NXCD, r = nunits % NXCD, xcd = wgid % NXCD, off = wgid / NXCD; wgid = (xcd < r ? xcd * (q + 1) : r * (q + 1) + (xcd - r) * q) + off; }
        int e = 0;
#pragma unroll
        for (int j = 1; j < 32; ++j) e += (wgid >= tbl[j]) ? 1 : 0;
        const int local = wgid - tbl[e], tb = tbl[33 + e], nt = tbl[34 + e] - tb;
        const int pn = local / nt, tl = local - pn * nt;
        u.pm = __builtin_amdgcn_readfirstlane(tb + tl); u.pn = __builtin_amdgcn_readfirstlane(e * 4 + pn); return true;
    }
    __device__ __forceinline__ void a_ready(const Unit&) const {}
    __device__ __forceinline__ void done(const Unit&) const {}
};

__device__ __forceinline__ unsigned cvt_pk_bf16(float lo, float hi) { unsigned r; asm volatile("v_cvt_pk_bf16_f32 %0, %1, %2" : "=v"(r) : "v"(lo), "v"(hi)); return r; }

struct EpiStore {
    static constexpr bool PERM = true, AFTER_DRAIN = false;
    bf16_t* O; int ldc; const float* bias; int pn_mask;
    __device__ __forceinline__ void operator()(const f32x4 (&acc)[2][2][4][2], const Unit& u, int wr, int wc, int fr, int fq) const {
        const int row0 = u.pm * BM + wr * 64 + fr; const int col0 = (u.pn & pn_mask) * BM + wc * 32 + 8 * fq;
        f32x4 bv[2][2];
#pragma unroll
        for (int bj = 0; bj < 2; ++bj)
#pragma unroll
            for (int n = 0; n < 2; ++n) bv[bj][n] = bias ? *(const f32x4*)(bias + col0 + bj * HALF + 4 * n) : (f32x4){0.f, 0.f, 0.f, 0.f};
#pragma unroll
        for (int ai = 0; ai < 2; ++ai)
#pragma unroll
            for (int m = 0; m < 4; ++m) { bf16_t* rowp = O + (size_t)(row0 + ai * HALF + m * 16) * ldc + col0;
#pragma unroll
                for (int bj = 0; bj < 2; ++bj) { const f32x4 v0 = acc[ai][bj][m][0] + bv[bj][0], v1 = acc[ai][bj][m][1] + bv[bj][1];
                    u32x4 w; w.x = cvt_pk_bf16(v0[0], v0[1]); w.y = cvt_pk_bf16(v0[2], v0[3]); w.z = cvt_pk_bf16(v1[0], v1[1]); w.w = cvt_pk_bf16(v1[2], v1[3]);
                    *(u32x4*)(rowp + bj * HALF) = w; } }
    }
};
template <int MODE> struct EpiPair {
    static constexpr bool PERM = true, AFTER_DRAIN = false;
    bf16_t* O; int ldc; int pn_mask;
    __device__ __forceinline__ void operator()(const f32x4 (&acc)[2][2][4][2], const Unit& u, int wr, int wc, int fr, int fq) const {
        const int row0 = u.pm * BM + wr * 64 + fr; const int col0 = (u.pn & pn_mask) * HALF + wc * 32 + 8 * fq;
#pragma unroll
        for (int ai = 0; ai < 2; ++ai)
#pragma unroll
            for (int m = 0; m < 4; ++m) { bf16_t* rowp = O + (size_t)(row0 + ai * HALF + m * 16) * ldc + col0;
                float r[8];
#pragma unroll
                for (int n = 0; n < 2; ++n)
#pragma unroll
                    for (int j = 0; j < 4; ++j) { const float a = acc[ai][0][m][n][j], b = acc[ai][1][m][n][j];
                        r[n * 4 + j] = (MODE == 0) ? (a * b) / (1.0f + __expf(-a)) : a / (1.0f + __expf(-b)); }
                u32x4 w; w.x = cvt_pk_bf16(r[0], r[1]); w.y = cvt_pk_bf16(r[2], r[3]); w.z = cvt_pk_bf16(r[4], r[5]); w.w = cvt_pk_bf16(r[6], r[7]);
                *(u32x4*)rowp = w; }
    }
};
template <class Epi, class Sched, bool ALIGN_EPI = false, bool SP2 = false, bool GATHER = false>
__device__ __forceinline__ void gemm_phase(PG8_LAS unsigned char* lds, const Gemm g, const Sched& S, const Epi& E) {
    const int tid = threadIdx.x, wid = __builtin_amdgcn_readfirstlane(tid >> 6), lane = tid & 63, wr = wid >> 2, wc = wid & 3, fr = lane & 15, fq = lane >> 4;
    const int K = g.K, nt = K / BK;
    unsigned voffA[2], voffB[2];
#pragma unroll
    for (int i = 0; i < 2; ++i) { int R, C; stage_rc(tid * 16 + i * 8192, R, C); const int Rb = Epi::PERM ? ((R & ~31) + perm32(R & 31)) : R;
        voffA[i] = (unsigned)(R * K + C) * 2u; voffB[i] = (unsigned)(Rb * K + C) * 2u; }
    unsigned cvA[2][2], nvA[2][2]; int gR[2], gC[2];
    if constexpr (GATHER) {
#pragma unroll
        for (int i = 0; i < 2; ++i) { stage_rc(tid * 16 + i * 8192, gR[i], gC[i]); }
    }
#define PG8_GOFF(dst, u) do { _Pragma("unroll") for (int _h = 0; _h < 2; ++_h) _Pragma("unroll") for (int _i = 0; _i < 2; ++_i) dst[_h][_i] = (unsigned)S.arow(u, _h * HALF + gR[_i]) * (unsigned)(K * 2) + (unsigned)(gC[_i] * 2); } while (0)
    const size_t kstep = (size_t)(BK * 2);
    const size_t hstep = (size_t)HALF * K * 2;
    const size_t tstep = 2 * hstep;
    const unsigned ldsw = (unsigned)wid * 1024u;
    const int aoff = lds_byte(wr * 64 + fr, fq * 8), boff = lds_byte(wc * 32 + fr, fq * 8);
#define PG8_SA(b, h) (((b) * 2 + (h)) * HTB)
#define PG8_SB(b, h) ((4 + (b) * 2 + (h)) * HTB)
#define PG8_STAGE(bufoff, gbase, voff) do { _Pragma("unroll") for (int _i = 0; _i < 2; ++_i) \
        __builtin_amdgcn_global_load_lds((const unsigned*)((const char*)(gbase) + (voff)[_i]), (PG8_LAS unsigned*)(lds + (bufoff) + ldsw + _i * 8192), 16, 0, 0); } while (0)
#define PG8_LDA(dst, b, h) do { _Pragma("unroll") for (int m = 0; m < 4; ++m) _Pragma("unroll") for (int k = 0; k < 2; ++k) dst[m][k] = *(const PG8_LAS bf16x8*)(lds + PG8_SA(b, h) + aoff + m * 2048 + k * 1024); } while (0)
#define PG8_LDB(dst, b, h) do { _Pragma("unroll") for (int n = 0; n < 2; ++n) _Pragma("unroll") for (int k = 0; k < 2; ++k) dst[n][k] = *(const PG8_LAS bf16x8*)(lds + PG8_SB(b, h) + boff + n * 2048 + k * 1024); } while (0)
#define PG8_MMA(ai, bj, At, Bt) do { __builtin_amdgcn_s_setprio(1); _Pragma("unroll") for (int m = 0; m < 4; ++m) _Pragma("unroll") for (int n = 0; n < 2; ++n) _Pragma("unroll") for (int k = 0; k < 2; ++k) \
        acc[ai][bj][m][n] = __builtin_amdgcn_mfma_f32_16x16x32_bf16(Bt[n][k], At[m][k], acc[ai][bj][m][n], 0, 0, 0); __builtin_amdgcn_s_setprio(0); } while (0)
#define PG8_WAIT_V(n) asm volatile("s_waitcnt vmcnt(" #n ")" ::: "memory")
#define PG8_WAIT_L(n) asm volatile("s_waitcnt lgkmcnt(" #n ")" ::: "memory")
#define PG8_BAR __builtin_amdgcn_s_barrier()
#define PG8_SCHED __builtin_amdgcn_sched_barrier(0)
    Unit cur, nxt; int ui = 0;
    if (!S.next(0, cur)) return;
    f32x4 acc[2][2][4][2];
#pragma unroll
    for (int a = 0; a < 2; ++a)
#pragma unroll
        for (int b = 0; b < 2; ++b)
#pragma unroll
            for (int m = 0; m < 4; ++m)
#pragma unroll
                for (int n = 0; n < 2; ++n) acc[a][b][m][n] = (f32x4){0.f, 0.f, 0.f, 0.f};
    bf16x8 At[4][2], B0[2][2], B1[2][2];
    const char* cA = GATHER ? (const char*)g.A : (const char*)g.A + (size_t)cur.pm * tstep; const char* cB = (const char*)g.Bt + (size_t)cur.pn * tstep;
    if constexpr (GATHER) { PG8_GOFF(cvA, cur); }
    S.a_ready(cur);
    if constexpr (SP2) {
        PG8_STAGE(PG8_SB(0, 0), cB, voffB); PG8_STAGE(PG8_SB(0, 1), cB + hstep, voffB);
        if constexpr (GATHER) { PG8_STAGE(PG8_SA(0, 0), cA, cvA[0]); PG8_STAGE(PG8_SA(0, 1), cA, cvA[1]); } else { PG8_STAGE(PG8_SA(0, 0), cA, voffA); PG8_STAGE(PG8_SA(0, 1), cA + hstep, voffA); }
        if (wr == 1) PG8_BAR;
        PG8_WAIT_V(2); PG8_BAR;
        PG8_STAGE(PG8_SB(1, 0), cB + kstep, voffB); if constexpr (GATHER) { PG8_STAGE(PG8_SA(1, 0), cA + kstep, cvA[0]); } else { PG8_STAGE(PG8_SA(1, 0), cA + kstep, voffA); } PG8_STAGE(PG8_SB(1, 1), cB + hstep + kstep, voffB);
        PG8_WAIT_V(6); PG8_BAR;
    } else {
        PG8_STAGE(PG8_SB(0, 0), cB, voffB); PG8_STAGE(PG8_SA(0, 0), cA, voffA); PG8_STAGE(PG8_SB(0, 1), cB + hstep, voffB); PG8_STAGE(PG8_SA(0, 1), cA + hstep, voffA);
        if (wr == 1) PG8_BAR;
        PG8_WAIT_V(4); PG8_BAR;
        PG8_STAGE(PG8_SB(1, 0), cB + kstep, voffB); PG8_STAGE(PG8_SA(1, 0), cA + kstep, voffA); PG8_STAGE(PG8_SB(1, 1), cB + hstep + kstep, voffB);
        PG8_WAIT_V(6); PG8_BAR;
    }
    for (;;) {
        const bool has_next = S.next(ui + 1, nxt);
        if constexpr (GATHER) { if (has_next) { PG8_GOFF(nvA, nxt); } else { _Pragma("unroll") for (int _h = 0; _h < 2; ++_h) _Pragma("unroll") for (int _i = 0; _i < 2; ++_i) nvA[_h][_i] = cvA[_h][_i]; } }
        const char* nA = GATHER ? (const char*)g.A : (has_next ? (const char*)g.A + (size_t)nxt.pm * tstep : cA); const char* nB = has_next ? (const char*)g.Bt + (size_t)nxt.pn * tstep : cB;
        for (int t = 0; t < nt; t += 2) {
            const bool last = (t == nt - 2);
            const char* a1 = cA + (size_t)(t + 1) * kstep;
            const char* a2 = last ? nA : cA + (size_t)(t + 2) * kstep; const char* b2 = last ? nB : cB + (size_t)(t + 2) * kstep;
            const char* a3 = a2 + kstep; const char* b3 = b2 + kstep;
            unsigned sv0[2], sv1[2];
            if constexpr (GATHER) { sv0[0] = last ? nvA[0][0] : cvA[0][0]; sv0[1] = last ? nvA[0][1] : cvA[0][1]; sv1[0] = last ? nvA[1][0] : cvA[1][0]; sv1[1] = last ? nvA[1][1] : cvA[1][1]; }
            if (last && has_next) S.a_ready(nxt);
            if constexpr (SP2) {
            PG8_LDB(B0, 0, 0); PG8_LDB(B1, 0, 1); PG8_SCHED; PG8_LDA(At, 0, 0); if constexpr (GATHER) { PG8_STAGE(PG8_SA(1, 1), a1, cvA[1]); } else { PG8_STAGE(PG8_SA(1, 1), a1 + hstep, voffA); }
            PG8_WAIT_V(8); PG8_WAIT_L(0); PG8_BAR; PG8_MMA(0, 0, At, B0); PG8_MMA(0, 1, At, B1); PG8_BAR; PG8_SCHED;
            PG8_LDA(At, 0, 1); PG8_STAGE(PG8_SB(0, 0), b2, voffB); PG8_STAGE(PG8_SB(0, 1), b2 + hstep, voffB); if constexpr (GATHER) { PG8_STAGE(PG8_SA(0, 0), a2, sv0); } else { PG8_STAGE(PG8_SA(0, 0), a2, voffA); }
            PG8_WAIT_V(8); PG8_WAIT_L(0); PG8_BAR; PG8_MMA(1, 0, At, B0); PG8_MMA(1, 1, At, B1); PG8_BAR; PG8_SCHED;
            PG8_LDB(B0, 1, 0); PG8_LDB(B1, 1, 1); PG8_SCHED; PG8_LDA(At, 1, 0); if constexpr (GATHER) { PG8_STAGE(PG8_SA(0, 1), a2, sv1); } else { PG8_STAGE(PG8_SA(0, 1), a2 + hstep, voffA); }
            PG8_WAIT_V(8); PG8_WAIT_L(0); PG8_BAR; PG8_MMA(0, 0, At, B0); PG8_MMA(0, 1, At, B1); PG8_BAR; PG8_SCHED;
            PG8_LDA(At, 1, 1); PG8_STAGE(PG8_SB(1, 0), b3, voffB); PG8_STAGE(PG8_SB(1, 1), b3 + hstep, voffB); if constexpr (GATHER) { PG8_STAGE(PG8_SA(1, 0), a3, sv0); } else { PG8_STAGE(PG8_SA(1, 0), a3, voffA); }
            PG8_WAIT_V(8); PG8_WAIT_L(0); PG8_BAR; PG8_MMA(1, 0, At, B0); PG8_MMA(1, 1, At, B1); PG8_BAR; PG8_SCHED;
            } else {
            PG8_LDB(B0, 0, 0); PG8_SCHED; PG8_LDA(At, 0, 0); PG8_STAGE(PG8_SA(1, 1), a1 + hstep, voffA);
            PG8_WAIT_L(8); PG8_BAR; PG8_WAIT_L(0); PG8_MMA(0, 0, At, B0); PG8_BAR; PG8_SCHED;
            PG8_LDB(B1, 0, 1); PG8_STAGE(PG8_SB(0, 0), b2, voffB);
            PG8_BAR; PG8_WAIT_L(0); PG8_MMA(0, 1, At, B1); PG8_BAR;
            PG8_LDA(At, 0, 1); PG8_STAGE(PG8_SA(0, 0), a2, voffA);
            PG8_BAR; PG8_WAIT_L(0); PG8_MMA(1, 0, At, B0); PG8_BAR; PG8_SCHED;
            PG8_STAGE(PG8_SB(0, 1), b2 + hstep, voffB);
            PG8_WAIT_V(6); PG8_BAR; PG8_MMA(1, 1, At, B1); PG8_BAR;
            PG8_LDB(B0, 1, 0); PG8_SCHED; PG8_LDA(At, 1, 0); PG8_STAGE(PG8_SA(0, 1), a2 + hstep, voffA);
            PG8_WAIT_L(8); PG8_BAR; PG8_WAIT_L(0); PG8_MMA(0, 0, At, B0); PG8_BAR; PG8_SCHED;
            PG8_LDB(B1, 1, 1); PG8_STAGE(PG8_SB(1, 0), b3, voffB);
            PG8_BAR; PG8_WAIT_L(0); PG8_MMA(0, 1, At, B1); PG8_BAR;
            PG8_LDA(At, 1, 1); PG8_STAGE(PG8_SA(1, 0), a3, voffA);
            PG8_BAR; PG8_WAIT_L(0); PG8_MMA(1, 0, At, B0); PG8_BAR; PG8_SCHED;
            PG8_STAGE(PG8_SB(1, 1), b3 + hstep, voffB);
            PG8_WAIT_V(6); PG8_BAR; PG8_MMA(1, 1, At, B1); PG8_BAR;
            }
        }
        if constexpr (ALIGN_EPI) { if (wr == 0) PG8_BAR; }
        if constexpr (!Epi::AFTER_DRAIN) { E(acc, cur, wr, wc, fr, fq); S.done(cur); }
        if (!has_next) break;
#pragma unroll
        for (int a = 0; a < 2; ++a)
#pragma unroll
            for (int b = 0; b < 2; ++b)
#pragma unroll
                for (int m = 0; m < 4; ++m)
#pragma unroll
                    for (int n = 0; n < 2; ++n) acc[a][b][m][n] = (f32x4){0.f, 0.f, 0.f, 0.f};
        cur = nxt; cA = nA; cB = nB; ++ui;
        if constexpr (GATHER) { _Pragma("unroll") for (int _h = 0; _h < 2; ++_h) _Pragma("unroll") for (int _i = 0; _i < 2; ++_i) cvA[_h][_i] = nvA[_h][_i]; }
        if constexpr (ALIGN_EPI) { if (wr == 1) PG8_BAR; }
    }
    PG8_WAIT_V(0);
    if constexpr (!ALIGN_EPI) { if (wr == 0) PG8_BAR; }
    PG8_BAR;
    if constexpr (Epi::AFTER_DRAIN) { E.fused(acc, cur, wr, wc, fr, fq, lds, wid, lane); S.done(cur); }
#undef PG8_GOFF
#undef PG8_SA
#undef PG8_SB
#undef PG8_STAGE
#undef PG8_LDA
#undef PG8_LDB
#undef PG8_MMA
#undef PG8_WAIT_V
#undef PG8_WAIT_L
#undef PG8_BAR
#undef PG8_SCHED
}
}

#define XB_TMO      128
#define XB_XCNT(j)  (256  + 64 * (j))
#define XB_XSUB(j)  (1280 + 64 * (j))
#define XB_XGEN(j)  (2304 + 64 * (j))
#define XB_TOP      3328
#define XB_TOPGEN   3392
#define XCD_BAR_WORDS 3456
#define XB_SPIN_CAP (1u << 18)

__device__ __forceinline__ unsigned xb_ld(unsigned* p)              { return __hip_atomic_load(p, __ATOMIC_RELAXED, __HIP_MEMORY_SCOPE_AGENT); }
__device__ __forceinline__ unsigned xb_add(unsigned* p, unsigned v) { return __hip_atomic_fetch_add(p, v, __ATOMIC_RELAXED, __HIP_MEMORY_SCOPE_AGENT); }
__device__ __forceinline__ unsigned xb_xcc_id() { return (unsigned)__builtin_amdgcn_s_getreg((3 << 11) | 20) & 0xFu; }
#define XB_SPIN(cond, bar) do { unsigned _sp = 0; while (cond) { __builtin_amdgcn_s_sleep(1); \
    if ((++_sp & 255u) == 0u) { if (xb_ld(&(bar)[XB_TMO])) break; if (_sp > XB_SPIN_CAP) { atomicAdd(&(bar)[XB_TMO], 1u); break; } } } } while (0)

struct XcdBarrier {
    unsigned* bar; unsigned x;
    volatile LAS unsigned* st;
};

__device__ __forceinline__ XcdBarrier xcd_barrier_post(unsigned* bar, volatile LAS unsigned* st) {
    XcdBarrier b; b.bar = bar; b.x = xb_xcc_id(); b.st = st;
    if (threadIdx.x == 0) (void)xb_add(&bar[XB_XCNT(b.x)], 1u);
    return b;
}
__device__ __forceinline__ void xcd_barrier_complete(unsigned* bar, unsigned x, unsigned& nloc, unsigned& nx) {
    const unsigned G = gridDim.x * gridDim.y * gridDim.z;
    unsigned sum, cnt, mine, sp = 0u;
    for (;;) {
        sum = 0u; cnt = 0u; mine = 0u;
#pragma unroll
        for (unsigned j = 0; j < 16; ++j) { const unsigned c = xb_ld(&bar[XB_XCNT(j)]); sum += c; cnt += (c > 0u) ? 1u : 0u; mine = (j == x) ? c : mine; }
        if (sum == G) break;
        __builtin_amdgcn_s_sleep(1);
        if ((++sp & 255u) == 0u) { if (xb_ld(&bar[XB_TMO])) break; if (sp > XB_SPIN_CAP) { atomicAdd(&bar[XB_TMO], 1u); break; } }
    }
    nloc = mine > 0u ? mine : 1u; nx = cnt > 0u ? cnt : 1u;
}

__device__ __forceinline__ void xcd_barrier(const XcdBarrier& b) {
    asm volatile("s_waitcnt vmcnt(0)" ::: "memory");
    __syncthreads();
    if (threadIdx.x == 0) {
        unsigned* bar = b.bar;
        __builtin_amdgcn_s_waitcnt(0);
        unsigned nloc = b.st[0], nx = b.st[1];
        if (nloc == 0u) { xcd_barrier_complete(bar, b.x, nloc, nx); b.st[0] = nloc; b.st[1] = nx; }
        const unsigned old = xb_add(&bar[XB_XSUB(b.x)], 1u);
        const unsigned gen = old / nloc;
        if (old + 1u == (gen + 1u) * nloc) {
            __builtin_amdgcn_fence(__ATOMIC_RELEASE, "agent");
            asm volatile("s_waitcnt vmcnt(0)" ::: "memory");
            const unsigned og = xb_add(&bar[XB_TOP], 1u);
            const unsigned tg = og / nx;
            if (og + 1u == (tg + 1u) * nx) xb_add(&bar[XB_TOPGEN], 1u);
            else XB_SPIN(xb_ld(&bar[XB_TOPGEN]) == tg, bar);
            __builtin_amdgcn_fence(__ATOMIC_ACQUIRE, "agent");
            xb_add(&bar[XB_XGEN(b.x)], 1u);
            asm volatile("s_waitcnt vmcnt(0)" ::: "memory");
        } else {
            XB_SPIN(xb_ld(&bar[XB_XGEN(b.x)]) == gen, bar);
            __builtin_amdgcn_fence(__ATOMIC_ACQUIRE, "agent");
            asm volatile("s_waitcnt vmcnt(0)" ::: "memory");
        }
    }
    __syncthreads();
}

struct Ctx {
    LAS unsigned char* lds;
    unsigned* ctl;
    unsigned char* ws;
    const float* const* in;
    float* out;
    int tid, lane, wave, G, vcu;
};
#define WSP(T_, off) ((T_*)(C.ws + (off)))

DI void transpose_item(const float* W, int ldw, int K, int k0, int n0, bf16* WT, int drow0, LAS float* scr, int lane) {
#pragma unroll 8
    for (int i = 0; i < 32; ++i) { const int kk = 2 * i + (lane >> 5); scr[kk * 33 + (lane & 31)] = W[(size_t)(k0 + kk) * ldw + n0 + (lane & 31)]; }
    LDS_WAIT(); asm volatile("" ::: "memory");
    const int c = lane & 7;
#pragma unroll
    for (int j = 0; j < 4; ++j) { const int n = (lane >> 3) + 8 * j; const LAS float* s = scr + (8 * c) * 33 + n;
        u32x4 o; o.x = pk2(s[0 * 33], s[1 * 33]); o.y = pk2(s[2 * 33], s[3 * 33]); o.z = pk2(s[4 * 33], s[5 * 33]); o.w = pk2(s[6 * 33], s[7 * 33]);
        *(u32x4*)(WT + (size_t)(drow0 + n) * K + k0 + 8 * c) = o; }
    LDS_WAIT(); asm volatile("" ::: "memory");
}
DI int pair_row(int n, int half) { return (n >> 7) * 256 + half * 128 + (n & 127); }

DI void p0a_weights(Ctx& C) {
    LAS float* scr = (LAS float*)(C.lds + C.wave * 8448);
    const int gw = C.vcu * 8 + C.wave, NGW = C.G * 8, lane = C.lane;
    constexpr int I_MIN = 16 * 96, I_SQ = 16 * 32, I_GLU = 16 * 64, I_QKV = 16 * 48;
    constexpr int NDENSE = 2 * I_MIN + 2 * I_SQ + I_SQ + I_GLU + I_QKV + I_SQ;
    for (int it = gw; it < NDENSE; it += NGW) {
        int r = it;
        if (r < 2 * I_MIN) { const int j = r / I_MIN; r -= j * I_MIN; const int kb = r / 96, nb = r % 96;
            transpose_item(C.in[8] + (size_t)j * D * M_IN, M_IN, D, kb * 64, nb * 32, WSP(bf16, WS_WMIN) + (size_t)j * M_NIN * D, nb * 32, scr, lane); continue; } r -= 2 * I_MIN;
        if (r < 2 * I_SQ) { const int j = r / I_SQ; r -= j * I_SQ; const int kb = r / 32, nb = r % 32;
            transpose_item(C.in[13] + (size_t)j * D * D, D, D, kb * 64, nb * 32, WSP(bf16, WS_WMOUT) + (size_t)j * D * D, nb * 32, scr, lane); continue; } r -= 2 * I_SQ;
        if (r < I_SQ) { const int kb = r / 32, nb = r % 32; transpose_item(C.in[14], D, D, kb * 64, nb * 32, WSP(bf16, WS_WS5IN), nb * 32, scr, lane); continue; } r -= I_SQ;
        if (r < I_GLU) { const int kb = r / 64, nb = r % 64; const int n0 = nb * 32; transpose_item(C.in[23], 2 * D, D, kb * 64, n0, WSP(bf16, WS_WS5GLU), pair_row(n0 & 1023, n0 >> 10), scr, lane); continue; } r -= I_GLU;
        if (r < I_QKV) { const int kb = r / 48, nb = r % 48; transpose_item(C.in[24], A_NQKV, D, kb * 64, nb * 32, WSP(bf16, WS_WQKV), nb * 32, scr, lane); continue; } r -= I_QKV;
        { const int kb = r / 32, nb = r % 32; transpose_item(C.in[27], D, D, kb * 64, nb * 32, WSP(bf16, WS_WWO), nb * 32, scr, lane); }
    }
    constexpr int I_E = 256;
    constexpr int NMOE = DEPTH * N_EXP * 3 * I_E;
    for (int it = gw; it < NMOE; it += NGW) {
        const int le = it / (3 * I_E); int r = it - le * 3 * I_E; const int which = r / I_E; r -= which * I_E;
        if (which < 2) { const int kb = r / 16, nb = r % 16; const int n0 = nb * 32;
            transpose_item(C.in[which == 0 ? 32 : 33] + (size_t)le * D * D_EXP, D_EXP, D, kb * 64, n0, WSP(bf16, WS_W13) + (size_t)le * D * D, pair_row(n0, which), scr, lane); }
        else { const int kb = r / 32, nb = r % 32;
            transpose_item(C.in[34] + (size_t)le * D_EXP * D, D, D_EXP, kb * 64, nb * 32, WSP(bf16, WS_W2) + (size_t)le * D * D_EXP, nb * 32, scr, lane); }
    }
    const int gt = C.vcu * 512 + C.tid, NGT = C.G * 512;
    for (int i = gt; i < DEPTH * 48 * D; i += NGT) { const int l = i / (48 * D), c = (i / D) % 48, k = i % D; float w = 0.f;
        if (c < 4) w = C.in[28][((size_t)l * D + k) * E_GROUPS + c]; else if (c >= 16) w = C.in[30][((size_t)l * D + k) * N_EXP + (c - 16)];
        const unsigned h = f2bf(w); WSP(bf16, WS_RWH)[i] = (bf16)h; WSP(bf16, WS_RWL)[i] = (bf16)f2bf(w - bf2f(h)); }
    for (int i = gt; i < DEPTH * 48; i += NGT) { const int l = i / 48, c = i % 48; float b = 0.f;
        if (c < 4) b = C.in[29][l * E_GROUPS + c]; else if (c >= 16) b = C.in[31][l * N_EXP + (c - 16)]; WSP(float, WS_RB)[i] = b; }
    for (int i = gt; i < 2 * 16 * D; i += NGT) { const int j = i / (16 * D), c = (i / D) % 16, k = i % D; float w = 0.f;
        if (c < 8) w = C.in[8][((size_t)j * D + k) * M_IN + M_NIN + c];
        const unsigned h = f2bf(w); WSP(bf16, WS_GWH)[i] = (bf16)h; WSP(bf16, WS_GWL)[i] = (bf16)f2bf(w - bf2f(h)); }
    for (int i = gt; i < S5_G * S5_P; i += NGT) { const int g = i / S5_P, p = i % S5_P;
        const float dt = expf(C.in[17][g]), lr = C.in[15][i], li = C.in[16][i];
        const float mag = expf(lr * dt); float sn, cs; sincosf(li * dt, &sn, &cs);
        const float are = mag * cs, aim = mag * sn; WSP(float, WS_S5ABAR)[2 * i] = are; WSP(float, WS_S5ABAR)[2 * i + 1] = aim;
        const float lsq = lr * lr + li * li, tre = ((are - 1.0f) * lr + aim * li) / lsq, tim = (aim * lr - (are - 1.0f) * li) / lsq;
        bf16* bbt = WSP(bf16, WS_S5BBT) + (size_t)g * 128 * 16;
        for (int q = 0; q < 16; ++q) { const float br = C.in[18][(size_t)i * 16 + q], bi = C.in[19][(size_t)i * 16 + q];
            bbt[p * 16 + q] = (bf16)f2bf(tre * br - tim * bi); bbt[(64 + p) * 16 + q] = (bf16)f2bf(tre * bi + tim * br); }
        bf16* cmt = WSP(bf16, WS_S5CMT) + (size_t)g * 16 * 128;
        for (int q = 0; q < 16; ++q) { cmt[q * 128 + p] = (bf16)f2bf(C.in[20][((size_t)g * 16 + q) * S5_P + p]); cmt[q * 128 + 64 + p] = (bf16)f2bf(-C.in[21][((size_t)g * 16 + q) * S5_P + p]); } }
    __syncthreads();
    LAS float* cs = (LAS float*)C.lds;
    LAS float* red = cs + 2048;
    for (int i = C.tid; i < 2 * D; i += 512) { const float v = C.in[1][i]; cs[i] = v / (1.0f + __expf(-v)); }
    __syncthreads();
    for (int it = C.vcu; it < DEPTH * 96; it += C.G) { const int l = it / 96, cg = it % 96;
        const float* w = C.in[2] + (size_t)l * D * 6 * D + cg * 64 + lane; float a0 = 0.f, a1 = 0.f;
#pragma unroll 8
        for (int k = C.wave * 128; k < C.wave * 128 + 128; ++k) { const float wv = w[(size_t)k * 6 * D]; a0 += cs[k] * wv; a1 += cs[D + k] * wv; }
        red[(C.wave * 2 + 0) * 64 + lane] = a0; red[(C.wave * 2 + 1) * 64 + lane] = a1;
        __syncthreads();
        if (C.tid < 128) { const int b = C.tid >> 6, c = C.tid & 63; float s = 0.f;
#pragma unroll
            for (int w8 = 0; w8 < 8; ++w8) s += red[(w8 * 2 + b) * 64 + c];
            WSP(float, WS_MOD)[((size_t)l * 2 + b) * 6 * D + cg * 64 + c] = s + C.in[3][(size_t)l * 6 * D + cg * 64 + c]; }
        __syncthreads();
    }
}

DI int moe_tables(Ctx& C, int layer) {
    LAS int* tbl = (LAS int*)(C.lds + MISC_OFF);
    __syncthreads();
    if (C.tid == 0) { int tb = 0;
        for (int e = 0; e < N_EXP; ++e) { const unsigned n = __hip_atomic_load(C.ctl + CW_GCNT + layer * 32 + e, __ATOMIC_RELAXED, __HIP_MEMORY_SCOPE_AGENT);
            tbl[e] = tb * 4; tbl[33 + e] = tb; tbl[66 + e] = (int)n; tb += (int)((n + 255u) >> 8); }
        tbl[32] = tb * 4; tbl[65] = tb; }
    __syncthreads();
    return tbl[32];
}

constexpr int RP_XSTR = 1032;
constexpr int RP_XH = 0, RP_XL = RP_XH + 16 * RP_XSTR * 2, RP_PART = RP_XL + 16 * RP_XSTR * 2, RP_LOG = RP_PART + 8 * 16 * 48 * 4, RP_REC = RP_LOG + 16 * 48 * 4,
              RP_LCNT = RP_REC + 128 * 6 * 4, RP_VEC = RP_LCNT + 64 * 4, RP_END = RP_VEC + 5 * 1024 * 4;
static_assert(RP_END <= RING_BYTES, "row phase LDS");

template <int MODE, int NT, bool WRITE_HIN>
DI void row_phase(Ctx& C, const float* xsrc, const int layer, const int gate_idx, const float* lng, const float* lnb, const int mlayer, const int sc_idx, const int sh_idx, const int gj) {
    const int lane = C.lane, wave = C.wave, tid = C.tid, q = lane >> 4, fr = lane & 15;
    LAS bf16* XH = (LAS bf16*)(C.lds + RP_XH); LAS bf16* XL = (LAS bf16*)(C.lds + RP_XL);
    LAS float* PART = (LAS float*)(C.lds + RP_PART); LAS float* LOG = (LAS float*)(C.lds + RP_LOG);
    LAS int* REC = (LAS int*)(C.lds + RP_REC); LAS int* LCNT = (LAS int*)(C.lds + RP_LCNT); LAS float* VEC = (LAS float*)(C.lds + RP_VEC);
    const float* MOD = WSP(float, WS_MOD);
    const LAS int* MTBL = (const LAS int*)(C.lds + MISC_OFF);
    if constexpr (MODE == 2) { (void)moe_tables(C, layer); }
    bf16x8 wh[NT > 0 ? NT : 1][4], wl[NT > 0 ? NT : 1][4];
    if constexpr (NT > 0) {
        const bf16* th = (NT == 3) ? WSP(bf16, WS_RWH) + (size_t)layer * 48 * D : WSP(bf16, WS_GWH) + (size_t)gj * 16 * D;
        const bf16* tl = (NT == 3) ? WSP(bf16, WS_RWL) + (size_t)layer * 48 * D : WSP(bf16, WS_GWL) + (size_t)gj * 16 * D;
#pragma unroll
        for (int nt = 0; nt < NT; ++nt)
#pragma unroll
            for (int ks = 0; ks < 4; ++ks) { const size_t o = (size_t)(nt * 16 + fr) * D + wave * 128 + ks * 32 + 8 * q;
                wh[nt][ks] = *(const bf16x8*)(th + o); wl[nt][ks] = *(const bf16x8*)(tl + o); }
    }
    for (int rb = C.vcu; rb < T / 128; rb += C.G) {
        const int b = (rb * 128) / SEQ;
        __syncthreads();
        for (int c = tid; c < D; c += 512) {
            if constexpr (MODE != 0) { VEC[c] = MOD[((size_t)layer * 2 + b) * 6 * D + gate_idx * D + c]; VEC[D + c] = lng[c]; VEC[2 * D + c] = lnb[c]; }
            if constexpr (WRITE_HIN) { VEC[3 * D + c] = MOD[((size_t)mlayer * 2 + b) * 6 * D + sc_idx * D + c] + 1.0f; VEC[4 * D + c] = MOD[((size_t)mlayer * 2 + b) * 6 * D + sh_idx * D + c]; } }
        if constexpr (NT == 3) { if (tid < 32) LCNT[tid] = 0; }
        __syncthreads();
        for (int grp = 0; grp < 8; ++grp) {
#pragma unroll
            for (int rr = 0; rr < 2; ++rr) {
                const int lr = 2 * wave + rr; const size_t t = (size_t)rb * 128 + grp * 16 + lr;
                f32x4 v[4];
#pragma unroll
                for (int j = 0; j < 4; ++j) v[j] = *(const f32x4*)(xsrc + t * D + 4 * lane + 256 * j);
                if constexpr (MODE == 1) {
                    const bf16* yr = WSP(bf16, WS_YMIX) + t * D + 4 * lane;
#pragma unroll
                    for (int j = 0; j < 4; ++j) { const u32x2 w = *(const u32x2*)(yr + 256 * j); const f32x4 y = {bflo(w.x), bfhi(w.x), bflo(w.y), bfhi(w.y)}; v[j] = v[j] * DN_ALPHA + *(const LAS f32x4*)(VEC + 4 * lane + 256 * j) * y; }
                }
                if constexpr (MODE == 2) {
                    const int es0 = WSP(int, WS_TOKES)[2 * t], es1 = WSP(int, WS_TOKES)[2 * t + 1]; const int p0 = MTBL[33 + (es0 & 255)] * 256 + (es0 >> 8), p1 = MTBL[33 + (es1 & 255)] * 256 + (es1 >> 8); const float w0 = WSP(float, WS_TOKW)[2 * t], w1 = WSP(float, WS_TOKW)[2 * t + 1];
                    const bf16* y0 = WSP(bf16, WS_YEXP) + (size_t)p0 * D + 4 * lane; const bf16* y1 = WSP(bf16, WS_YEXP) + (size_t)p1 * D + 4 * lane;
#pragma unroll
                    for (int j = 0; j < 4; ++j) { const u32x2 a = *(const u32x2*)(y0 + 256 * j), c2 = *(const u32x2*)(y1 + 256 * j);
                        const f32x4 y = (f32x4){bflo(a.x), bfhi(a.x), bflo(a.y), bfhi(a.y)} * w0 + (f32x4){bflo(c2.x), bfhi(c2.x), bflo(c2.y), bfhi(c2.y)} * w1;
                        v[j] = v[j] * DN_ALPHA + *(const LAS f32x4*)(VEC + 4 * lane + 256 * j) * y; }
                }
                if constexpr (MODE != 0) {
                    float s = 0.f;
#pragma unroll
                    for (int j = 0; j < 4; ++j) s += (v[j].x + v[j].y) + (v[j].z + v[j].w);
                    const float mean = wave_sum(s) * (1.0f / D); float s2 = 0.f;
#pragma unroll
                    for (int j = 0; j < 4; ++j) { v[j] = v[j] - mean; s2 += (v[j].x * v[j].x + v[j].y * v[j].y) + (v[j].z * v[j].z + v[j].w * v[j].w); }
                    const float rstd = 1.0f / sqrtf(wave_sum(s2) * (1.0f / D) + LN_EPS);
#pragma unroll
                    for (int j = 0; j < 4; ++j) { v[j] = v[j] * rstd * *(const LAS f32x4*)(VEC + D + 4 * lane + 256 * j) + *(const LAS f32x4*)(VEC + 2 * D + 4 * lane + 256 * j); *(f32x4*)(C.out + t * D + 4 * lane + 256 * j) = v[j]; }
                }
                if constexpr (WRITE_HIN) {
#pragma unroll
                    for (int j = 0; j < 4; ++j) { const f32x4 h = v[j] * *(const LAS f32x4*)(VEC + 3 * D + 4 * lane + 256 * j) + *(const LAS f32x4*)(VEC + 4 * D + 4 * lane + 256 * j);
                        const unsigned h0 = f2bf(h.x), h1 = f2bf(h.y), h2 = f2bf(h.z), h3 = f2bf(h.w);
                        u32x2 hw; hw.x = h0 | (h1 << 16); hw.y = h2 | (h3 << 16);
                        *(u32x2*)(WSP(bf16, WS_HIN) + t * D + 4 * lane + 256 * j) = hw;
                        if constexpr (NT > 0) {
                            u32x2 lw; lw.x = pk2(h.x - bf2f(h0), h.y - bf2f(h1)); lw.y = pk2(h.z - bf2f(h2), h.w - bf2f(h3));
                            *(LAS u32x2*)(XH + lr * RP_XSTR + 4 * lane + 256 * j) = hw; *(LAS u32x2*)(XL + lr * RP_XSTR + 4 * lane + 256 * j) = lw; } }
                }
            }
            if constexpr (NT > 0) {
                __syncthreads();
                f32x4 acc[NT];
#pragma unroll
                for (int nt = 0; nt < NT; ++nt) acc[nt] = (f32x4){0.f, 0.f, 0.f, 0.f};
#pragma unroll
                for (int ks = 0; ks < 4; ++ks) { const int o = fr * RP_XSTR + wave * 128 + ks * 32 + 8 * q;
                    const bf16x8 ah = *(const LAS bf16x8*)(XH + o), al = *(const LAS bf16x8*)(XL + o);
#pragma unroll
                    for (int nt = 0; nt < NT; ++nt) { acc[nt] = MMA(ah, wh[nt][ks], acc[nt]); acc[nt] = MMA(al, wh[nt][ks], acc[nt]); acc[nt] = MMA(ah, wl[nt][ks], acc[nt]); } }
#pragma unroll
                for (int nt = 0; nt < NT; ++nt)
#pragma unroll
                    for (int r = 0; r < 4; ++r) PART[(wave * 16 + 4 * q + r) * 48 + nt * 16 + fr] = acc[nt][r];
                __syncthreads();
                if constexpr (NT == 1) {
                    if (tid < 128) { const int row = tid >> 3, c = tid & 7; float s = 0.f;
#pragma unroll
                        for (int w8 = 0; w8 < 8; ++w8) s += PART[(w8 * 16 + row) * 48 + c];
                        WSP(float, WS_GATES)[((size_t)rb * 128 + grp * 16 + row) * 8 + c] = s; }
                } else {
                    const float* rbias = WSP(float, WS_RB) + layer * 48;
                    for (int idx = tid; idx < 16 * 48; idx += 512) { const int row = idx / 48, c = idx % 48; float s = 0.f;
#pragma unroll
                        for (int w8 = 0; w8 < 8; ++w8) s += PART[(w8 * 16 + row) * 48 + c];
                        LOG[idx] = s + rbias[c]; }
                    __syncthreads();
                    if (tid < 16) {
                        const LAS float* lg = LOG + tid * 48; int gs = 0; float gm = lg[0];
#pragma unroll
                        for (int g = 1; g < 4; ++g) if (lg[g] > gm) { gm = lg[g]; gs = g; }
                        float den = 0.f;
#pragma unroll
                        for (int g = 0; g < 4; ++g) den += __expf(lg[g] - gm);
                        const float pg = 1.0f / den;
                        const LAS float* el = lg + 16 + gs * 8; int i0 = 0; float v0 = el[0];
#pragma unroll
                        for (int i = 1; i < 8; ++i) if (el[i] > v0) { v0 = el[i]; i0 = i; }
                        int i1 = -1; float v1 = -3.0e38f;
#pragma unroll
                        for (int i = 0; i < 8; ++i) if (i != i0 && el[i] > v1) { v1 = el[i]; i1 = i; }
                        const float e1 = __expf(v1 - v0), w0 = pg / (1.0f + e1), w1 = pg * e1 / (1.0f + e1);
                        const int ex0 = gs * 8 + i0, ex1 = gs * 8 + i1;
                        const int ls0 = __hip_atomic_fetch_add(&LCNT[ex0], 1, __ATOMIC_RELAXED, __HIP_MEMORY_SCOPE_WORKGROUP), ls1 = __hip_atomic_fetch_add(&LCNT[ex1], 1, __ATOMIC_RELAXED, __HIP_MEMORY_SCOPE_WORKGROUP);
                        const int rloc = grp * 16 + tid;
                        REC[rloc * 6 + 0] = ex0; REC[rloc * 6 + 1] = ex1; REC[rloc * 6 + 2] = ls0; REC[rloc * 6 + 3] = ls1;
                        REC[rloc * 6 + 4] = __builtin_bit_cast(int, w0); REC[rloc * 6 + 5] = __builtin_bit_cast(int, w1);
                    }
                }
                __syncthreads();
            }
        }
        if constexpr (NT == 3) {
            __syncthreads();
            if (tid < 32) { const int n = LCNT[tid]; const unsigned gb = n ? atomicAdd(C.ctl + CW_GCNT + layer * 32 + tid, (unsigned)n) : 0u; LCNT[32 + tid] = (int)gb; }
            __syncthreads();
            if (tid < 256) { const int rloc = tid >> 1, k = tid & 1; const int e = REC[rloc * 6 + k], ls = REC[rloc * 6 + 2 + k]; const size_t t = (size_t)rb * 128 + rloc;
                const int slot = LCNT[32 + e] + ls; WSP(int, WS_TOKES)[2 * t + k] = e | (slot << 8); WSP(int, WS_TOKW)[2 * t + k] = REC[rloc * 6 + 4 + k]; WSP(int, WS_ELIST)[e * 32768 + slot] = (int)t; }
            __syncthreads();
        }
    }
}


constexpr int ML_QSTR = 136, ML_TSTR = 72, ML_HSTR = 264;
constexpr int ML_QS = 0, ML_KS = ML_QS + 64 * ML_QSTR * 2, ML_VT = ML_KS + 64 * ML_QSTR * 2, ML_KWT = ML_VT + 256 * ML_TSTR * 2, ML_WM = ML_KWT + 128 * ML_TSTR * 2,
              ML_CW = ML_WM + 64 * ML_TSTR * 2, ML_AP = ML_CW + 2 * 5 * 128 * 4, ML_FL = ML_AP + 2048, ML_MR = ML_FL + 2048, ML_CH = ML_MR + 2048  ,
              ML_NS = ML_CH + 8 * 256, ML_STP = ML_NS + 512, ML_MRS = ML_STP + 64 * 8 * 8, ML_TMP = ML_MRS + 512, ML_END = ML_TMP + 256;
static_assert(ML_END <= RING_BYTES && 64 * ML_HSTR * 2 <= ML_VT, "mlstm LDS");

DI void mlstm_seg_scalars(Ctx& C, int mj, int bh, int seg) {
    LAS float* AP = (LAS float*)(C.lds + ML_AP); LAS float* FL = (LAS float*)(C.lds + ML_FL); LAS float* MR = (LAS float*)(C.lds + ML_MR); LAS float* TMP = (LAS float*)(C.lds + ML_TMP);
    const int b = bh >> 2, h = bh & 3, lane = C.lane, wave = C.wave; const size_t t = (size_t)b * SEQ + seg * M_SEGT + C.tid;
    const float* g = WSP(float, WS_GATES) + t * 8; const float* bif = C.in[11] + mj * 8;
    const float li = g[h] + bif[h], x = g[4 + h] + bif[4 + h];
    const float lf = fminf(x, 0.f) - log1pf(expf(-fabsf(x)));
    float s = lf;
#pragma unroll
    for (int o = 1; o < 64; o <<= 1) { const float n = __shfl_up(s, o); if (lane >= o) s += n; }
    if (lane == 63) TMP[wave] = s;
    __syncthreads();
    float off = 0.f;
    for (int w = 0; w < wave; ++w) off += TMP[w];
    s += off;
    const float ap = li - s; float m = ap;
#pragma unroll
    for (int o = 1; o < 64; o <<= 1) { const float n = __shfl_up(m, o); if (lane >= o) m = fmaxf(m, n); }
    if (lane == 63) TMP[16 + wave] = m;
    __syncthreads();
    for (int w = 0; w < wave; ++w) m = fmaxf(m, TMP[16 + w]);
    AP[C.tid] = ap; FL[C.tid] = s; MR[C.tid] = m;
    __syncthreads();
}
DI void mlstm_load_cw(Ctx& C, int mj, int h) {
    LAS float* CW = (LAS float*)(C.lds + ML_CW);
    for (int i = C.tid; i < 2 * 5 * 128; i += 512) { const int which = i / 640, r = (i % 640) / 128, d = i % 128; const int col = which * 512 + h * 128 + d;
        CW[i] = (r < 4) ? C.in[9][((size_t)mj * 4 + r) * 1024 + col] : C.in[10][(size_t)mj * 1024 + col]; }
}
DI void mlstm_conv16(const bf16* proj, size_t tok, int pos, int col0, const LAS float* cwp, float (&o)[16]) {
#pragma unroll
    for (int dd = 0; dd < 16; ++dd) o[dd] = cwp[4 * 128 + dd];
#pragma unroll
    for (int jj = 0; jj < 4; ++jj) {
        if (pos - 3 + jj >= 0) { const u32x4* p = (const u32x4*)(proj + (tok - 3 + jj) * M_NIN + col0); const u32x4 a = p[0], b2 = p[1];
            const unsigned w[8] = {a.x, a.y, a.z, a.w, b2.x, b2.y, b2.z, b2.w};
#pragma unroll
            for (int e = 0; e < 8; ++e) { o[2 * e] += cwp[jj * 128 + 2 * e] * bflo(w[e]); o[2 * e + 1] += cwp[jj * 128 + 2 * e + 1] * bfhi(w[e]); } }
    }
#pragma unroll
    for (int dd = 0; dd < 16; ++dd) o[dd] = o[dd] / (1.0f + __expf(-o[dd]));
}
DI void mlstm_load_vt(Ctx& C, const bf16* proj, size_t tok0, int h, int lane) {
    LAS bf16* VT = (LAS bf16*)(C.lds + ML_VT); const int s = lane, v0 = C.wave * 32;
    const u32x4* p = (const u32x4*)(proj + (tok0 + s) * M_NIN + 1024 + h * 256 + v0);
#pragma unroll
    for (int i = 0; i < 4; ++i) { const u32x4 a = p[i]; const unsigned w[4] = {a.x, a.y, a.z, a.w};
#pragma unroll
        for (int e = 0; e < 4; ++e) { VT[(v0 + i * 8 + 2 * e) * ML_TSTR + s] = (bf16)(w[e] & 0xffffu); VT[(v0 + i * 8 + 2 * e + 1) * ML_TSTR + s] = (bf16)(w[e] >> 16); } }
}
DI void mlstm_state_update(Ctx& C, f32x4 (&acc)[8][2], float decay, int lane) {
    const LAS bf16* VT = (const LAS bf16*)(C.lds + ML_VT); const LAS bf16* KWT = (const LAS bf16*)(C.lds + ML_KWT);
    const int fr = lane & 15, q = lane >> 4, w = C.wave;
#pragma unroll
    for (int dt = 0; dt < 8; ++dt) { acc[dt][0] = acc[dt][0] * decay; acc[dt][1] = acc[dt][1] * decay; }
#pragma unroll
    for (int ks = 0; ks < 2; ++ks) {
        const bf16x8 b0 = *(const LAS bf16x8*)(VT + ((2 * w) * 16 + fr) * ML_TSTR + ks * 32 + 8 * q), b1 = *(const LAS bf16x8*)(VT + ((2 * w + 1) * 16 + fr) * ML_TSTR + ks * 32 + 8 * q);
#pragma unroll
        for (int dt = 0; dt < 8; ++dt) { const bf16x8 a = *(const LAS bf16x8*)(KWT + (dt * 16 + fr) * ML_TSTR + ks * 32 + 8 * q);
            acc[dt][0] = MMA(a, b0, acc[dt][0]); acc[dt][1] = MMA(a, b1, acc[dt][1]); }
    }
}
DI void mlstm_n_update(Ctx& C, float decay, int tid) {
    if (tid < 128) { LAS float* NS = (LAS float*)(C.lds + ML_NS); const LAS bf16* KWT = (const LAS bf16*)(C.lds + ML_KWT); float s = 0.f;
#pragma unroll
        for (int i = 0; i < 8; ++i) { const u32x4 a = *(const LAS u32x4*)(KWT + tid * ML_TSTR + 8 * i); s += (bflo(a.x) + bfhi(a.x)) + (bflo(a.y) + bfhi(a.y)) + (bflo(a.z) + bfhi(a.z)) + (bflo(a.w) + bfhi(a.w)); }
        NS[tid] = decay * NS[tid] + s; }
}

DI void mlstm_m1(Ctx& C, int mj) {
    const bf16* proj = WSP(bf16, WS_PROJ);
    LAS float* AP = (LAS float*)(C.lds + ML_AP); LAS float* FL = (LAS float*)(C.lds + ML_FL); LAS float* MR = (LAS float*)(C.lds + ML_MR); LAS float* NS = (LAS float*)(C.lds + ML_NS);
    LAS float* CW = (LAS float*)(C.lds + ML_CW); LAS bf16* KWT = (LAS bf16*)(C.lds + ML_KWT);
    const int wave = C.wave;
    for (int item = C.vcu; item < 8 * M_NSEG; item += C.G) {
        const int bh = item / M_NSEG, seg = item % M_NSEG, b = bh >> 2, h = bh & 3; const size_t tok_seg = (size_t)b * SEQ + seg * M_SEGT;
        __syncthreads();
        mlstm_load_cw(C, mj, h);
        if (C.tid < 128) NS[C.tid] = 0.f;
        mlstm_seg_scalars(C, mj, bh, seg);
        f32x4 acc[8][2];
#pragma unroll
        for (int dt = 0; dt < 8; ++dt) { acc[dt][0] = (f32x4){0.f, 0.f, 0.f, 0.f}; acc[dt][1] = (f32x4){0.f, 0.f, 0.f, 0.f}; }
        for (int c = 0; c < M_SEGC; ++c) {
            int tz = threadIdx.x; asm volatile("" : "+v"(tz)); const int lane = tz & 63;
            const float mnew = MR[64 * c + 63], mold = (c == 0) ? -1.0e30f : MR[64 * c - 1];
            const float decay = __expf(mold - mnew);
            { const int s = lane; const float wgt = __expf(AP[64 * c + s] - mnew); float o[16];
              mlstm_conv16(proj, tok_seg + 64 * c + s, seg * M_SEGT + 64 * c + s, 512 + h * 128 + wave * 16, CW + 640 + wave * 16, o);
#pragma unroll
              for (int dd = 0; dd < 16; ++dd) KWT[(wave * 16 + dd) * ML_TSTR + s] = (bf16)f2bf(o[dd] * 0.08838834764831845f * wgt); }
            mlstm_load_vt(C, proj, tok_seg + 64 * c, h, lane);
            __syncthreads();
            mlstm_n_update(C, decay, tz);
            mlstm_state_update(C, acc, decay, lane);
            __syncthreads();
        }
        float* dst = WSP(float, WS_SLOC) + (size_t)item * M_STATE;
#pragma unroll
        for (int dt = 0; dt < 8; ++dt)
#pragma unroll
            for (int vtl = 0; vtl < 2; ++vtl)
#pragma unroll
                for (int r = 0; r < 4; ++r) dst[(((wave * 8 + dt) * 2 + vtl) * 4 + r) * 64 + C.lane] = acc[dt][vtl][r];
        if (C.tid < 128) dst[32768 + C.tid] = NS[C.tid];
        if (C.tid == 0) { WSP(float, WS_SEGF)[item] = FL[511]; WSP(float, WS_SEGM)[item] = MR[511]; }
    }
}
DI void mlstm_m15(Ctx& C) {
    LAS float* DEC = (LAS float*)C.lds; LAS float* SCL = DEC + 256;
    __syncthreads();
    if (C.tid < 8) { const int bh = C.tid; float F0 = 0.f, M0 = 0.f;
        for (int seg = 0; seg < M_NSEG; ++seg) { const float cand = WSP(float, WS_SEGM)[bh * M_NSEG + seg] - F0, mn = fmaxf(M0, cand);
            DEC[bh * 32 + seg] = __expf(M0 - mn); SCL[bh * 32 + seg] = __expf(cand - mn); F0 += WSP(float, WS_SEGF)[bh * M_NSEG + seg]; M0 = mn; } }
    __syncthreads();
    const int gt = C.vcu * 512 + C.tid, NGT = C.G * 512;
    for (int i = gt; i < 8 * M_STATE; i += NGT) { const int bh = i / M_STATE, e = i % M_STATE; float s = 0.f;
        const float* src = WSP(float, WS_SLOC) + (size_t)bh * M_NSEG * M_STATE + e; float* dst = WSP(float, WS_SINIT) + (size_t)bh * M_NSEG * M_STATE + e;
        for (int seg = 0; seg < M_NSEG; ++seg) { dst[(size_t)seg * M_STATE] = s; s = s * DEC[bh * 32 + seg] + SCL[bh * 32 + seg] * src[(size_t)seg * M_STATE]; } }
}
DI void mlstm_m2(Ctx& C, int mj) {
    const bf16* proj = WSP(bf16, WS_PROJ);
    LAS bf16* QS = (LAS bf16*)(C.lds + ML_QS); LAS bf16* KS = (LAS bf16*)(C.lds + ML_KS); LAS bf16* VT = (LAS bf16*)(C.lds + ML_VT); LAS bf16* KWT = (LAS bf16*)(C.lds + ML_KWT);
    LAS bf16* WM = (LAS bf16*)(C.lds + ML_WM); LAS bf16* HOUT = (LAS bf16*)(C.lds + ML_QS);
    LAS float* CW = (LAS float*)(C.lds + ML_CW); LAS float* AP = (LAS float*)(C.lds + ML_AP); LAS float* FL = (LAS float*)(C.lds + ML_FL); LAS float* MR = (LAS float*)(C.lds + ML_MR);
    LAS float* AG = (LAS float*)(C.lds + ML_CH); LAS float* MG = AG + 64; LAS float* FAC = AG + 128; LAS float* EMT = AG + 192; LAS float* DEN = AG + 256; LAS float* QN = AG + 320;
    LAS float* NS = (LAS float*)(C.lds + ML_NS); LAS f32x2* STP = (LAS f32x2*)(C.lds + ML_STP); LAS f32x2* MRS = (LAS f32x2*)(C.lds + ML_MRS); LAS float* TMP = (LAS float*)(C.lds + ML_TMP);
    const int wave = C.wave;
    for (int item = C.vcu; item < 8 * M_NSEG; item += C.G) {
        const int bh = item / M_NSEG, seg = item % M_NSEG, b = bh >> 2, h = bh & 3; const size_t tok_seg = (size_t)b * SEQ + seg * M_SEGT;
        __syncthreads();
        mlstm_load_cw(C, mj, h);
        if (C.tid == 0) { float F0 = 0.f, M0 = 0.f;
            for (int sg = 0; sg < seg; ++sg) { M0 = fmaxf(M0, WSP(float, WS_SEGM)[bh * M_NSEG + sg] - F0); F0 += WSP(float, WS_SEGF)[bh * M_NSEG + sg]; }
            TMP[32] = F0; TMP[33] = M0; }
        mlstm_seg_scalars(C, mj, bh, seg);
        const float Fseg0 = TMP[32], Mseg0 = TMP[33];
        f32x4 acc[8][2];
        { const float* src = WSP(float, WS_SINIT) + (size_t)item * M_STATE;
#pragma unroll
          for (int dt = 0; dt < 8; ++dt)
#pragma unroll
              for (int vtl = 0; vtl < 2; ++vtl)
#pragma unroll
                  for (int r = 0; r < 4; ++r) acc[dt][vtl][r] = src[(((wave * 8 + dt) * 2 + vtl) * 4 + r) * 64 + C.lane];
          if (C.tid < 128) NS[C.tid] = src[32768 + C.tid]; }
        for (int c = 0; c < M_SEGC; ++c) {
            int tz = threadIdx.x; asm volatile("" : "+v"(tz)); const int tid = tz, lane = tz & 63, fr = lane & 15, q = lane >> 4;
            const size_t tok0 = tok_seg + 64 * c;
            const float Mc0 = (c == 0) ? Mseg0 : fmaxf(Mseg0, MR[64 * c - 1] - Fseg0);
            const float Mend = fmaxf(Mseg0, MR[64 * c + 63] - Fseg0);
            const float decay = __expf(Mc0 - Mend);
            { const int s = lane; const float ag = AP[64 * c + s] - Fseg0; const float wgt = __expf(ag - Mend); float o[16];
              if (wave == 0) { const float mt = fmaxf(Mseg0, MR[64 * c + s] - Fseg0); AG[s] = ag; MG[s] = mt; FAC[s] = __expf(Mc0 - mt); EMT[s] = __expf(-(Fseg0 + FL[64 * c + s] + mt)); DEN[s] = 0.f; }
              mlstm_conv16(proj, tok0 + s, seg * M_SEGT + 64 * c + s, h * 128 + wave * 16, CW + wave * 16, o);
              { u32x4 w0, w1; w0.x = pk2(o[0], o[1]); w0.y = pk2(o[2], o[3]); w0.z = pk2(o[4], o[5]); w0.w = pk2(o[6], o[7]); w1.x = pk2(o[8], o[9]); w1.y = pk2(o[10], o[11]); w1.z = pk2(o[12], o[13]); w1.w = pk2(o[14], o[15]);
                *(LAS u32x4*)(QS + s * ML_QSTR + wave * 16) = w0; *(LAS u32x4*)(QS + s * ML_QSTR + wave * 16 + 8) = w1; }
              asm volatile("" ::: "memory");
              mlstm_conv16(proj, tok0 + s, seg * M_SEGT + 64 * c + s, 512 + h * 128 + wave * 16, CW + 640 + wave * 16, o);
#pragma unroll
              for (int dd = 0; dd < 16; ++dd) o[dd] *= 0.08838834764831845f;
              { u32x4 w0, w1; w0.x = pk2(o[0], o[1]); w0.y = pk2(o[2], o[3]); w0.z = pk2(o[4], o[5]); w0.w = pk2(o[6], o[7]); w1.x = pk2(o[8], o[9]); w1.y = pk2(o[10], o[11]); w1.z = pk2(o[12], o[13]); w1.w = pk2(o[14], o[15]);
                *(LAS u32x4*)(KS + s * ML_QSTR + wave * 16) = w0; *(LAS u32x4*)(KS + s * ML_QSTR + wave * 16 + 8) = w1; }
#pragma unroll
              for (int dd = 0; dd < 16; ++dd) KWT[(wave * 16 + dd) * ML_TSTR + s] = (bf16)f2bf(o[dd] * wgt); }
            asm volatile("" ::: "memory");
            mlstm_load_vt(C, proj, tok0, h, lane);
            __syncthreads();
            { const int tt = wave >> 1, st0 = (wave & 1) * 2; f32x4 d0 = {0.f, 0.f, 0.f, 0.f}, d1 = {0.f, 0.f, 0.f, 0.f};
#pragma unroll
              for (int ks = 0; ks < 4; ++ks) { const bf16x8 a = *(const LAS bf16x8*)(QS + (tt * 16 + fr) * ML_QSTR + ks * 32 + 8 * q);
                  const bf16x8 b0 = *(const LAS bf16x8*)(KS + (st0 * 16 + fr) * ML_QSTR + ks * 32 + 8 * q), b1 = *(const LAS bf16x8*)(KS + ((st0 + 1) * 16 + fr) * ML_QSTR + ks * 32 + 8 * q);
                  d0 = MMA(a, b0, d0); d1 = MMA(a, b1, d1); }
              const int s0 = st0 * 16 + fr, s1 = s0 + 16; const float a0 = AG[s0], a1 = AG[s1];
#pragma unroll
              for (int r = 0; r < 4; ++r) { const int t = tt * 16 + 4 * q + r; const float mt = MG[t];
                  const float w0 = (s0 <= t) ? __expf(a0 - mt) * d0[r] : 0.f, w1 = (s1 <= t) ? __expf(a1 - mt) * d1[r] : 0.f;
                  WM[t * ML_TSTR + s0] = (bf16)f2bf(w0); WM[t * ML_TSTR + s1] = (bf16)f2bf(w1);
                  float ps = w0 + w1; ps += __shfl_xor(ps, 1); ps += __shfl_xor(ps, 2); ps += __shfl_xor(ps, 4); ps += __shfl_xor(ps, 8);
                  if (fr == 0) __hip_atomic_fetch_add(DEN + t, ps, __ATOMIC_RELAXED, __HIP_MEMORY_SCOPE_WORKGROUP); } }
            { const int t = tid >> 3, part = tid & 7; float s = 0.f;
              const u32x4 a = *(const LAS u32x4*)(QS + t * ML_QSTR + part * 16), b2 = *(const LAS u32x4*)(QS + t * ML_QSTR + part * 16 + 8); const LAS float* np = NS + part * 16;
              s += bflo(a.x) * np[0] + bfhi(a.x) * np[1] + bflo(a.y) * np[2] + bfhi(a.y) * np[3] + bflo(a.z) * np[4] + bfhi(a.z) * np[5] + bflo(a.w) * np[6] + bfhi(a.w) * np[7];
              s += bflo(b2.x) * np[8] + bfhi(b2.x) * np[9] + bflo(b2.y) * np[10] + bfhi(b2.y) * np[11] + bflo(b2.z) * np[12] + bfhi(b2.z) * np[13] + bflo(b2.w) * np[14] + bfhi(b2.w) * np[15];
              s += __shfl_xor(s, 1); s += __shfl_xor(s, 2); s += __shfl_xor(s, 4);
              if (part == 0) QN[t] = s; }
            __syncthreads();
            f32x4 num[4][2];
#pragma unroll
            for (int tt = 0; tt < 4; ++tt) { num[tt][0] = (f32x4){0.f, 0.f, 0.f, 0.f}; num[tt][1] = (f32x4){0.f, 0.f, 0.f, 0.f}; }
#pragma unroll
            for (int ks = 0; ks < 4; ++ks) {
                u32x4 p0, p1;
                p0.x = pk2(acc[2 * ks][0][0], acc[2 * ks][0][1]); p0.y = pk2(acc[2 * ks][0][2], acc[2 * ks][0][3]); p0.z = pk2(acc[2 * ks + 1][0][0], acc[2 * ks + 1][0][1]); p0.w = pk2(acc[2 * ks + 1][0][2], acc[2 * ks + 1][0][3]);
                p1.x = pk2(acc[2 * ks][1][0], acc[2 * ks][1][1]); p1.y = pk2(acc[2 * ks][1][2], acc[2 * ks][1][3]); p1.z = pk2(acc[2 * ks + 1][1][0], acc[2 * ks + 1][1][1]); p1.w = pk2(acc[2 * ks + 1][1][2], acc[2 * ks + 1][1][3]);
                const bf16x8 b0 = __builtin_bit_cast(bf16x8, p0), b1 = __builtin_bit_cast(bf16x8, p1);
#pragma unroll
                for (int tt = 0; tt < 4; ++tt) { const LAS bf16* qp = QS + (tt * 16 + fr) * ML_QSTR + 4 * q;
                    const u32x2 lo = *(const LAS u32x2*)(qp + (2 * ks) * 16), hi = *(const LAS u32x2*)(qp + (2 * ks + 1) * 16);
                    u32x4 av; av.x = lo.x; av.y = lo.y; av.z = hi.x; av.w = hi.y; const bf16x8 a = __builtin_bit_cast(bf16x8, av);
                    num[tt][0] = MMA(a, b0, num[tt][0]); num[tt][1] = MMA(a, b1, num[tt][1]); }
            }
#pragma unroll
            for (int tt = 0; tt < 4; ++tt)
#pragma unroll
                for (int r = 0; r < 4; ++r) { const float f = FAC[tt * 16 + 4 * q + r]; num[tt][0][r] *= f; num[tt][1][r] *= f; }
#pragma unroll
            for (int ks = 0; ks < 2; ++ks) {
                const bf16x8 b0 = *(const LAS bf16x8*)(VT + ((2 * wave) * 16 + fr) * ML_TSTR + ks * 32 + 8 * q), b1 = *(const LAS bf16x8*)(VT + ((2 * wave + 1) * 16 + fr) * ML_TSTR + ks * 32 + 8 * q);
#pragma unroll
                for (int tt = 0; tt < 4; ++tt) { const bf16x8 a = *(const LAS bf16x8*)(WM + (tt * 16 + fr) * ML_TSTR + ks * 32 + 8 * q);
                    num[tt][0] = MMA(a, b0, num[tt][0]); num[tt][1] = MMA(a, b1, num[tt][1]); }
            }
#pragma unroll
            for (int tt = 0; tt < 4; ++tt)
#pragma unroll
                for (int r = 0; r < 4; ++r) { asm volatile("" ::: "memory"); const int t = tt * 16 + 4 * q + r; const float den = DEN[t] + FAC[t] * QN[t]; const float inv = 1.0f / fmaxf(fabsf(den), EMT[t]);
                    const float h0 = num[tt][0][r] * inv, h1 = num[tt][1][r] * inv; num[tt][0][r] = h0; num[tt][1][r] = h1;
                    float s1 = h0 + h1, s2 = h0 * h0 + h1 * h1;
                    s1 += __shfl_xor(s1, 1); s2 += __shfl_xor(s2, 1); s1 += __shfl_xor(s1, 2); s2 += __shfl_xor(s2, 2); s1 += __shfl_xor(s1, 4); s2 += __shfl_xor(s2, 4); s1 += __shfl_xor(s1, 8); s2 += __shfl_xor(s2, 8);
                    if (fr == 0) STP[t * 8 + wave] = (f32x2){s1, s2}; }
            mlstm_n_update(C, decay, tid);
            mlstm_state_update(C, acc, decay, lane);
            __syncthreads();
            if (tid < 64) { float s1 = 0.f, s2 = 0.f;
#pragma unroll
                for (int w = 0; w < 8; ++w) { const f32x2 p = STP[tid * 8 + w]; s1 += p.x; s2 += p.y; }
                const float mean = s1 * (1.0f / 256.0f), var = fmaxf(s2 * (1.0f / 256.0f) - mean * mean, 0.f); MRS[tid] = (f32x2){mean, 1.0f / sqrtf(var + LN_EPS)}; }
            __syncthreads();
#pragma unroll
            for (int tt = 0; tt < 4; ++tt)
#pragma unroll
                for (int r = 0; r < 4; ++r) { const int t = tt * 16 + 4 * q + r; const f32x2 mr = MRS[t];
                    HOUT[t * ML_HSTR + (2 * wave) * 16 + fr] = (bf16)f2bf((num[tt][0][r] - mr.x) * mr.y); HOUT[t * ML_HSTR + (2 * wave + 1) * 16 + fr] = (bf16)f2bf((num[tt][1][r] - mr.x) * mr.y); }
            __syncthreads();
            { const int t = tid >> 3, c8 = tid & 7; const float* ng = C.in[12] + (size_t)mj * 1024 + h * 256;
#pragma unroll 1
              for (int jj = 0; jj < 4; ++jj) { const int col = (c8 + 8 * jj) * 8;
                  const u32x4 hv = *(const LAS u32x4*)(HOUT + t * ML_HSTR + col); const u32x4 ov = *(const u32x4*)(proj + (tok0 + t) * M_NIN + 2048 + h * 256 + col);
                  const f32x4 g0 = *(const f32x4*)(ng + col), g1 = *(const f32x4*)(ng + col + 4);
                  u32x4 w;
                  w.x = pk2(bflo(hv.x) * g0.x * sigmoidf_(bflo(ov.x)), bfhi(hv.x) * g0.y * sigmoidf_(bfhi(ov.x))); w.y = pk2(bflo(hv.y) * g0.z * sigmoidf_(bflo(ov.y)), bfhi(hv.y) * g0.w * sigmoidf_(bfhi(ov.y)));
                  w.z = pk2(bflo(hv.z) * g1.x * sigmoidf_(bflo(ov.z)), bfhi(hv.z) * g1.y * sigmoidf_(bfhi(ov.z))); w.w = pk2(bflo(hv.w) * g1.z * sigmoidf_(bflo(ov.w)), bfhi(hv.w) * g1.w * sigmoidf_(bfhi(ov.w)));
                  *(u32x4*)(WSP(bf16, WS_MIXA) + (tok0 + t) * D + h * 256 + col) = w; } }
            __syncthreads();
        }
    }
}

constexpr int S5_BUSTR = 132, S5_XSTR = 136, S5_WAVE_LDS = 16 * S5_BUSTR * 4 + 16 * S5_XSTR * 2;
static_assert(8 * S5_WAVE_LDS <= RING_BYTES, "s5 LDS");
DI float gelu_tanh(float x) { const float z = 0.7978845608028654f * (x + 0.044715f * x * x * x); return x * (1.0f - 1.0f / (1.0f + __expf(2.0f * z))); }

template <int PASS> DI void s5_pass(Ctx& C) {
    const int lane = C.lane, wave = C.wave, fr = lane & 15, q = lane >> 4;
    LAS float* BU = (LAS float*)(C.lds + wave * S5_WAVE_LDS); LAS bf16* XS = (LAS bf16*)(C.lds + wave * S5_WAVE_LDS + 16 * S5_BUSTR * 4);
    const bf16* U = WSP(bf16, WS_PROJ);
    for (int wi = C.vcu; wi < 2 * S5_NSEG * 8; wi += C.G) {
        const int g = (wi & 7) * 8 + wave, bs = wi >> 3, b = bs / S5_NSEG, seg = bs % S5_NSEG; const size_t tokbase = (size_t)b * SEQ + seg * S5_SEGT;
        const float ar = WSP(float, WS_S5ABAR)[(g * 64 + lane) * 2], ai = WSP(float, WS_S5ABAR)[(g * 64 + lane) * 2 + 1];
        bf16x8 bB[8];
#pragma unroll
        for (int nt = 0; nt < 8; ++nt) { bB[nt] = (bf16x8){0, 0, 0, 0, 0, 0, 0, 0}; if (q < 2) bB[nt] = *(const bf16x8*)(WSP(bf16, WS_S5BBT) + ((size_t)g * 128 + nt * 16 + fr) * 16 + 8 * q); }
        bf16x8 cB[4]; float xr = 0.f, xi = 0.f, dsk = 0.f;
        if constexpr (PASS == 2) {
#pragma unroll
            for (int ks = 0; ks < 4; ++ks) cB[ks] = *(const bf16x8*)(WSP(bf16, WS_S5CMT) + ((size_t)g * 16 + fr) * 128 + ks * 32 + 8 * q);
            dsk = C.in[22][g * 16 + fr];
            if (seg > 0) { const float dt = expf(C.in[17][g]), lr = C.in[15][g * 64 + lane], li = C.in[16][g * 64 + lane];
                const float mg = expf(lr * dt * (float)S5_SEGT); float sn, cs; sincosf(li * dt * (float)S5_SEGT, &sn, &cs); const float pr = mg * cs, pi = mg * sn;
                const float* en = WSP(float, WS_S5END) + (((size_t)b * 64 + g) * S5_NSEG) * 128 + lane * 2;
                for (int sp = 0; sp < seg; ++sp) { const float er = en[sp * 128], ei = en[sp * 128 + 1]; const float nr = pr * xr - pi * xi + er, ni = pr * xi + pi * xr + ei; xr = nr; xi = ni; } }
        }
        for (int sub = 0; sub < S5_SEGT / 16; ++sub) {
            const size_t tok0 = tokbase + sub * 16;
            bf16x8 a = (bf16x8){0, 0, 0, 0, 0, 0, 0, 0};
            if (q < 2) a = *(const bf16x8*)(U + (tok0 + fr) * D + g * 16 + 8 * q);
#pragma unroll
            for (int nt = 0; nt < 8; ++nt) { const f32x4 d = MMA(a, bB[nt], (f32x4){0.f, 0.f, 0.f, 0.f});
#pragma unroll
                for (int r = 0; r < 4; ++r) BU[(4 * q + r) * S5_BUSTR + nt * 16 + fr] = d[r]; }
            asm volatile("s_waitcnt lgkmcnt(0)" ::: "memory");
#pragma unroll
            for (int t = 0; t < 16; ++t) { const float br = BU[t * S5_BUSTR + lane], bi = BU[t * S5_BUSTR + 64 + lane];
                const float nr = ar * xr - ai * xi + br, ni = ar * xi + ai * xr + bi; xr = nr; xi = ni;
                if constexpr (PASS == 2) { XS[t * S5_XSTR + lane] = (bf16)f2bf(xr); XS[t * S5_XSTR + 64 + lane] = (bf16)f2bf(xi); } }
            if constexpr (PASS == 2) {
                asm volatile("s_waitcnt lgkmcnt(0)" ::: "memory");
                f32x4 y = {0.f, 0.f, 0.f, 0.f};
#pragma unroll
                for (int ks = 0; ks < 4; ++ks) { const bf16x8 xa = *(const LAS bf16x8*)(XS + fr * S5_XSTR + ks * 32 + 8 * q); y = MMA(xa, cB[ks], y); }
#pragma unroll
                for (int r = 0; r < 4; ++r) { const size_t o = (tok0 + 4 * q + r) * D + g * 16 + fr; const float uv = bf2f(U[o]);
                    WSP(bf16, WS_MIXA)[o] = (bf16)f2bf(gelu_tanh(y[r] + dsk * uv)); }
            }
            asm volatile("s_waitcnt lgkmcnt(0)" ::: "memory");
        }
        if constexpr (PASS == 1) { float* en = WSP(float, WS_S5END) + ((((size_t)b * 64 + g) * S5_NSEG) + seg) * 128 + lane * 2; en[0] = xr; en[1] = xi; }
    }
}

constexpr int AT_KSTR = 72, AT_VSTR = 200, AT_KS = 0, AT_VT = 192 * AT_KSTR * 2, AT_END = AT_VT + 64 * AT_VSTR * 2;
static_assert(AT_END <= RING_BYTES, "attn LDS");
DI void swa_phase(Ctx& C) {
    const bf16* QKV = WSP(bf16, WS_PROJ);
    LAS bf16* KS = (LAS bf16*)(C.lds + AT_KS); LAS bf16* VT = (LAS bf16*)(C.lds + AT_VT);
    const int lane = C.lane, wave = C.wave, tid = C.tid, fr = lane & 15, q = lane >> 4;
    for (int item = C.vcu; item < BATCH * A_KV * (SEQ / 64); item += C.G) {
        const int qb = item % (SEQ / 64), kvh = (item / (SEQ / 64)) % A_KV, b = item / ((SEQ / 64) * A_KV); const int q0 = qb * 64; const size_t tokb = (size_t)b * SEQ;
        __syncthreads();
#pragma unroll
        for (int i = 0; i < 3; ++i) { const int kk = (tid >> 3) + 64 * i, ch = tid & 7, kp = q0 - 128 + kk; u32x4 v = {0u, 0u, 0u, 0u};
            if (kp >= 0) v = *(const u32x4*)(QKV + (tokb + kp) * A_NQKV + 1024 + kvh * 64 + ch * 8);
            *(LAS u32x4*)(KS + kk * AT_KSTR + ch * 8) = v; }
#pragma unroll
        for (int i = 0; i < 3; ++i) { const int kk = lane + 64 * i, kp = q0 - 128 + kk; u32x4 v = {0u, 0u, 0u, 0u};
            if (kp >= 0) v = *(const u32x4*)(QKV + (tokb + kp) * A_NQKV + 1280 + kvh * 64 + wave * 8);
            const unsigned w[4] = {v.x, v.y, v.z, v.w};
#pragma unroll
            for (int e = 0; e < 4; ++e) { VT[(wave * 8 + 2 * e) * AT_VSTR + kk] = (bf16)(w[e] & 0xffffu); VT[(wave * 8 + 2 * e + 1) * AT_VSTR + kk] = (bf16)(w[e] >> 16); } }
        __syncthreads();
        const int g = wave >> 1, head = kvh * 4 + g; const float sink = C.in[26][head];
#pragma unroll 1
        for (int rt = 0; rt < 2; ++rt) {
            const int r0 = (wave & 1) * 32 + rt * 16, kt0 = r0 >> 4; const size_t tq = tokb + q0 + r0 + fr;
            const bf16x8 qf0 = *(const bf16x8*)(QKV + tq * A_NQKV + head * 64 + 8 * q), qf1 = *(const bf16x8*)(QKV + tq * A_NQKV + head * 64 + 32 + 8 * q);
            f32x4 s[9];
#pragma unroll
            for (int kt = 0; kt < 9; ++kt) { const LAS bf16* kp_ = KS + ((kt0 + kt) * 16 + fr) * AT_KSTR + 8 * q;
                s[kt] = MMA(*(const LAS bf16x8*)kp_, qf0, (f32x4){0.f, 0.f, 0.f, 0.f}); s[kt] = MMA(*(const LAS bf16x8*)(kp_ + 32), qf1, s[kt]); }
            float m = sink;
#pragma unroll
            for (int kt = 0; kt < 9; ++kt)
#pragma unroll
                for (int r = 0; r < 4; ++r) { const int kk = (kt0 + kt) * 16 + 4 * q + r; const bool ok = (kk > r0 + fr) && (kk <= r0 + fr + 128) && (q0 - 128 + kk >= 0);
                    s[kt][r] = ok ? s[kt][r] * 0.125f : -3.0e38f; m = fmaxf(m, s[kt][r]); }
            m = fmaxf(m, __shfl_xor(m, 16)); m = fmaxf(m, __shfl_xor(m, 32));
            float l = 0.f;
#pragma unroll
            for (int kt = 0; kt < 9; ++kt)
#pragma unroll
                for (int r = 0; r < 4; ++r) { const float p = __expf(s[kt][r] - m); s[kt][r] = p; l += p; }
            l += __shfl_xor(l, 16); l += __shfl_xor(l, 32);
            const float inv = 1.0f / (l + __expf(sink - m));
            f32x4 o[4];
#pragma unroll
            for (int dt = 0; dt < 4; ++dt) o[dt] = (f32x4){0.f, 0.f, 0.f, 0.f};
#pragma unroll
            for (int pr = 0; pr < 5; ++pr) { const int ka = 2 * pr, kb = 2 * pr + 1;
                u32x4 pw; pw.x = pk2(s[ka][0] * inv, s[ka][1] * inv); pw.y = pk2(s[ka][2] * inv, s[ka][3] * inv);
                if (kb < 9) { pw.z = pk2(s[kb < 9 ? kb : 8][0] * inv, s[kb < 9 ? kb : 8][1] * inv); pw.w = pk2(s[kb < 9 ? kb : 8][2] * inv, s[kb < 9 ? kb : 8][3] * inv); } else { pw.z = 0u; pw.w = 0u; }
                const bf16x8 pb = __builtin_bit_cast(bf16x8, pw);
#pragma unroll
                for (int dt = 0; dt < 4; ++dt) { const LAS bf16* vp = VT + (dt * 16 + fr) * AT_VSTR + 4 * q;
                    const u32x2 lo = *(const LAS u32x2*)(vp + (kt0 + ka) * 16); u32x2 hi = {0u, 0u}; if (kb < 9) hi = *(const LAS u32x2*)(vp + (kt0 + (kb < 9 ? kb : 8)) * 16);
                    u32x4 av; av.x = lo.x; av.y = lo.y; av.z = hi.x; av.w = hi.y;
                    o[dt] = MMA(__builtin_bit_cast(bf16x8, av), pb, o[dt]); } }
            bf16* orow = WSP(bf16, WS_MIXA) + tq * D + head * 64 + 4 * q;
#pragma unroll
            for (int dt = 0; dt < 4; ++dt) { u32x2 w; w.x = pk2(o[dt][0], o[dt][1]); w.y = pk2(o[dt][2], o[dt][3]); *(u32x2*)(orow + dt * 16) = w; }
        }
    }
}

template <class Epi> DI void dense_gemm(Ctx& C, const bf16* A, const bf16* Bt, int N, int K, const Epi& E) {
    pg8::Gemm g{A, Bt, T, N, K}; pg8::StaticOrder S; S.init(T, N, C.G, (int)blockIdx.x);
    pg8::gemm_phase<Epi, pg8::StaticOrder, true, true>(C.lds, g, S, E);
}
DI void moe_gemm1(Ctx& C, int layer) {
    const int nunits = moe_tables(C, layer);
    pg8::Gemm g{WSP(bf16, WS_HIN), WSP(bf16, WS_W13) + (size_t)layer * N_EXP * D * D, MOE_P, D, D};
    pg8::MoeOrder S{(const LAS int*)(C.lds + MISC_OFF), C.G, (int)blockIdx.x, nunits, WSP(int, WS_ELIST)};
    pg8::EpiPair<0> E{WSP(bf16, WS_HID), D_EXP, 3};
    pg8::gemm_phase<pg8::EpiPair<0>, pg8::MoeOrder, true, true, true>(C.lds, g, S, E);
}
DI void moe_gemm2(Ctx& C, int layer) {
    const int nunits = moe_tables(C, layer);
    pg8::Gemm g{WSP(bf16, WS_HID), WSP(bf16, WS_W2) + (size_t)layer * N_EXP * D * D_EXP, MOE_P, D, D_EXP};
    pg8::MoeOrder S{(const LAS int*)(C.lds + MISC_OFF), C.G, (int)blockIdx.x, nunits, nullptr};
    pg8::EpiStore E{WSP(bf16, WS_YEXP), D, nullptr, 3};
    pg8::gemm_phase<pg8::EpiStore, pg8::MoeOrder, true, true>(C.lds, g, S, E);
}

constexpr int N_PHASES = 35;
#ifndef REP_MASK
#define REP_MASK 0
#endif
struct Args { const float* in[35]; float* out; unsigned char* ws; int ph_lo, ph_hi, li, pad; };
__global__ void __launch_bounds__(512, 2) fwd(Args args) {
    extern __shared__ __attribute__((aligned(16))) unsigned char lds_raw[];
    Ctx C;
    C.lds = (LAS unsigned char*)lds_raw; C.ws = args.ws; C.ctl = (unsigned*)(args.ws + WS_CTL); C.out = args.out;
    C.in = args.in;
    C.tid = threadIdx.x; C.lane = C.tid & 63; C.wave = __builtin_amdgcn_readfirstlane(C.tid >> 6);
    C.G = gridDim.x; { const int bx = blockIdx.x; C.vcu = (C.G % 8 == 0) ? (bx % 8) * (C.G / 8) + bx / 8 : bx; }
    volatile LAS unsigned* xbw = (volatile LAS unsigned*)(C.lds + MISC_OFF + 512);
    if (C.tid < 4) xbw[C.tid] = 0u;
    __syncthreads();
    const int lo = args.ph_lo, hi = args.ph_hi;
    XcdBarrier bar; bar.bar = C.ctl + CW_BAR + args.li * XCD_BAR_WORDS; bar.x = 0; bar.st = xbw;
    if (hi - lo > 1) bar = xcd_barrier_post(C.ctl + CW_BAR + args.li * XCD_BAR_WORDS, xbw);
#ifdef PH_ONLY
#define IN(k) ((k) == PH_ONLY && lo <= (k) && (k) < hi)
#else
#define IN(k) (lo <= (k) && (k) < hi)
#endif
#define SEAM(k) do { if (IN(k) && IN((k) + 1)) xcd_barrier(bar); else __syncthreads(); } while (0)
    bf16* HIN = WSP(bf16, WS_HIN); bf16* PROJ = WSP(bf16, WS_PROJ); bf16* MIXA = WSP(bf16, WS_MIXA); bf16* YMIX = WSP(bf16, WS_YMIX);

    if (IN(0)) for (int rep_ = 0; rep_ < ((REP_MASK & 32) ? 2 : 1); ++rep_) { p0a_weights(C); __syncthreads(); } SEAM(0);
    if (IN(1)) for (int rep_ = 0; rep_ < ((REP_MASK & 128) ? 2 : 1); ++rep_) { row_phase<0, 1, true>(C, C.in[0], 0, 0, nullptr, nullptr, 0, 1, 0, 0); __syncthreads(); } SEAM(1);

    if (IN(2)) for (int rep_ = 0; rep_ < ((REP_MASK & 1) ? 2 : 1); ++rep_) { pg8::EpiStore E{PROJ, M_NIN, nullptr, -1}; dense_gemm(C, HIN, WSP(bf16, WS_WMIN), M_NIN, D, E); __syncthreads(); } SEAM(2);
    if (IN(3)) for (int rep_ = 0; rep_ < ((REP_MASK & 4) ? 2 : 1); ++rep_) { mlstm_m1(C, 0); __syncthreads(); } SEAM(3);
    if (IN(4)) for (int rep_ = 0; rep_ < ((REP_MASK & 4) ? 2 : 1); ++rep_) { mlstm_m15(C); __syncthreads(); } SEAM(4);
    if (IN(5)) for (int rep_ = 0; rep_ < ((REP_MASK & 4) ? 2 : 1); ++rep_) { mlstm_m2(C, 0); __syncthreads(); } SEAM(5);
    if (IN(6)) for (int rep_ = 0; rep_ < ((REP_MASK & 1) ? 2 : 1); ++rep_) { pg8::EpiStore E{YMIX, D, nullptr, -1}; dense_gemm(C, MIXA, WSP(bf16, WS_WMOUT), D, D, E); __syncthreads(); } SEAM(6);
    if (IN(7)) { row_phase<1, 3, true>(C, C.in[0], 0, 2, C.in[4], C.in[5], 0, 4, 3, 0); } SEAM(7);
    if (IN(8)) for (int rep_ = 0; rep_ < ((REP_MASK & 2) ? 2 : 1); ++rep_) { moe_gemm1(C, 0); __syncthreads(); } SEAM(8);
    if (IN(9)) for (int rep_ = 0; rep_ < ((REP_MASK & 2) ? 2 : 1); ++rep_) { moe_gemm2(C, 0); __syncthreads(); } SEAM(9);
    if (IN(10)) { row_phase<2, 0, true>(C, C.out, 0, 5, C.in[6], C.in[7], 1, 1, 0, 0); } SEAM(10);

    if (IN(11)) for (int rep_ = 0; rep_ < ((REP_MASK & 1) ? 2 : 1); ++rep_) { pg8::EpiStore E{PROJ, D, nullptr, -1}; dense_gemm(C, HIN, WSP(bf16, WS_WS5IN), D, D, E); __syncthreads(); } SEAM(11);
    if (IN(12)) for (int rep_ = 0; rep_ < ((REP_MASK & 8) ? 2 : 1); ++rep_) { s5_pass<1>(C); __syncthreads(); } SEAM(12);
    if (IN(13)) for (int rep_ = 0; rep_ < ((REP_MASK & 8) ? 2 : 1); ++rep_) { s5_pass<2>(C); __syncthreads(); } SEAM(13);
    if (IN(14)) for (int rep_ = 0; rep_ < ((REP_MASK & 1) ? 2 : 1); ++rep_) { pg8::EpiPair<1> E{YMIX, D, -1}; dense_gemm(C, MIXA, WSP(bf16, WS_WS5GLU), 2 * D, D, E); __syncthreads(); } SEAM(14);
    if (IN(15)) { row_phase<1, 3, true>(C, C.out, 1, 2, C.in[4] + D, C.in[5] + D, 1, 4, 3, 0); } SEAM(15);
    if (IN(16)) for (int rep_ = 0; rep_ < ((REP_MASK & 2) ? 2 : 1); ++rep_) { moe_gemm1(C, 1); __syncthreads(); } SEAM(16);
    if (IN(17)) for (int rep_ = 0; rep_ < ((REP_MASK & 2) ? 2 : 1); ++rep_) { moe_gemm2(C, 1); __syncthreads(); } SEAM(17);
    if (IN(18)) { row_phase<2, 0, true>(C, C.out, 1, 5, C.in[6] + D, C.in[7] + D, 2, 1, 0, 0); } SEAM(18);

    if (IN(19)) for (int rep_ = 0; rep_ < ((REP_MASK & 1) ? 2 : 1); ++rep_) { pg8::EpiStore E{PROJ, A_NQKV, C.in[25], -1}; dense_gemm(C, HIN, WSP(bf16, WS_WQKV), A_NQKV, D, E); __syncthreads(); } SEAM(19);
    if (IN(20)) for (int rep_ = 0; rep_ < ((REP_MASK & 16) ? 2 : 1); ++rep_) { swa_phase(C); __syncthreads(); } SEAM(20);
    if (IN(21)) for (int rep_ = 0; rep_ < ((REP_MASK & 1) ? 2 : 1); ++rep_) { pg8::EpiStore E{YMIX, D, nullptr, -1}; dense_gemm(C, MIXA, WSP(bf16, WS_WWO), D, D, E); __syncthreads(); } SEAM(21);
    if (IN(22)) { row_phase<1, 3, true>(C, C.out, 2, 2, C.in[4] + 2 * D, C.in[5] + 2 * D, 2, 4, 3, 0); } SEAM(22);
    if (IN(23)) for (int rep_ = 0; rep_ < ((REP_MASK & 2) ? 2 : 1); ++rep_) { moe_gemm1(C, 2); __syncthreads(); } SEAM(23);
    if (IN(24)) for (int rep_ = 0; rep_ < ((REP_MASK & 2) ? 2 : 1); ++rep_) { moe_gemm2(C, 2); __syncthreads(); } SEAM(24);
    if (IN(25)) { row_phase<2, 1, true>(C, C.out, 2, 5, C.in[6] + 2 * D, C.in[7] + 2 * D, 3, 1, 0, 1); } SEAM(25);

    if (IN(26)) for (int rep_ = 0; rep_ < ((REP_MASK & 1) ? 2 : 1); ++rep_) { pg8::EpiStore E{PROJ, M_NIN, nullptr, -1}; dense_gemm(C, HIN, WSP(bf16, WS_WMIN) + (size_t)M_NIN * D, M_NIN, D, E); __syncthreads(); } SEAM(26);
    if (IN(27)) for (int rep_ = 0; rep_ < ((REP_MASK & 4) ? 2 : 1); ++rep_) { mlstm_m1(C, 1); __syncthreads(); } SEAM(27);
    if (IN(28)) for (int rep_ = 0; rep_ < ((REP_MASK & 4) ? 2 : 1); ++rep_) { mlstm_m15(C); __syncthreads(); } SEAM(28);
    if (IN(29)) for (int rep_ = 0; rep_ < ((REP_MASK & 4) ? 2 : 1); ++rep_) { mlstm_m2(C, 1); __syncthreads(); } SEAM(29);
    if (IN(30)) for (int rep_ = 0; rep_ < ((REP_MASK & 1) ? 2 : 1); ++rep_) { pg8::EpiStore E{YMIX, D, nullptr, -1}; dense_gemm(C, MIXA, WSP(bf16, WS_WMOUT) + (size_t)D * D, D, D, E); __syncthreads(); } SEAM(30);
    if (IN(31)) { row_phase<1, 3, true>(C, C.out, 3, 2, C.in[4] + 3 * D, C.in[5] + 3 * D, 3, 4, 3, 0); } SEAM(31);
    if (IN(32)) for (int rep_ = 0; rep_ < ((REP_MASK & 2) ? 2 : 1); ++rep_) { moe_gemm1(C, 3); __syncthreads(); } SEAM(32);
    if (IN(33)) for (int rep_ = 0; rep_ < ((REP_MASK & 2) ? 2 : 1); ++rep_) { moe_gemm2(C, 3); __syncthreads(); } SEAM(33);
    if (IN(34)) { row_phase<2, 0, false>(C, C.out, 3, 5, C.in[6] + 3 * D, C.in[7] + 3 * D, 0, 0, 0, 0); }
#undef IN
#undef SEAM
}

#ifndef MK_LAUNCH_PER_PHASE
#define MK_LAUNCH_PER_PHASE 0
#endif
extern "C" void kernel_launch(void* const* d_in, const int* in_sizes, int n_in, void* d_out, int out_size, void* d_ws, size_t ws_size, hipStream_t stream) {
    static int grid = 0;
    if (grid == 0) {
        if (n_in != 35 || out_size != T * D || ws_size < WS_END) { fprintf(stderr, "kernel_launch: unexpected shapes (n_in %d, out %d, ws %zu < %zu)\n", n_in, out_size, ws_size, (size_t)WS_END); grid = -1; return; }
        int dev = 0, cus = 0, per_cu = 0;
        if (hipGetDevice(&dev) != hipSuccess || hipDeviceGetAttribute(&cus, hipDeviceAttributeMultiprocessorCount, dev) != hipSuccess) { grid = -1; return; }
        if (hipFuncSetAttribute((const void*)fwd, hipFuncAttributeMaxDynamicSharedMemorySize, LDS_BYTES) != hipSuccess) { fprintf(stderr, "kernel_launch: hipFuncSetAttribute failed\n"); grid = -1; return; }
        if (hipOccupancyMaxActiveBlocksPerMultiprocessor(&per_cu, (const void*)fwd, 512, LDS_BYTES) != hipSuccess || per_cu < 1) fprintf(stderr, "kernel_launch: occupancy query says %d\n", per_cu);
        (void)hipGetLastError();
        grid = cus;
    }
    if (grid < 0) return;
    (void)hipMemsetAsync((char*)d_ws + WS_CTL, 0, CTL_ZERO_BYTES, stream);
    Args a{};
    for (int i = 0; i < 35; ++i) a.in[i] = (const float*)d_in[i];
    a.out = (float*)d_out; a.ws = (unsigned char*)d_ws;
#if MK_LAUNCH_PER_PHASE
    for (int p = 0; p < N_PHASES; ++p) { a.ph_lo = p; a.ph_hi = p + 1; a.li = 0; hipLaunchKernelGGL(fwd, dim3(grid), dim3(512), LDS_BYTES, stream, a); }
#else
    a.ph_lo = 0; a.ph_hi = N_PHASES; a.li = 0;
    hipLaunchKernelGGL(fwd, dim3(grid), dim3(512), LDS_BYTES, stream, a);
#endif
}
```

```cpp
#include <hip/hip_runtime.h>
#include <cstdio>
#include <cstdint>

#define DI __device__ __forceinline__
#define GAS __attribute__((address_space(1)))
#define LAS __attribute__((address_space(3)))
typedef unsigned short bf16;
typedef short bf16x8 __attribute__((ext_vector_type(8)));
typedef short s16x4 __attribute__((ext_vector_type(4)));
typedef float f32x4 __attribute__((ext_vector_type(4)));
typedef float f32x2 __attribute__((ext_vector_type(2)));
typedef unsigned u32x4 __attribute__((ext_vector_type(4)));
typedef unsigned u32x2 __attribute__((ext_vector_type(2)));

constexpr int BATCH = 2, SEQ = 16384, D = 1024, T = BATCH * SEQ, DEPTH = 4;
constexpr float DN_ALPHA = 1.681792830507429f;
constexpr float LN_EPS = 1e-5f;
constexpr int M_HEADS = 4, M_DQK = 128, M_DV = 256, M_CHUNK = 64, M_NIN = 3072  , M_IN = 3080;
constexpr int M_NSEG = 32, M_SEGT = SEQ / M_NSEG  , M_SEGC = M_SEGT / M_CHUNK  ;
constexpr int M_STATE = M_DQK * M_DV + M_DQK;
constexpr int S5_G = 64, S5_P = 64, S5_NSEG = 16, S5_SEGT = SEQ / S5_NSEG  ;
constexpr int A_HEADS = 16, A_KV = 4, A_GRP = 4, A_HD = 64, A_NQKV = 1536, A_WIN = 128;
constexpr int E_GROUPS = 4, E_PER = 8, N_EXP = 32, D_EXP = 512;
constexpr int MOE_P = 2 * T + N_EXP * 256;

constexpr size_t MiB = 1u << 20;
constexpr size_t WS_CTL = 0, CTL_ZERO_BYTES = 1 * MiB;
constexpr size_t WS_MOD = 1 * MiB;
constexpr size_t WS_S5ABAR = 2 * MiB;
constexpr size_t WS_S5BBT = WS_S5ABAR + 64 * 1024;
constexpr size_t WS_S5CMT = WS_S5BBT + 256 * 1024;
constexpr size_t WS_RWH = 3 * MiB;
constexpr size_t WS_RWL = WS_RWH + 512 * 1024;
constexpr size_t WS_GWH = 4 * MiB;
constexpr size_t WS_GWL = WS_GWH + 64 * 1024;
constexpr size_t WS_RB = WS_GWL + 64 * 1024;
constexpr size_t WS_SEGF = WS_RB + 4096;
constexpr size_t WS_SEGM = WS_SEGF + 4096;
constexpr size_t WS_S5END = 5 * MiB;
constexpr size_t WS_TOKES = 6 * MiB;
constexpr size_t WS_TOKW = WS_TOKES + 256 * 1024;
constexpr size_t WS_TOKPOS = WS_TOKW + 256 * 1024;
constexpr size_t WS_GATES = 7 * MiB;
constexpr size_t WS_WMIN = 8 * MiB;
constexpr size_t WS_WMOUT = 20 * MiB;
constexpr size_t WS_WS5IN = 24 * MiB;
constexpr size_t WS_WS5GLU = 26 * MiB;
constexpr size_t WS_WQKV = 30 * MiB;
constexpr size_t WS_WWO = 33 * MiB;
constexpr size_t WS_W13 = 36 * MiB;
constexpr size_t WS_W2 = WS_W13 + 256 * MiB;
constexpr size_t WS_SLOC = WS_W2 + 128 * MiB;
constexpr size_t WS_SINIT = WS_SLOC + 34 * MiB;
constexpr size_t WS_HIN = WS_SINIT + 34 * MiB;
constexpr size_t WS_R1 = WS_HIN + 64 * MiB;
constexpr size_t WS_PROJ = WS_R1, WS_MIXA = WS_R1 + 192 * MiB;
constexpr size_t WS_ELIST = WS_R1  , WS_HID = WS_R1 + 144 * MiB;
constexpr size_t WS_R2 = WS_R1 + 256 * MiB;
constexpr size_t WS_YEXP = WS_R2, WS_YMIX = WS_R2;
constexpr size_t WS_END = WS_R2 + 144 * MiB;
constexpr int CW_BAR = 4096;
constexpr int CW_GCNT = 16384;

constexpr int RING_BYTES = 131072;
constexpr int MISC_OFF = RING_BYTES;
constexpr int LDS_BYTES = 147456;

DI unsigned f2bf(float f) { unsigned u = __builtin_bit_cast(unsigned, f); return (u + 0x7fffu + ((u >> 16) & 1u)) >> 16; }
DI unsigned pk2(float lo, float hi) { return f2bf(lo) | (f2bf(hi) << 16); }
DI float bf2f(unsigned b) { return __builtin_bit_cast(float, b << 16); }
DI float bflo(unsigned w) { return __builtin_bit_cast(float, w << 16); }
DI float bfhi(unsigned w) { return __builtin_bit_cast(float, w & 0xffff0000u); }
DI f32x4 MMA(bf16x8 a, bf16x8 b, f32x4 c) { return __builtin_amdgcn_mfma_f32_16x16x32_bf16(a, b, c, 0, 0, 0); }
DI float wave_sum(float v) {
#pragma unroll
    for (int o = 1; o < 64; o <<= 1) v += __shfl_xor(v, o);
    return v;
}
DI float sigmoidf_(float x) { return 1.0f / (1.0f + __expf(-x)); }
#define LDS_WAIT() asm volatile("s_waitcnt lgkmcnt(0)" ::: "memory")
#define VM_WAIT() asm volatile("s_waitcnt vmcnt(0)" ::: "memory")

namespace pg8 {
#define PG8_LAS __attribute__((address_space(3)))
typedef unsigned short bf16_t;
typedef short bf16x8 __attribute__((ext_vector_type(8)));
typedef float f32x4 __attribute__((ext_vector_type(4)));
typedef unsigned u32x4 __attribute__((ext_vector_type(4)));
constexpr int BM = 256, BK = 64, HALF = 128, HTB = HALF * BK * 2  , STAGE_BYTES = 8 * HTB, NXCD = 8, WGM = 8;

__host__ __device__ __forceinline__ int lds_byte(int r, int c) { const int st = (r >> 4) * 2 + (c >> 5), rr = r & 15, cc = c & 31, ob = rr * 64 + cc * 2; return st * 1024 + (ob ^ (((ob >> 9) & 1) << 5)); }
__host__ __device__ __forceinline__ void stage_rc(int b, int& R, int& C) { const int st = b / 1024, sb = b % 1024, swz = sb ^ (((sb >> 9) & 1) << 5); R = (st >> 1) * 16 + swz / 64; C = (st & 1) * 32 + (swz % 64) / 2; }
__host__ __device__ __forceinline__ int perm32(int rho) { const int n = rho >> 4, i = rho & 15; return 8 * (i >> 2) + 4 * n + (i & 3); }

struct Unit { int pm, pn; };
struct Gemm { const bf16_t* A; const bf16_t* Bt; int M, N, K; };

struct StaticOrder {
    int nM, nN, nwg, G, c;
    __host__ __device__ void init(int M, int N, int G_, int c_) { nM = M / BM; nN = N / BM; nwg = nM * nN; G = G_; c = c_; }
    __host__ __device__ bool next(int i, Unit& u) const {
        const long L = (long)i * G + c; if (L >= nwg) return false;
        int wgid = (int)L; { const int q = nwg / NXCD, r = nwg % NXCD, xcd = wgid % NXCD, off = wgid / NXCD; wgid = (xcd < r ? xcd * (q + 1) : r * (q + 1) + (xcd - r) * q) + off; }
        const int nig = WGM * nN, gid = wgid / nig, fm = gid * WGM, gsz = (nM - fm) < WGM ? (nM - fm) : WGM;
        u.pm = fm + ((wgid % nig) % gsz); u.pn = (wgid % nig) / gsz; return true;
    }
    __device__ __forceinline__ void a_ready(const Unit&) const {}
    __device__ __forceinline__ void done(const Unit&) const {}
    __device__ __forceinline__ int arow(const Unit& u, int r) const { return u.pm * BM + r; }
};
struct MoeOrder {
    const PG8_LAS int* tbl; int G, c, nunits; const int* elist;
    __device__ __forceinline__ int arow(const Unit& u, int r) const { const int e = u.pn >> 2; const int slot = (u.pm - tbl[33 + e]) * BM + r; return slot < tbl[66 + e] ? elist[e * 32768 + slot] : 0; }
    __device__ __forceinline__ bool next(int i, Unit& u) const {
        const long L = (long)i * G + c; if (L >= nunits) return false;
        int wgid = (int)L; { const int q = nunits / NXCD, r = nunits % NXCD, xcd = wgid % NXCD, off = wgid / NXCD; wgid = (xcd < r ? xcd * (q + 1) : r * (q + 1) + (xcd - r) * q) + off; }
        int e = 0;
#pragma unroll
        for (int j = 1; j < 32; ++j) e += (wgid >= tbl[j]) ? 1 : 0;
        const int local = wgid - tbl[e], tb = tbl[33 + e], nt = tbl[34 + e] - tb;
        const int pn = local / nt, tl = local - pn * nt;
        u.pm = __builtin_amdgcn_readfirstlane(tb + tl); u.pn = __builtin_amdgcn_readfirstlane(e * 4 + pn); return true;
    }
    __device__ __forceinline__ void a_ready(const Unit&) const {}
    __device__ __forceinline__ void done(const Unit&) const {}
};

__device__ __forceinline__ unsigned cvt_pk_bf16(float lo, float hi) { unsigned r; asm volatile("v_cvt_pk_bf16_f32 %0, %1, %2" : "=v"(r) : "v"(lo), "v"(hi)); return r; }

struct EpiStore {
    static constexpr bool PERM = true, AFTER_DRAIN = false;
    bf16_t* O; int ldc; const float* bias; int pn_mask;
    __device__ __forceinline__ void operator()(const f32x4 (&acc)[2][2][4][2], const Unit& u, int wr, int wc, int fr, int fq) const {
        const int row0 = u.pm * BM + wr * 64 + fr; const int col0 = (u.pn & pn_mask) * BM + wc * 32 + 8 * fq;
        f32x4 bv[2][2];
#pragma unroll
        for (int bj = 0; bj < 2; ++bj)
#pragma unroll
            for (int n = 0; n < 2; ++n) bv[bj][n] = bias ? *(const f32x4*)(bias + col0 + bj * HALF + 4 * n) : (f32x4){0.f, 0.f, 0.f, 0.f};
#pragma unroll
        for (int ai = 0; ai < 2; ++ai)
#pragma unroll
            for (int m = 0; m < 4; ++m) { bf16_t* rowp = O + (size_t)(row0 + ai * HALF + m * 16) * ldc + col0;
#pragma unroll
                for (int bj = 0; bj < 2; ++bj) { const f32x4 v0 = acc[ai][bj][m][0] + bv[bj][0], v1 = acc[ai][bj][m][1] + bv[bj][1];
                    u32x4 w; w.x = cvt_pk_bf16(v0[0], v0[1]); w.y = cvt_pk_bf16(v0[2], v0[3]); w.z = cvt_pk_bf16(v1[0], v1[1]); w.w = cvt_pk_bf16(v1[2], v1[3]);
                    *(u32x4*)(rowp + bj * HALF) = w; } }
    }
};
template <int MODE> struct EpiPair {
    static constexpr bool PERM = true, AFTER_DRAIN = false;
    bf16_t* O; int ldc; int pn_mask;
    __device__ __forceinline__ void operator()(const f32x4 (&acc)[2][2][4][2], const Unit& u, int wr, int wc, int fr, int fq) const {
        const int row0 = u.pm * BM + wr * 64 + fr; const int col0 = (u.pn & pn_mask) * HALF + wc * 32 + 8 * fq;
#pragma unroll
        for (int ai = 0; ai < 2; ++ai)
#pragma unroll
            for (int m = 0; m < 4; ++m) { bf16_t* rowp = O + (size_t)(row0 + ai * HALF + m * 16) * ldc + col0;
                float r[8];
#pragma unroll
                for (int n = 0; n < 2; ++n)
#pragma unroll
                    for (int j = 0; j < 4; ++j) { const float a = acc[ai][0][m][n][j], b = acc[ai][1][m][n][j];
                        r[n * 4 + j] = (MODE == 0) ? (a * b) / (1.0f + __expf(-a)) : a / (1.0f + __expf(-b)); }
                u32x4 w; w.x = cvt_pk_bf16(r[0], r[1]); w.y = cvt_pk_bf16(r[2], r[3]); w.z = cvt_pk_bf16(r[4], r[5]); w.w = cvt_pk_bf16(r[6], r[7]);
                *(u32x4*)rowp = w; }
    }
};
template <class Epi, class Sched, bool ALIGN_EPI = false, bool SP2 = false, bool GATHER = false>
__device__ __forceinline__ void gemm_phase(PG8_LAS unsigned char* lds, const Gemm g, const Sched& S, const Epi& E) {
    const int tid = threadIdx.x, wid = __builtin_amdgcn_readfirstlane(tid >> 6), lane = tid & 63, wr = wid >> 2, wc = wid & 3, fr = lane & 15, fq = lane >> 4;
    const int K = g.K, nt = K / BK;
    unsigned voffA[2], voffB[2];
#pragma unroll
    for (int i = 0; i < 2; ++i) { int R, C; stage_rc(tid * 16 + i * 8192, R, C); const int Rb = Epi::PERM ? ((R & ~31) + perm32(R & 31)) : R;
        voffA[i] = (unsigned)(R * K + C) * 2u; voffB[i] = (unsigned)(Rb * K + C) * 2u; }
    unsigned cvA[2][2], nvA[2][2]; int gR[2], gC[2];
    if constexpr (GATHER) {
#pragma unroll
        for (int i = 0; i < 2; ++i) { stage_rc(tid * 16 + i * 8192, gR[i], gC[i]); }
    }
#define PG8_GOFF(dst, u) do { _Pragma("unroll") for (int _h = 0; _h < 2; ++_h) _Pragma("unroll") for (int _i = 0; _i < 2; ++_i) dst[_h][_i] = (unsigned)S.arow(u, _h * HALF + gR[_i]) * (unsigned)(K * 2) + (unsigned)(gC[_i] * 2); } while (0)
    const size_t kstep = (size_t)(BK * 2);
    const size_t hstep = (size_t)HALF * K * 2;
    const size_t tstep = 2 * hstep;
    const unsigned ldsw = (unsigned)wid * 1024u;
    const int aoff = lds_byte(wr * 64 + fr, fq * 8), boff = lds_byte(wc * 32 + fr, fq * 8);
#define PG8_SA(b, h) (((b) * 2 + (h)) * HTB)
#define PG8_SB(b, h) ((4 + (b) * 2 + (h)) * HTB)
#define PG8_STAGE(bufoff, gbase, voff) do { _Pragma("unroll") for (int _i = 0; _i < 2; ++_i) \
        __builtin_amdgcn_global_load_lds((const unsigned*)((const char*)(gbase) + (voff)[_i]), (PG8_LAS unsigned*)(lds + (bufoff) + ldsw + _i * 8192), 16, 0, 0); } while (0)
#define PG8_LDA(dst, b, h) do { _Pragma("unroll") for (int m = 0; m < 4; ++m) _Pragma("unroll") for (int k = 0; k < 2; ++k) dst[m][k] = *(const PG8_LAS bf16x8*)(lds + PG8_SA(b, h) + aoff + m * 2048 + k * 1024); } while (0)
#define PG8_LDB(dst, b, h) do { _Pragma("unroll") for (int n = 0; n < 2; ++n) _Pragma("unroll") for (int k = 0; k < 2; ++k) dst[n][k] = *(const PG8_LAS bf16x8*)(lds + PG8_SB(b, h) + boff + n * 2048 + k * 1024); } while (0)
#define PG8_MMA(ai, bj, At, Bt) do { __builtin_amdgcn_s_setprio(1); _Pragma("unroll") for (int m = 0; m < 4; ++m) _Pragma("unroll") for (int n = 0; n < 2; ++n) _Pragma("unroll") for (int k = 0; k < 2; ++k) \
        acc[ai][bj][m][n] = __builtin_amdgcn_mfma_f32_16x16x32_bf16(Bt[n][k], At[m][k], acc[ai][bj][m][n], 0, 0, 0); __builtin_amdgcn_s_setprio(0); } while (0)
#define PG8_WAIT_V(n) asm volatile("s_waitcnt vmcnt(" #n ")" ::: "memory")
#define PG8_WAIT_L(n) asm volatile("s_waitcnt lgkmcnt(" #n ")" ::: "memory")
#define PG8_BAR __builtin_amdgcn_s_barrier()
#define PG8_SCHED __builtin_amdgcn_sched_barrier(0)
    Unit cur, nxt; int ui = 0;
    if (!S.next(0, cur)) return;
    f32x4 acc[2][2][4][2];
#pragma unroll
    for (int a = 0; a < 2; ++a)
#pragma unroll
        for (int b = 0; b < 2; ++b)
#pragma unroll
            for (int m = 0; m < 4; ++m)
#pragma unroll
                for (int n = 0; n < 2; ++n) acc[a][b][m][n] = (f32x4){0.f, 0.f, 0.f, 0.f};
    bf16x8 At[4][2], B0[2][2], B1[2][2];
    const char* cA = GATHER ? (const char*)g.A : (const char*)g.A + (size_t)cur.pm * tstep; const char* cB = (const char*)g.Bt + (size_t)cur.pn * tstep;
    if constexpr (GATHER) { PG8_GOFF(cvA, cur); }
    S.a_ready(cur);
    if constexpr (SP2) {
        PG8_STAGE(PG8_SB(0, 0), cB, voffB); PG8_STAGE(PG8_SB(0, 1), cB + hstep, voffB);
        if constexpr (GATHER) { PG8_STAGE(PG8_SA(0, 0), cA, cvA[0]); PG8_STAGE(PG8_SA(0, 1), cA, cvA[1]); } else { PG8_STAGE(PG8_SA(0, 0), cA, voffA); PG8_STAGE(PG8_SA(0, 1), cA + hstep, voffA); }
        if (wr == 1) PG8_BAR;
        PG8_WAIT_V(2); PG8_BAR;
        PG8_STAGE(PG8_SB(1, 0), cB + kstep, voffB); if constexpr (GATHER) { PG8_STAGE(PG8_SA(1, 0), cA + kstep, cvA[0]); } else { PG8_STAGE(PG8_SA(1, 0), cA + kstep, voffA); } PG8_STAGE(PG8_SB(1, 1), cB + hstep + kstep, voffB);
        PG8_WAIT_V(6); PG8_BAR;
    } else {
        PG8_STAGE(PG8_SB(0, 0), cB, voffB); PG8_STAGE(PG8_SA(0, 0), cA, voffA); PG8_STAGE(PG8_SB(0, 1), cB + hstep, voffB); PG8_STAGE(PG8_SA(0, 1), cA + hstep, voffA);
        if (wr == 1) PG8_BAR;
        PG8_WAIT_V(4); PG8_BAR;
        PG8_STAGE(PG8_SB(1, 0), cB + kstep, voffB); PG8_STAGE(PG8_SA(1, 0), cA + kstep, voffA); PG8_STAGE(PG8_SB(1, 1), cB + hstep + kstep, voffB);
        PG8_WAIT_V(6); PG8_BAR;
    }
    for (;;) {
        const bool has_next = S.next(ui + 1, nxt);
        if constexpr (GATHER) { if (has_next) { PG8_GOFF(nvA, nxt); } else { _Pragma("unroll") for (int _h = 0; _h < 2; ++_h) _Pragma("unroll") for (int _i = 0; _i < 2; ++_i) nvA[_h][_i] = cvA[_h][_i]; } }
        const char* nA = GATHER ? (const char*)g.A : (has_next ? (const char*)g.A + (size_t)nxt.pm * tstep : cA); const char* nB = has_next ? (const char*)g.Bt + (size_t)nxt.pn * tstep : cB;
        for (int t = 0; t < nt; t += 2) {
            const bool last = (t == nt - 2);
            const char* a1 = cA + (size_t)(t + 1) * kstep;
            const char* a2 = last ? nA : cA + (size_t)(t + 2) * kstep; const char* b2 = last ? nB : cB + (size_t)(t + 2) * kstep;
            const char* a3 = a2 + kstep; const char* b3 = b2 + kstep;
            unsigned sv0[2], sv1[2];
            if constexpr (GATHER) { sv0[0] = last ? nvA[0][0] : cvA[0][0]; sv0[1] = last ? nvA[0][1] : cvA[0][1]; sv1[0] = last ? nvA[1][0] : cvA[1][0]; sv1[1] = last ? nvA[1][1] : cvA[1][1]; }
            if (last && has_next) S.a_ready(nxt);
            if constexpr (SP2) {
            PG8_LDB(B0, 0, 0); PG8_LDB(B1, 0, 1); PG8_SCHED; PG8_LDA(At, 0, 0); if constexpr (GATHER) { PG8_STAGE(PG8_SA(1, 1), a1, cvA[1]); } else { PG8_STAGE(PG8_SA(1, 1), a1 + hstep, voffA); }
            PG8_WAIT_V(8); PG8_WAIT_L(0); PG8_BAR; PG8_MMA(0, 0, At, B0); PG8_MMA(0, 1, At, B1); PG8_BAR; PG8_SCHED;
            PG8_LDA(At, 0, 1); PG8_STAGE(PG8_SB(0, 0), b2, voffB); PG8_STAGE(PG8_SB(0, 1), b2 + hstep, voffB); if constexpr (GATHER) { PG8_STAGE(PG8_SA(0, 0), a2, sv0); } else { PG8_STAGE(PG8_SA(0, 0), a2, voffA); }
            PG8_WAIT_V(8); PG8_WAIT_L(0); PG8_BAR; PG8_MMA(1, 0, At, B0); PG8_MMA(1, 1, At, B1); PG8_BAR; PG8_SCHED;
            PG8_LDB(B0, 1, 0); PG8_LDB(B1, 1, 1); PG8_SCHED; PG8_LDA(At, 1, 0); if constexpr (GATHER) { PG8_STAGE(PG8_SA(0, 1), a2, sv1); } else { PG8_STAGE(PG8_SA(0, 1), a2 + hstep, voffA); }
            PG8_WAIT_V(8); PG8_WAIT_L(0); PG8_BAR; PG8_MMA(0, 0, At, B0); PG8_MMA(0, 1, At, B1); PG8_BAR; PG8_SCHED;
            PG8_LDA(At, 1, 1); PG8_STAGE(PG8_SB(1, 0), b3, voffB); PG8_STAGE(PG8_SB(1, 1), b3 + hstep, voffB); if constexpr (GATHER) { PG8_STAGE(PG8_SA(1, 0), a3, sv0); } else { PG8_STAGE(PG8_SA(1, 0), a3, voffA); }
            PG8_WAIT_V(8); PG8_WAIT_L(0); PG8_BAR; PG8_MMA(1, 0, At, B0); PG8_MMA(1, 1, At, B1); PG8_BAR; PG8_SCHED;
            } else {
            PG8_LDB(B0, 0, 0); PG8_SCHED; PG8_LDA(At, 0, 0); PG8_STAGE(PG8_SA(1, 1), a1 + hstep, voffA);
            PG8_WAIT_L(8); PG8_BAR; PG8_WAIT_L(0); PG8_MMA(0, 0, At, B0); PG8_BAR; PG8_SCHED;
            PG8_LDB(B1, 0, 1); PG8_STAGE(PG8_SB(0, 0), b2, voffB);
            PG8_BAR; PG8_WAIT_L(0); PG8_MMA(0, 1, At, B1); PG8_BAR;
            PG8_LDA(At, 0, 1); PG8_STAGE(PG8_SA(0, 0), a2, voffA);
            PG8_BAR; PG8_WAIT_L(0); PG8_MMA(1, 0, At, B0); PG8_BAR; PG8_SCHED;
            PG8_STAGE(PG8_SB(0, 1), b2 + hstep, voffB);
            PG8_WAIT_V(6); PG8_BAR; PG8_MMA(1, 1, At, B1); PG8_BAR;
            PG8_LDB(B0, 1, 0); PG8_SCHED; PG8_LDA(At, 1, 0); PG8_STAGE(PG8_SA(0, 1), a2 + hstep, voffA);
            PG8_WAIT_L(8); PG8_BAR; PG8_WAIT_L(0); PG8_MMA(0, 0, At, B0); PG8_BAR; PG8_SCHED;
            PG8_LDB(B1, 1, 1); PG8_STAGE(PG8_SB(1, 0), b3, voffB);
            PG8_BAR; PG8_WAIT_L(0); PG8_MMA(0, 1, At, B1); PG8_BAR;
            PG8_LDA(At, 1, 1); PG8_STAGE(PG8_SA(1, 0), a3, voffA);
            PG8_BAR; PG8_WAIT_L(0); PG8_MMA(1, 0, At, B0); PG8_BAR; PG8_SCHED;
            PG8_STAGE(PG8_SB(1, 1), b3 + hstep, voffB);
            PG8_WAIT_V(6); PG8_BAR; PG8_MMA(1, 1, At, B1); PG8_BAR;
            }
        }
        if constexpr (ALIGN_EPI) { if (wr == 0) PG8_BAR; }
        if constexpr (!Epi::AFTER_DRAIN) { E(acc, cur, wr, wc, fr, fq); S.done(cur); }
        if (!has_next) break;
#pragma unroll
        for (int a = 0; a < 2; ++a)
#pragma unroll
            for (int b = 0; b < 2; ++b)
#pragma unroll
                for (int m = 0; m < 4; ++m)
#pragma unroll
                    for (int n = 0; n < 2; ++n) acc[a][b][m][n] = (f32x4){0.f, 0.f, 0.f, 0.f};
        cur = nxt; cA = nA; cB = nB; ++ui;
        if constexpr (GATHER) { _Pragma("unroll") for (int _h = 0; _h < 2; ++_h) _Pragma("unroll") for (int _i = 0; _i < 2; ++_i) cvA[_h][_i] = nvA[_h][_i]; }
        if constexpr (ALIGN_EPI) { if (wr == 1) PG8_BAR; }
    }
    PG8_WAIT_V(0);
    if constexpr (!ALIGN_EPI) { if (wr == 0) PG8_BAR; }
    PG8_BAR;
    if constexpr (Epi::AFTER_DRAIN) { E.fused(acc, cur, wr, wc, fr, fq, lds, wid, lane); S.done(cur); }
#undef PG8_GOFF
#undef PG8_SA
#undef PG8_SB
#undef PG8_STAGE
#undef PG8_LDA
#undef PG8_LDB
#undef PG8_MMA
#undef PG8_WAIT_V
#undef PG8_WAIT_L
#undef PG8_BAR
#undef PG8_SCHED
}
}

#define XB_TMO      128
#define XB_XCNT(j)  (256  + 64 * (j))
#define XB_XSUB(j)  (1280 + 64 * (j))
#define XB_XGEN(j)  (2304 + 64 * (j))
#define XB_TOP      3328
#define XB_TOPGEN   3392
#define XCD_BAR_WORDS 3456
#define XB_SPIN_CAP (1u << 18)

__device__ __forceinline__ unsigned xb_ld(unsigned* p)              { return __hip_atomic_load(p, __ATOMIC_RELAXED, __HIP_MEMORY_SCOPE_AGENT); }
__device__ __forceinline__ unsigned xb_add(unsigned* p, unsigned v) { return __hip_atomic_fetch_add(p, v, __ATOMIC_RELAXED, __HIP_MEMORY_SCOPE_AGENT); }
__device__ __forceinline__ unsigned xb_xcc_id() { return (unsigned)__builtin_amdgcn_s_getreg((3 << 11) | 20) & 0xFu; }
#define XB_SPIN(cond, bar) do { unsigned _sp = 0; while (cond) { __builtin_amdgcn_s_sleep(1); \
    if ((++_sp & 255u) == 0u) { if (xb_ld(&(bar)[XB_TMO])) break; if (_sp > XB_SPIN_CAP) { atomicAdd(&(bar)[XB_TMO], 1u); break; } } } } while (0)

struct XcdBarrier {
    unsigned* bar; unsigned x;
    volatile LAS unsigned* st;
};

__device__ __forceinline__ XcdBarrier xcd_barrier_post(unsigned* bar, volatile LAS unsigned* st) {
    XcdBarrier b; b.bar = bar; b.x = xb_xcc_id(); b.st = st;
    if (threadIdx.x == 0) (void)xb_add(&bar[XB_XCNT(b.x)], 1u);
    return b;
}
__device__ __forceinline__ void xcd_barrier_complete(unsigned* bar, unsigned x, unsigned& nloc, unsigned& nx) {
    const unsigned G = gridDim.x * gridDim.y * gridDim.z;
    unsigned sum, cnt, mine, sp = 0u;
    for (;;) {
        sum = 0u; cnt = 0u; mine = 0u;
#pragma unroll
        for (unsigned j = 0; j < 16; ++j) { const unsigned c = xb_ld(&bar[XB_XCNT(j)]); sum += c; cnt += (c > 0u) ? 1u : 0u; mine = (j == x) ? c : mine; }
        if (sum == G) break;
        __builtin_amdgcn_s_sleep(1);
        if ((++sp & 255u) == 0u) { if (xb_ld(&bar[XB_TMO])) break; if (sp > XB_SPIN_CAP) { atomicAdd(&bar[XB_TMO], 1u); break; } }
    }
    nloc = mine > 0u ? mine : 1u; nx = cnt > 0u ? cnt : 1u;
}

__device__ __forceinline__ void xcd_barrier(const XcdBarrier& b) {
    asm volatile("s_waitcnt vmcnt(0)" ::: "memory");
    __syncthreads();
    if (threadIdx.x == 0) {
        unsigned* bar = b.bar;
        __builtin_amdgcn_s_waitcnt(0);
        unsigned nloc = b.st[0], nx = b.st[1];
        if (nloc == 0u) { xcd_barrier_complete(bar, b.x, nloc, nx); b.st[0] = nloc; b.st[1] = nx; }
        const unsigned old = xb_add(&bar[XB_XSUB(b.x)], 1u);
        const unsigned gen = old / nloc;
        if (old + 1u == (gen + 1u) * nloc) {
            __builtin_amdgcn_fence(__ATOMIC_RELEASE, "agent");
            asm volatile("s_waitcnt vmcnt(0)" ::: "memory");
            const unsigned og = xb_add(&bar[XB_TOP], 1u);
            const unsigned tg = og / nx;
            if (og + 1u == (tg + 1u) * nx) xb_add(&bar[XB_TOPGEN], 1u);
            else XB_SPIN(xb_ld(&bar[XB_TOPGEN]) == tg, bar);
            __builtin_amdgcn_fence(__ATOMIC_ACQUIRE, "agent");
            xb_add(&bar[XB_XGEN(b.x)], 1u);
            asm volatile("s_waitcnt vmcnt(0)" ::: "memory");
        } else {
            XB_SPIN(xb_ld(&bar[XB_XGEN(b.x)]) == gen, bar);
            __builtin_amdgcn_fence(__ATOMIC_ACQUIRE, "agent");
            asm volatile("s_waitcnt vmcnt(0)" ::: "memory");
        }
    }
    __syncthreads();
}

struct Ctx {
    LAS unsigned char* lds;
    unsigned* ctl;
    unsigned char* ws;
    const float* const* in;
    float* out;
    int tid, lane, wave, G, vcu;
};
#define WSP(T_, off) ((T_*)(C.ws + (off)))

DI void transpose_item(const float* W, int ldw, int K, int k0, int n0, bf16* WT, int drow0, LAS float* scr, int lane) {
#pragma unroll 8
    for (int i = 0; i < 32; ++i) { const int kk = 2 * i + (lane >> 5); scr[kk * 33 + (lane & 31)] = W[(size_t)(k0 + kk) * ldw + n0 + (lane & 31)]; }
    LDS_WAIT(); asm volatile("" ::: "memory");
    const int c = lane & 7;
#pragma unroll
    for (int j = 0; j < 4; ++j) { const int n = (lane >> 3) + 8 * j; const LAS float* s = scr + (8 * c) * 33 + n;
        u32x4 o; o.x = pk2(s[0 * 33], s[1 * 33]); o.y = pk2(s[2 * 33], s[3 * 33]); o.z = pk2(s[4 * 33], s[5 * 33]); o.w = pk2(s[6 * 33], s[7 * 33]);
        *(u32x4*)(WT + (size_t)(drow0 + n) * K + k0 + 8 * c) = o; }
    LDS_WAIT(); asm volatile("" ::: "memory");
}
DI int pair_row(int n, int half) { return (n >> 7) * 256 + half * 128 + (n & 127); }

DI void p0a_weights(Ctx& C) {
    LAS float* scr = (LAS float*)(C.lds + C.wave * 8448);
    const int gw = C.vcu * 8 + C.wave, NGW = C.G * 8, lane = C.lane;
    constexpr int I_MIN = 16 * 96, I_SQ = 16 * 32, I_GLU = 16 * 64, I_QKV = 16 * 48;
    constexpr int NDENSE = 2 * I_MIN + 2 * I_SQ + I_SQ + I_GLU + I_QKV + I_SQ;
    for (int it = gw; it < NDENSE; it += NGW) {
        int r = it;
        if (r < 2 * I_MIN) { const int j = r / I_MIN; r -= j * I_MIN; const int kb = r / 96, nb = r % 96;
            transpose_item(C.in[8] + (size_t)j * D * M_IN, M_IN, D, kb * 64, nb * 32, WSP(bf16, WS_WMIN) + (size_t)j * M_NIN * D, nb * 32, scr, lane); continue; } r -= 2 * I_MIN;
        if (r < 2 * I_SQ) { const int j = r / I_SQ; r -= j * I_SQ; const int kb = r / 32, nb = r % 32;
            transpose_item(C.in[13] + (size_t)j * D * D, D, D, kb * 64, nb * 32, WSP(bf16, WS_WMOUT) + (size_t)j * D * D, nb * 32, scr, lane); continue; } r -= 2 * I_SQ;
        if (r < I_SQ) { const int kb = r / 32, nb = r % 32; transpose_item(C.in[14], D, D, kb * 64, nb * 32, WSP(bf16, WS_WS5IN), nb * 32, scr, lane); continue; } r -= I_SQ;
        if (r < I_GLU) { const int kb = r / 64, nb = r % 64; const int n0 = nb * 32; transpose_item(C.in[23], 2 * D, D, kb * 64, n0, WSP(bf16, WS_WS5GLU), pair_row(n0 & 1023, n0 >> 10), scr, lane); continue; } r -= I_GLU;
        if (r < I_QKV) { const int kb = r / 48, nb = r % 48; transpose_item(C.in[24], A_NQKV, D, kb * 64, nb * 32, WSP(bf16, WS_WQKV), nb * 32, scr, lane); continue; } r -= I_QKV;
        { const int kb = r / 32, nb = r % 32; transpose_item(C.in[27], D, D, kb * 64, nb * 32, WSP(bf16, WS_WWO), nb * 32, scr, lane); }
    }
    constexpr int I_E = 256;
    constexpr int NMOE = DEPTH * N_EXP * 3 * I_E;
    for (int it = gw; it < NMOE; it += NGW) {
        const int le = it / (3 * I_E); int r = it - le * 3 * I_E; const int which = r / I_E; r -= which * I_E;
        if (which < 2) { const int kb = r / 16, nb = r % 16; const int n0 = nb * 32;
            transpose_item(C.in[which == 0 ? 32 : 33] + (size_t)le * D * D_EXP, D_EXP, D, kb * 64, n0, WSP(bf16, WS_W13) + (size_t)le * D * D, pair_row(n0, which), scr, lane); }
        else { const int kb = r / 32, nb = r % 32;
            transpose_item(C.in[34] + (size_t)le * D_EXP * D, D, D_EXP, kb * 64, nb * 32, WSP(bf16, WS_W2) + (size_t)le * D * D_EXP, nb * 32, scr, lane); }
    }
    const int gt = C.vcu * 512 + C.tid, NGT = C.G * 512;
    for (int i = gt; i < DEPTH * 48 * D; i += NGT) { const int l = i / (48 * D), c = (i / D) % 48, k = i % D; float w = 0.f;
        if (c < 4) w = C.in[28][((size_t)l * D + k) * E_GROUPS + c]; else if (c >= 16) w = C.in[30][((size_t)l * D + k) * N_EXP + (c - 16)];
        const unsigned h = f2bf(w); WSP(bf16, WS_RWH)[i] = (bf16)h; WSP(bf16, WS_RWL)[i] = (bf16)f2bf(w - bf2f(h)); }
    for (int i = gt; i < DEPTH * 48; i += NGT) { const int l = i / 48, c = i % 48; float b = 0.f;
        if (c < 4) b = C.in[29][l * E_GROUPS + c]; else if (c >= 16) b = C.in[31][l * N_EXP + (c - 16)]; WSP(float, WS_RB)[i] = b; }
    for (int i = gt; i < 2 * 16 * D; i += NGT) { const int j = i / (16 * D), c = (i / D) % 16, k = i % D; float w = 0.f;
        if (c < 8) w = C.in[8][((size_t)j * D + k) * M_IN + M_NIN + c];
        const unsigned h = f2bf(w); WSP(bf16, WS_GWH)[i] = (bf16)h; WSP(bf16, WS_GWL)[i] = (bf16)f2bf(w - bf2f(h)); }
    for (int i = gt; i < S5_G * S5_P; i += NGT) { const int g = i / S5_P, p = i % S5_P;
        const float dt = expf(C.in[17][g]), lr = C.in[15][i], li = C.in[16][i];
        const float mag = expf(lr * dt); float sn, cs; sincosf(li * dt, &sn, &cs);
        const float are = mag * cs, aim = mag * sn; WSP(float, WS_S5ABAR)[2 * i] = are; WSP(float, WS_S5ABAR)[2 * i + 1] = aim;
        const float lsq = lr * lr + li * li, tre = ((are - 1.0f) * lr + aim * li) / lsq, tim = (aim * lr - (are - 1.0f) * li) / lsq;
        bf16* bbt = WSP(bf16, WS_S5BBT) + (size_t)g * 128 * 16;
        for (int q = 0; q < 16; ++q) { const float br = C.in[18][(size_t)i * 16 + q], bi = C.in[19][(size_t)i * 16 + q];
            bbt[p * 16 + q] = (bf16)f2bf(tre * br - tim * bi); bbt[(64 + p) * 16 + q] = (bf16)f2bf(tre * bi + tim * br); }
        bf16* cmt = WSP(bf16, WS_S5CMT) + (size_t)g * 16 * 128;
        for (int q = 0; q < 16; ++q) { cmt[q * 128 + p] = (bf16)f2bf(C.in[20][((size_t)g * 16 + q) * S5_P + p]); cmt[q * 128 + 64 + p] = (bf16)f2bf(-C.in[21][((size_t)g * 16 + q) * S5_P + p]); } }
    __syncthreads();
    LAS float* cs = (LAS float*)C.lds;
    LAS float* red = cs + 2048;
    for (int i = C.tid; i < 2 * D; i += 512) { const float v = C.in[1][i]; cs[i] = v / (1.0f + __expf(-v)); }
    __syncthreads();
    for (int it = C.vcu; it < DEPTH * 96; it += C.G) { const int l = it / 96, cg = it % 96;
        const float* w = C.in[2] + (size_t)l * D * 6 * D + cg * 64 + lane; float a0 = 0.f, a1 = 0.f;
#pragma unroll 8
        for (int k = C.wave * 128; k < C.wave * 128 + 128; ++k) { const float wv = w[(size_t)k * 6 * D]; a0 += cs[k] * wv; a1 += cs[D + k] * wv; }
        red[(C.wave * 2 + 0) * 64 + lane] = a0; red[(C.wave * 2 + 1) * 64 + lane] = a1;
        __syncthreads();
        if (C.tid < 128) { const int b = C.tid >> 6, c = C.tid & 63; float s = 0.f;
#pragma unroll
            for (int w8 = 0; w8 < 8; ++w8) s += red[(w8 * 2 + b) * 64 + c];
            WSP(float, WS_MOD)[((size_t)l * 2 + b) * 6 * D + cg * 64 + c] = s + C.in[3][(size_t)l * 6 * D + cg * 64 + c]; }
        __syncthreads();
    }
}

DI int moe_tables(Ctx& C, int layer) {
    LAS int* tbl = (LAS int*)(C.lds + MISC_OFF);
    __syncthreads();
    if (C.tid == 0) { int tb = 0;
        for (int e = 0; e < N_EXP; ++e) { const unsigned n = __hip_atomic_load(C.ctl + CW_GCNT + layer * 32 + e, __ATOMIC_RELAXED, __HIP_MEMORY_SCOPE_AGENT);
            tbl[e] = tb * 4; tbl[33 + e] = tb; tbl[66 + e] = (int)n; tb += (int)((n + 255u) >> 8); }
        tbl[32] = tb * 4; tbl[65] = tb; }
    __syncthreads();
    return tbl[32];
}

constexpr int RP_XSTR = 1032;
constexpr int RP_XH = 0, RP_XL = RP_XH + 16 * RP_XSTR * 2, RP_PART = RP_XL + 16 * RP_XSTR * 2, RP_LOG = RP_PART + 8 * 16 * 48 * 4, RP_REC = RP_LOG + 16 * 48 * 4,
              RP_LCNT = RP_REC + 128 * 6 * 4, RP_VEC = RP_LCNT + 64 * 4, RP_END = RP_VEC + 5 * 1024 * 4;
static_assert(RP_END <= RING_BYTES, "row phase LDS");

struct RowRegs { f32x4 x[4]; u32x2 y0[4], y1[4]; float w0, w1; };
template <int MODE> DI void rr_issue(Ctx& C, RowRegs& r, const float* xsrc, size_t t, int lane, int mypos, float myw, int j) {
#pragma unroll
    for (int jj = 0; jj < 4; ++jj) r.x[jj] = *(const f32x4*)(xsrc + t * D + 4 * lane + 256 * jj);
    if constexpr (MODE == 1) {
        const bf16* yr = WSP(bf16, WS_YMIX) + t * D + 4 * lane;
#pragma unroll
        for (int jj = 0; jj < 4; ++jj) r.y0[jj] = *(const u32x2*)(yr + 256 * jj);
    }
    if constexpr (MODE == 2) {
        const int p0 = __shfl(mypos, 2 * j), p1 = __shfl(mypos, 2 * j + 1); r.w0 = __shfl(myw, 2 * j); r.w1 = __shfl(myw, 2 * j + 1);
        const bf16* y0 = WSP(bf16, WS_YEXP) + (size_t)p0 * D + 4 * lane; const bf16* y1 = WSP(bf16, WS_YEXP) + (size_t)p1 * D + 4 * lane;
#pragma unroll
        for (int jj = 0; jj < 4; ++jj) { r.y0[jj] = *(const u32x2*)(y0 + 256 * jj); r.y1[jj] = *(const u32x2*)(y1 + 256 * jj); }
    }
}
template <int MODE, int NT, bool WRITE_HIN>
DI void row_phase(Ctx& C, const float* xsrc, const int layer, const int gate_idx, const float* lng, const float* lnb, const int mlayer, const int sc_idx, const int sh_idx, const int gj) {
    const int lane = C.lane, wave = C.wave, tid = C.tid, q = lane >> 4, fr = lane & 15;
    LAS bf16* XH = (LAS bf16*)(C.lds + RP_XH); LAS bf16* XL = (LAS bf16*)(C.lds + RP_XL);
    LAS float* PART = (LAS float*)(C.lds + RP_PART); LAS float* LOG = (LAS float*)(C.lds + RP_LOG);
    LAS int* REC = (LAS int*)(C.lds + RP_REC); LAS int* LCNT = (LAS int*)(C.lds + RP_LCNT); LAS float* VEC = (LAS float*)(C.lds + RP_VEC);
    const float* MOD = WSP(float, WS_MOD);
    const LAS int* MTBL = (const LAS int*)(C.lds + MISC_OFF);
    if constexpr (MODE == 2) { (void)moe_tables(C, layer); }
    bf16x8 wh[NT > 0 ? NT : 1][4], wl[NT > 0 ? NT : 1][4];
    if constexpr (NT > 0) {
        const bf16* th = (NT == 3) ? WSP(bf16, WS_RWH) + (size_t)layer * 48 * D : WSP(bf16, WS_GWH) + (size_t)gj * 16 * D;
        const bf16* tl = (NT == 3) ? WSP(bf16, WS_RWL) + (size_t)layer * 48 * D : WSP(bf16, WS_GWL) + (size_t)gj * 16 * D;
#pragma unroll
        for (int nt = 0; nt < NT; ++nt)
#pragma unroll
            for (int ks = 0; ks < 4; ++ks) { const size_t o = (size_t)(nt * 16 + fr) * D + wave * 128 + ks * 32 + 8 * q;
                wh[nt][ks] = *(const bf16x8*)(th + o); wl[nt][ks] = *(const bf16x8*)(tl + o); }
    }
    for (int rb = C.vcu; rb < T / 128; rb += C.G) {
        const int b = (rb * 128) / SEQ;
        __syncthreads();
        for (int c = tid; c < D; c += 512) {
            if constexpr (MODE != 0) { VEC[c] = MOD[((size_t)layer * 2 + b) * 6 * D + gate_idx * D + c]; VEC[D + c] = lng[c]; VEC[2 * D + c] = lnb[c]; }
            if constexpr (WRITE_HIN) { VEC[3 * D + c] = MOD[((size_t)mlayer * 2 + b) * 6 * D + sc_idx * D + c] + 1.0f; VEC[4 * D + c] = MOD[((size_t)mlayer * 2 + b) * 6 * D + sh_idx * D + c]; } }
        if constexpr (NT == 3) { if (tid < 32) LCNT[tid] = 0; }
        __syncthreads();
        RowRegs cur, nxt;
        int mypos = 0; float myw = 0.f;
        if constexpr (MODE == 2) { if (lane < 32) { const int j = lane >> 1, k = lane & 1; const size_t t = (size_t)rb * 128 + (j >> 1) * 16 + 2 * wave + (j & 1);
            const int es = WSP(int, WS_TOKES)[2 * t + k]; mypos = MTBL[33 + (es & 255)] * 256 + (es >> 8); myw = WSP(float, WS_TOKW)[2 * t + k]; } }
        rr_issue<MODE>(C, cur, xsrc, (size_t)rb * 128 + 2 * wave, lane, mypos, myw, 0);
        for (int grp = 0; grp < 8; ++grp) {
#pragma unroll
            for (int rr = 0; rr < 2; ++rr) {
                const int lr = 2 * wave + rr; const size_t t = (size_t)rb * 128 + grp * 16 + lr;
                { const int jn = grp * 2 + rr + 1; if (jn < 16) rr_issue<MODE>(C, nxt, xsrc, (size_t)rb * 128 + (jn >> 1) * 16 + 2 * wave + (jn & 1), lane, mypos, myw, jn); }
                f32x4 v[4];
#pragma unroll
                for (int j = 0; j < 4; ++j) v[j] = cur.x[j];
                if constexpr (MODE == 1) {
#pragma unroll
                    for (int j = 0; j < 4; ++j) { const u32x2 w = cur.y0[j]; const f32x4 y = {bflo(w.x), bfhi(w.x), bflo(w.y), bfhi(w.y)}; v[j] = v[j] * DN_ALPHA + *(const LAS f32x4*)(VEC + 4 * lane + 256 * j) * y; }
                }
                if constexpr (MODE == 2) {
                    const float w0 = cur.w0, w1 = cur.w1;
#pragma unroll
                    for (int j = 0; j < 4; ++j) { const u32x2 a = cur.y0[j], c2 = cur.y1[j];
                        const f32x4 y = (f32x4){bflo(a.x), bfhi(a.x), bflo(a.y), bfhi(a.y)} * w0 + (f32x4){bflo(c2.x), bfhi(c2.x), bflo(c2.y), bfhi(c2.y)} * w1;
                        v[j] = v[j] * DN_ALPHA + *(const LAS f32x4*)(VEC + 4 * lane + 256 * j) * y; }
                }
                if constexpr (MODE != 0) {
                    float s = 0.f;
#pragma unroll
                    for (int j = 0; j < 4; ++j) s += (v[j].x + v[j].y) + (v[j].z + v[j].w);
                    const float mean = wave_sum(s) * (1.0f / D); float s2 = 0.f;
#pragma unroll
                    for (int j = 0; j < 4; ++j) { v[j] = v[j] - mean; s2 += (v[j].x * v[j].x + v[j].y * v[j].y) + (v[j].z * v[j].z + v[j].w * v[j].w); }
                    const float rstd = 1.0f / sqrtf(wave_sum(s2) * (1.0f / D) + LN_EPS);
#pragma unroll
                    for (int j = 0; j < 4; ++j) { v[j] = v[j] * rstd * *(const LAS f32x4*)(VEC + D + 4 * lane + 256 * j) + *(const LAS f32x4*)(VEC + 2 * D + 4 * lane + 256 * j); *(f32x4*)(C.out + t * D + 4 * lane + 256 * j) = v[j]; }
                }
                if constexpr (WRITE_HIN) {
#pragma unroll
                    for (int j = 0; j < 4; ++j) { const f32x4 h = v[j] * *(const LAS f32x4*)(VEC + 3 * D + 4 * lane + 256 * j) + *(const LAS f32x4*)(VEC + 4 * D + 4 * lane + 256 * j);
                        const unsigned h0 = f2bf(h.x), h1 = f2bf(h.y), h2 = f2bf(h.z), h3 = f2bf(h.w);
                        u32x2 hw; hw.x = h0 | (h1 << 16); hw.y = h2 | (h3 << 16);
                        *(u32x2*)(WSP(bf16, WS_HIN) + t * D + 4 * lane + 256 * j) = hw;
                        if constexpr (NT > 0) {
                            u32x2 lw; lw.x = pk2(h.x - bf2f(h0), h.y - bf2f(h1)); lw.y = pk2(h.z - bf2f(h2), h.w - bf2f(h3));
                            *(LAS u32x2*)(XH + lr * RP_XSTR + 4 * lane + 256 * j) = hw; *(LAS u32x2*)(XL + lr * RP_XSTR + 4 * lane + 256 * j) = lw; } }
                }
                cur = nxt;
            }
            if constexpr (NT > 0) {
                __syncthreads();
                f32x4 acc[NT];
#pragma unroll
                for (int nt = 0; nt < NT; ++nt) acc[nt] = (f32x4){0.f, 0.f, 0.f, 0.f};
#pragma unroll
                for (int ks = 0; ks < 4; ++ks) { const int o = fr * RP_XSTR + wave * 128 + ks * 32 + 8 * q;
                    const bf16x8 ah = *(const LAS bf16x8*)(XH + o), al = *(const LAS bf16x8*)(XL + o);
#pragma unroll
                    for (int nt = 0; nt < NT; ++nt) { acc[nt] = MMA(ah, wh[nt][ks], acc[nt]); acc[nt] = MMA(al, wh[nt][ks], acc[nt]); acc[nt] = MMA(ah, wl[nt][ks], acc[nt]); } }
#pragma unroll
                for (int nt = 0; nt < NT; ++nt)
#pragma unroll
                    for (int r = 0; r < 4; ++r) PART[(wave * 16 + 4 * q + r) * 48 + nt * 16 + fr] = acc[nt][r];
                __syncthreads();
                if constexpr (NT == 1) {
                    if (tid < 128) { const int row = tid >> 3, c = tid & 7; float s = 0.f;
#pragma unroll
                        for (int w8 = 0; w8 < 8; ++w8) s += PART[(w8 * 16 + row) * 48 + c];
                        WSP(float, WS_GATES)[((size_t)rb * 128 + grp * 16 + row) * 8 + c] = s; }
                } else {
                    const float* rbias = WSP(float, WS_RB) + layer * 48;
                    for (int idx = tid; idx < 16 * 48; idx += 512) { const int row = idx / 48, c = idx % 48; float s = 0.f;
#pragma unroll
                        for (int w8 = 0; w8 < 8; ++w8) s += PART[(w8 * 16 + row) * 48 + c];
                        LOG[idx] = s + rbias[c]; }
                    __syncthreads();
                    if (tid < 16) {
                        const LAS float* lg = LOG + tid * 48; int gs = 0; float gm = lg[0];
#pragma unroll
                        for (int g = 1; g < 4; ++g) if (lg[g] > gm) { gm = lg[g]; gs = g; }
                        float den = 0.f;
#pragma unroll
                        for (int g = 0; g < 4; ++g) den += __expf(lg[g] - gm);
                        const float pg = 1.0f / den;
                        const LAS float* el = lg + 16 + gs * 8; int i0 = 0; float v0 = el[0];
#pragma unroll
                        for (int i = 1; i < 8; ++i) if (el[i] > v0) { v0 = el[i]; i0 = i; }
                        int i1 = -1; float v1 = -3.0e38f;
#pragma unroll
                        for (int i = 0; i < 8; ++i) if (i != i0 && el[i] > v1) { v1 = el[i]; i1 = i; }
                        const float e1 = __expf(v1 - v0), w0 = pg / (1.0f + e1), w1 = pg * e1 / (1.0f + e1);
                        const int ex0 = gs * 8 + i0, ex1 = gs * 8 + i1;
                        const int ls0 = __hip_atomic_fetch_add(&LCNT[ex0], 1, __ATOMIC_RELAXED, __HIP_MEMORY_SCOPE_WORKGROUP), ls1 = __hip_atomic_fetch_add(&LCNT[ex1], 1, __ATOMIC_RELAXED, __HIP_MEMORY_SCOPE_WORKGROUP);
                        const int rloc = grp * 16 + tid;
                        REC[rloc * 6 + 0] = ex0; REC[rloc * 6 + 1] = ex1; REC[rloc * 6 + 2] = ls0; REC[rloc * 6 + 3] = ls1;
                        REC[rloc * 6 + 4] = __builtin_bit_cast(int, w0); REC[rloc * 6 + 5] = __builtin_bit_cast(int, w1);
                    }
                }
                __syncthreads();
            }
        }
        if constexpr (NT == 3) {
            __syncthreads();
            if (tid < 32) { const int n = LCNT[tid]; const unsigned gb = n ? atomicAdd(C.ctl + CW_GCNT + layer * 32 + tid, (unsigned)n) : 0u; LCNT[32 + tid] = (int)gb; }
            __syncthreads();
            if (tid < 256) { const int rloc = tid >> 1, k = tid & 1; const int e = REC[rloc * 6 + k], ls = REC[rloc * 6 + 2 + k]; const size_t t = (size_t)rb * 128 + rloc;
                const int slot = LCNT[32 + e] + ls; WSP(int, WS_TOKES)[2 * t + k] = e | (slot << 8); WSP(int, WS_TOKW)[2 * t + k] = REC[rloc * 6 + 4 + k]; WSP(int, WS_ELIST)[e * 32768 + slot] = (int)t; }
            __syncthreads();
        }
    }
}


typedef short v4i16_t __attribute__((ext_vector_type(4)));
DI int img_off(int row, int ch) { return 256 * row + 16 * (ch ^ (((row & 3) << 2) | ((row >> 2) & 3))); }
DI bf16x8 img_tr_frag(const LAS unsigned char* img, int lane, int c, int ks) {
    const int g = lane >> 4, qq = (lane & 15) >> 2, p = lane & 3;
    const int r0 = 32 * ks + 8 * g + qq, ch = 2 * c + (p >> 1), bo = 8 * (p & 1);
    const v4i16_t lo = __builtin_amdgcn_ds_read_tr16_b64_v4i16((LAS v4i16_t*)(img + img_off(r0, ch) + bo));
    const v4i16_t hi = __builtin_amdgcn_ds_read_tr16_b64_v4i16((LAS v4i16_t*)(img + img_off(r0 + 4, ch) + bo));
    return (bf16x8){lo[0], lo[1], lo[2], lo[3], hi[0], hi[1], hi[2], hi[3]};
}
DI bf16x8 img_row_frag(const LAS unsigned char* img, int lane, int rb, int ks) { return *(const LAS bf16x8*)(img + img_off((lane & 15) + 16 * rb, 4 * ks + (lane >> 4))); }
template <int CTRL> DI float dppf(float x) { return __builtin_bit_cast(float, __builtin_amdgcn_mov_dpp(__builtin_bit_cast(int, x), CTRL, 0xf, 0xf, true)); }
DI float row16_sum(float x) { x += dppf<0x128>(x); x += dppf<0x124>(x); x += dppf<0x122>(x); x += dppf<0x121>(x); return x; }
DI float oct_sum(float x) { x += dppf<0xB1>(x); x += dppf<0x4E>(x); x += dppf<0x141>(x); return x; }

constexpr int ML_IMG = 16384, ML_WSTR = 72, ML_HSTR = 264;
constexpr int ML_Q = 0, ML_K = ML_Q + ML_IMG, ML_WM = ML_K + ML_IMG, ML_KW = ML_WM + 64 * ML_WSTR * 2, ML_V0 = ML_KW + ML_IMG, ML_V1 = ML_V0 + ML_IMG,
              ML_AP = ML_V1 + ML_IMG, ML_FL = ML_AP + 2048, ML_MR = ML_FL + 2048, ML_CH = ML_MR + 2048  ,
              ML_NS = ML_CH + 8 * 256, ML_STP = ML_NS + 512, ML_MRS = ML_STP + 64 * 8 * 8, ML_TMP = ML_MRS + 512, ML_END = ML_TMP + 256;
static_assert(ML_END <= RING_BYTES && 64 * ML_HSTR * 2 <= ML_KW, "mlstm LDS");

DI void mlstm_conv(Ctx& C, int mj) {
    const bf16* proj = WSP(bf16, WS_PROJ); bf16* qk = WSP(bf16, WS_HIN);
    const int ch = C.tid & 127, sub = C.tid >> 7, c0 = ch * 8;
    float cw[4][8], cb[8];
#pragma unroll
    for (int e = 0; e < 8; ++e) { cb[e] = C.in[10][(size_t)mj * 1024 + c0 + e];
#pragma unroll
        for (int j = 0; j < 4; ++j) cw[j][e] = C.in[9][((size_t)mj * 4 + j) * 1024 + c0 + e]; }
    const float osc = (c0 >= 512) ? 0.08838834764831845f : 1.0f;
    for (int rb = C.vcu; rb < T / 128; rb += C.G) {
        const int t0 = rb * 128 + sub * 32, pos0 = t0 % SEQ;
        u32x4 w0 = {0u, 0u, 0u, 0u}, w1 = w0, w2 = w0;
        if (pos0 >= 3) { w0 = *(const u32x4*)(proj + (size_t)(t0 - 3) * M_NIN + c0); w1 = *(const u32x4*)(proj + (size_t)(t0 - 2) * M_NIN + c0); w2 = *(const u32x4*)(proj + (size_t)(t0 - 1) * M_NIN + c0); }
#pragma unroll 4
        for (int r = 0; r < 32; ++r) {
            const u32x4 w3 = *(const u32x4*)(proj + (size_t)(t0 + r) * M_NIN + c0);
            const unsigned a0[4] = {w0.x, w0.y, w0.z, w0.w}, a1[4] = {w1.x, w1.y, w1.z, w1.w}, a2[4] = {w2.x, w2.y, w2.z, w2.w}, a3[4] = {w3.x, w3.y, w3.z, w3.w};
            float o[8];
#pragma unroll
            for (int e = 0; e < 4; ++e) {
                o[2 * e] = cb[2 * e] + cw[0][2 * e] * bflo(a0[e]) + cw[1][2 * e] * bflo(a1[e]) + cw[2][2 * e] * bflo(a2[e]) + cw[3][2 * e] * bflo(a3[e]);
                o[2 * e + 1] = cb[2 * e + 1] + cw[0][2 * e + 1] * bfhi(a0[e]) + cw[1][2 * e + 1] * bfhi(a1[e]) + cw[2][2 * e + 1] * bfhi(a2[e]) + cw[3][2 * e + 1] * bfhi(a3[e]); }
#pragma unroll
            for (int e = 0; e < 8; ++e) o[e] = osc * o[e] / (1.0f + __expf(-o[e]));
            u32x4 ov; ov.x = pk2(o[0], o[1]); ov.y = pk2(o[2], o[3]); ov.z = pk2(o[4], o[5]); ov.w = pk2(o[6], o[7]);
            *(u32x4*)(qk + (size_t)(t0 + r) * D + c0) = ov;
            w0 = w1; w1 = w2; w2 = w3;
        }
    }
}

DI void mlstm_seg_scalars(Ctx& C, int mj, int bh, int seg, int tid) {
    LAS float* AP = (LAS float*)(C.lds + ML_AP); LAS float* FL = (LAS float*)(C.lds + ML_FL); LAS float* MR = (LAS float*)(C.lds + ML_MR); LAS float* TMP = (LAS float*)(C.lds + ML_TMP);
    const int b = bh >> 2, h = bh & 3, lane = tid & 63, wave = C.wave; const size_t t = (size_t)b * SEQ + seg * M_SEGT + tid;
    const float* g = WSP(float, WS_GATES) + t * 8; const float* bif = C.in[11] + mj * 8;
    const float li = g[h] + bif[h], x = g[4 + h] + bif[4 + h];
    const float lf = fminf(x, 0.f) - log1pf(expf(-fabsf(x)));
    float s = lf;
#pragma unroll
    for (int o = 1; o < 64; o <<= 1) { const float n = __shfl_up(s, o); if (lane >= o) s += n; }
    if (lane == 63) TMP[wave] = s;
    __syncthreads();
    float off = 0.f;
    for (int w = 0; w < wave; ++w) off += TMP[w];
    s += off;
    const float ap = li - s; float m = ap;
#pragma unroll
    for (int o = 1; o < 64; o <<= 1) { const float n = __shfl_up(m, o); if (lane >= o) m = fmaxf(m, n); }
    if (lane == 63) TMP[16 + wave] = m;
    __syncthreads();
    for (int w = 0; w < wave; ++w) m = fmaxf(m, TMP[16 + w]);
    AP[tid] = ap; FL[tid] = s; MR[tid] = m;
    __syncthreads();
}
struct MlTile { u32x4 k[2], v[4]; };
DI void ml_issue_kv(MlTile& R, const bf16* qk, const bf16* proj, size_t tok0, int h, int tid) {
#pragma unroll
    for (int i = 0; i < 2; ++i) R.k[i] = *(const u32x4*)(qk + (tok0 + (tid >> 4) + 32 * i) * D + 512 + h * 128 + (tid & 15) * 8);
#pragma unroll
    for (int i = 0; i < 4; ++i) { const int p = tid + 512 * i; R.v[i] = *(const u32x4*)(proj + (tok0 + (p >> 5)) * M_NIN + 1024 + h * 256 + (p & 31) * 8); }
}
DI u32x4 scale_bf8(u32x4 a, float s) { u32x4 o; o.x = pk2(bflo(a.x) * s, bfhi(a.x) * s); o.y = pk2(bflo(a.y) * s, bfhi(a.y) * s); o.z = pk2(bflo(a.z) * s, bfhi(a.z) * s); o.w = pk2(bflo(a.w) * s, bfhi(a.w) * s); return o; }
DI void ml_store_kwv(Ctx& C, const MlTile& R, const LAS float* WG, int tid) {
#pragma unroll
    for (int i = 0; i < 2; ++i) { const int row = (tid >> 4) + 32 * i; *(LAS u32x4*)(C.lds + ML_KW + img_off(row, tid & 15)) = scale_bf8(R.k[i], WG[row]); }
#pragma unroll
    for (int i = 0; i < 4; ++i) { const int p = tid + 512 * i, row = p >> 5, c32 = p & 31; *(LAS u32x4*)(C.lds + ((c32 & 16) ? ML_V1 : ML_V0) + img_off(row, c32 & 15)) = R.v[i]; }
}
DI void mlstm_state_update(Ctx& C, f32x4 (&acc)[8][2], f32x4& nacc, float decay, int lane) {
    const LAS unsigned char* KW = C.lds + ML_KW; const int w = C.wave; const LAS unsigned char* VI = C.lds + ((w & 4) ? ML_V1 : ML_V0);
    const bf16x8 ones = {0x3F80, 0x3F80, 0x3F80, 0x3F80, 0x3F80, 0x3F80, 0x3F80, 0x3F80};
#pragma unroll
    for (int dt = 0; dt < 8; ++dt) { acc[dt][0] = acc[dt][0] * decay; acc[dt][1] = acc[dt][1] * decay; }
    nacc = nacc * decay;
#pragma unroll
    for (int ks = 0; ks < 2; ++ks) {
        const bf16x8 b0 = img_tr_frag(VI, lane, (2 * w) & 7, ks), b1 = img_tr_frag(VI, lane, (2 * w + 1) & 7, ks);
#pragma unroll
        for (int dt = 0; dt < 8; ++dt) { const bf16x8 a = img_tr_frag(KW, lane, dt, ks);
            acc[dt][0] = MMA(a, b0, acc[dt][0]); acc[dt][1] = MMA(a, b1, acc[dt][1]); }
        nacc = MMA(img_tr_frag(KW, lane, w, ks), ones, nacc);
    }
}

DI void mlstm_m1(Ctx& C, int mj) {
    const bf16* proj = WSP(bf16, WS_PROJ); const bf16* qk = WSP(bf16, WS_HIN);
    LAS float* AP = (LAS float*)(C.lds + ML_AP); LAS float* FL = (LAS float*)(C.lds + ML_FL); LAS float* MR = (LAS float*)(C.lds + ML_MR); LAS float* WG = (LAS float*)(C.lds + ML_CH);
    const int wave = C.wave;
    for (int item = C.vcu; item < 8 * M_NSEG; item += C.G) {
        const int bh = item / M_NSEG, seg = item % M_NSEG, b = bh >> 2, h = bh & 3; const size_t tok_seg = (size_t)b * SEQ + seg * M_SEGT;
        __syncthreads();
        int tz0 = threadIdx.x; asm volatile("" : "+v"(tz0));
        MlTile R; ml_issue_kv(R, qk, proj, tok_seg, h, tz0);
        mlstm_seg_scalars(C, mj, bh, seg, tz0);
        f32x4 acc[8][2], nacc = {0.f, 0.f, 0.f, 0.f};
#pragma unroll
        for (int dt = 0; dt < 8; ++dt) { acc[dt][0] = (f32x4){0.f, 0.f, 0.f, 0.f}; acc[dt][1] = (f32x4){0.f, 0.f, 0.f, 0.f}; }
        for (int c = 0; c < M_SEGC; ++c) {
            int tz = threadIdx.x; asm volatile("" : "+v"(tz)); const int tid = tz, lane = tz & 63;
            const float mnew = MR[64 * c + 63], mold = (c == 0) ? -1.0e30f : MR[64 * c - 1];
            const float decay = __expf(mold - mnew);
            if (tid < 64) WG[tid] = __expf(AP[64 * c + tid] - mnew);
            __syncthreads();
            ml_store_kwv(C, R, WG, tid);
            if (c + 1 < M_SEGC) ml_issue_kv(R, qk, proj, tok_seg + 64 * (c + 1), h, tid);
            __syncthreads();
            mlstm_state_update(C, acc, nacc, decay, lane);
        }
        float* dst = WSP(float, WS_SLOC) + (size_t)item * M_STATE;
        int tz1 = threadIdx.x; asm volatile("" : "+v"(tz1)); const int lane1 = tz1 & 63;
#pragma unroll
        for (int dt = 0; dt < 8; ++dt)
#pragma unroll
            for (int vtl = 0; vtl < 2; ++vtl)
#pragma unroll
                for (int r = 0; r < 4; ++r) dst[(((wave * 8 + dt) * 2 + vtl) * 4 + r) * 64 + lane1] = acc[dt][vtl][r];
        if ((lane1 & 15) == 0) {
#pragma unroll
            for (int r = 0; r < 4; ++r) dst[32768 + wave * 16 + 4 * (lane1 >> 4) + r] = nacc[r]; }
        if (tz1 == 0) { WSP(float, WS_SEGF)[item] = FL[511]; WSP(float, WS_SEGM)[item] = MR[511]; }
    }
}
DI void mlstm_m15(Ctx& C) {
    LAS float* DEC = (LAS float*)C.lds; LAS float* SCL = DEC + 256;
    __syncthreads();
    if (C.tid < 8) { const int bh = C.tid; float F0 = 0.f, M0 = 0.f;
        for (int seg = 0; seg < M_NSEG; ++seg) { const float cand = WSP(float, WS_SEGM)[bh * M_NSEG + seg] - F0, mn = fmaxf(M0, cand);
            DEC[bh * 32 + seg] = __expf(M0 - mn); SCL[bh * 32 + seg] = __expf(cand - mn); F0 += WSP(float, WS_SEGF)[bh * M_NSEG + seg]; M0 = mn; } }
    __syncthreads();
    const int gt = C.vcu * 512 + C.tid, NGT = C.G * 512;
    for (int i = gt; i < 8 * M_STATE; i += NGT) { const int bh = i / M_STATE, e = i % M_STATE; float s = 0.f;
        const float* src = WSP(float, WS_SLOC) + (size_t)bh * M_NSEG * M_STATE + e; float* dst = WSP(float, WS_SINIT) + (size_t)bh * M_NSEG * M_STATE + e;
#pragma unroll 8
        for (int seg = 0; seg < M_NSEG; ++seg) { dst[(size_t)seg * M_STATE] = s; s = s * DEC[bh * 32 + seg] + SCL[bh * 32 + seg] * src[(size_t)seg * M_STATE]; } }
}
DI void mlstm_m2(Ctx& C, int mj) {
    const bf16* proj = WSP(bf16, WS_PROJ); const bf16* qk = WSP(bf16, WS_HIN);
    const LAS unsigned char* QI = C.lds + ML_Q; const LAS unsigned char* KI = C.lds + ML_K;
    LAS bf16* WM = (LAS bf16*)(C.lds + ML_WM); LAS bf16* HOUT = (LAS bf16*)(C.lds + ML_Q);
    LAS float* AP = (LAS float*)(C.lds + ML_AP); LAS float* FL = (LAS float*)(C.lds + ML_FL); LAS float* MR = (LAS float*)(C.lds + ML_MR);
    LAS float* AG = (LAS float*)(C.lds + ML_CH); LAS float* MG = AG + 64; LAS float* FAC = AG + 128; LAS float* EMT = AG + 192; LAS float* DENP = AG + 256  ; LAS float* QN = AG + 384; LAS float* WG = AG + 448;
    LAS float* NS = (LAS float*)(C.lds + ML_NS); LAS f32x2* STP = (LAS f32x2*)(C.lds + ML_STP); LAS f32x2* MRS = (LAS f32x2*)(C.lds + ML_MRS); LAS float* TMP = (LAS float*)(C.lds + ML_TMP);
    const int wave = C.wave;
    for (int item = C.vcu; item < 8 * M_NSEG; item += C.G) {
        const int bh = item / M_NSEG, seg = item % M_NSEG, b = bh >> 2, h = bh & 3; const size_t tok_seg = (size_t)b * SEQ + seg * M_SEGT;
        __syncthreads();
        int tz0 = threadIdx.x; asm volatile("" : "+v"(tz0));
        MlTile R; u32x4 rq[2];
        ml_issue_kv(R, qk, proj, tok_seg, h, tz0);
#pragma unroll
        for (int i = 0; i < 2; ++i) rq[i] = *(const u32x4*)(qk + (tok_seg + (tz0 >> 4) + 32 * i) * D + h * 128 + (tz0 & 15) * 8);
        if (tz0 == 0) { float F0 = 0.f, M0 = 0.f;
            for (int sg = 0; sg < seg; ++sg) { M0 = fmaxf(M0, WSP(float, WS_SEGM)[bh * M_NSEG + sg] - F0); F0 += WSP(float, WS_SEGF)[bh * M_NSEG + sg]; }
            TMP[32] = F0; TMP[33] = M0; }
        mlstm_seg_scalars(C, mj, bh, seg, tz0);
        const float Fseg0 = TMP[32], Mseg0 = TMP[33];
        f32x4 acc[8][2], nacc;
        { const float* src = WSP(float, WS_SINIT) + (size_t)item * M_STATE;
#pragma unroll
          for (int dt = 0; dt < 8; ++dt)
#pragma unroll
              for (int vtl = 0; vtl < 2; ++vtl)
#pragma unroll
                  for (int r = 0; r < 4; ++r) acc[dt][vtl][r] = src[(((wave * 8 + dt) * 2 + vtl) * 4 + r) * 64 + (tz0 & 63)];
#pragma unroll
          for (int r = 0; r < 4; ++r) nacc[r] = src[32768 + wave * 16 + 4 * ((tz0 & 63) >> 4) + r];
          if (tz0 < 128) NS[tz0] = src[32768 + tz0]; }
        for (int c = 0; c < M_SEGC; ++c) {
            int tz = threadIdx.x; asm volatile("" : "+v"(tz)); const int tid = tz;
#define ML_LANE() int lz_ = tz; asm volatile("" : "+v"(lz_)); const int lane = lz_ & 63, fr = lane & 15, q = lane >> 4; (void)fr; (void)q
            const size_t tok0 = tok_seg + 64 * c;
            const float Mc0 = (c == 0) ? Mseg0 : fmaxf(Mseg0, MR[64 * c - 1] - Fseg0);
            const float Mend = fmaxf(Mseg0, MR[64 * c + 63] - Fseg0);
            const float decay = __expf(Mc0 - Mend);
            if (tid < 64) { const int s = tid; const float ag = AP[64 * c + s] - Fseg0, mt = fmaxf(Mseg0, MR[64 * c + s] - Fseg0);
                AG[s] = ag; MG[s] = mt; FAC[s] = __expf(Mc0 - mt); EMT[s] = __expf(-(Fseg0 + FL[64 * c + s] + mt)); WG[s] = __expf(ag - Mend); }
            __syncthreads();
#pragma unroll
            for (int i = 0; i < 2; ++i) { const int row = (tid >> 4) + 32 * i; *(LAS u32x4*)(C.lds + ML_Q + img_off(row, tid & 15)) = rq[i]; *(LAS u32x4*)(C.lds + ML_K + img_off(row, tid & 15)) = R.k[i]; }
            ml_store_kwv(C, R, WG, tid);
            __syncthreads();
            { ML_LANE(); const int tt = wave >> 1, st0 = (wave & 1) * 2; f32x4 d0 = {0.f, 0.f, 0.f, 0.f}, d1 = {0.f, 0.f, 0.f, 0.f};
#pragma unroll
              for (int ks = 0; ks < 4; ++ks) { const bf16x8 a = img_row_frag(QI, lane, tt, ks); d0 = MMA(a, img_row_frag(KI, lane, st0, ks), d0); d1 = MMA(a, img_row_frag(KI, lane, st0 + 1, ks), d1); }
              const int s0 = st0 * 16 + fr, s1 = s0 + 16; const float a0 = AG[s0], a1 = AG[s1];
#pragma unroll
              for (int r = 0; r < 4; ++r) { const int t = tt * 16 + 4 * q + r; const float mt = MG[t];
                  const float w0 = (s0 <= t) ? __expf(a0 - mt) * d0[r] : 0.f, w1 = (s1 <= t) ? __expf(a1 - mt) * d1[r] : 0.f;
                  WM[t * ML_WSTR + s0] = (bf16)f2bf(w0); WM[t * ML_WSTR + s1] = (bf16)f2bf(w1);
                  const float ps = row16_sum(w0 + w1);
                  if (fr == 0) DENP[t * 2 + (wave & 1)] = ps; } }
            { const int t = tid >> 3, part = tid & 7; const LAS float* np = NS + part * 16;
              const u32x4 a = *(const LAS u32x4*)(QI + img_off(t, 2 * part)), b2 = *(const LAS u32x4*)(QI + img_off(t, 2 * part + 1));
              float s = bflo(a.x) * np[0] + bfhi(a.x) * np[1] + bflo(a.y) * np[2] + bfhi(a.y) * np[3] + bflo(a.z) * np[4] + bfhi(a.z) * np[5] + bflo(a.w) * np[6] + bfhi(a.w) * np[7];
              s += bflo(b2.x) * np[8] + bfhi(b2.x) * np[9] + bflo(b2.y) * np[10] + bfhi(b2.y) * np[11] + bflo(b2.z) * np[12] + bfhi(b2.z) * np[13] + bflo(b2.w) * np[14] + bfhi(b2.w) * np[15];
              s = oct_sum(s);
              if (part == 0) QN[t] = s; }
            u32x4 og[4];
#pragma unroll
            for (int jj = 0; jj < 4; ++jj) og[jj] = *(const u32x4*)(proj + (tok0 + (tid >> 3)) * M_NIN + 2048 + h * 256 + ((tid & 7) + 8 * jj) * 8);
            __syncthreads();
            f32x4 num[4][2];
            {
            ML_LANE();
#pragma unroll
            for (int tt = 0; tt < 4; ++tt) { num[tt][0] = (f32x4){0.f, 0.f, 0.f, 0.f}; num[tt][1] = (f32x4){0.f, 0.f, 0.f, 0.f}; }
#pragma unroll
            for (int ks = 0; ks < 4; ++ks) {
                u32x4 p0, p1;
                p0.x = pk2(acc[2 * ks][0][0], acc[2 * ks][0][1]); p0.y = pk2(acc[2 * ks][0][2], acc[2 * ks][0][3]); p0.z = pk2(acc[2 * ks + 1][0][0], acc[2 * ks + 1][0][1]); p0.w = pk2(acc[2 * ks + 1][0][2], acc[2 * ks + 1][0][3]);
                p1.x = pk2(acc[2 * ks][1][0], acc[2 * ks][1][1]); p1.y = pk2(acc[2 * ks][1][2], acc[2 * ks][1][3]); p1.z = pk2(acc[2 * ks + 1][1][0], acc[2 * ks + 1][1][1]); p1.w = pk2(acc[2 * ks + 1][1][2], acc[2 * ks + 1][1][3]);
                const bf16x8 b0 = __builtin_bit_cast(bf16x8, p0), b1 = __builtin_bit_cast(bf16x8, p1);
#pragma unroll
                for (int tt = 0; tt < 4; ++tt) { const int row = tt * 16 + fr;
                    const u32x2 lo = *(const LAS u32x2*)(QI + img_off(row, 4 * ks + (q >> 1)) + 8 * (q & 1)), hi = *(const LAS u32x2*)(QI + img_off(row, 4 * ks + 2 + (q >> 1)) + 8 * (q & 1));
                    u32x4 av; av.x = lo.x; av.y = lo.y; av.z = hi.x; av.w = hi.y; const bf16x8 a = __builtin_bit_cast(bf16x8, av);
                    num[tt][0] = MMA(a, b0, num[tt][0]); num[tt][1] = MMA(a, b1, num[tt][1]); }
            }
#pragma unroll
            for (int tt = 0; tt < 4; ++tt)
#pragma unroll
                for (int r = 0; r < 4; ++r) { const float f = FAC[tt * 16 + 4 * q + r]; num[tt][0][r] *= f; num[tt][1][r] *= f; }
            { const LAS unsigned char* VI = C.lds + ((wave & 4) ? ML_V1 : ML_V0);
#pragma unroll
              for (int ks = 0; ks < 2; ++ks) {
                const bf16x8 b0 = img_tr_frag(VI, lane, (2 * wave) & 7, ks), b1 = img_tr_frag(VI, lane, (2 * wave + 1) & 7, ks);
#pragma unroll
                for (int tt = 0; tt < 4; ++tt) { const bf16x8 a = *(const LAS bf16x8*)(WM + (tt * 16 + fr) * ML_WSTR + ks * 32 + 8 * q);
                    num[tt][0] = MMA(a, b0, num[tt][0]); num[tt][1] = MMA(a, b1, num[tt][1]); } } }
            }
            {
            ML_LANE();
#pragma unroll
            for (int tt = 0; tt < 4; ++tt)
#pragma unroll
                for (int r = 0; r < 4; ++r) { const int t = tt * 16 + 4 * q + r; const float den = (DENP[2 * t] + DENP[2 * t + 1]) + FAC[t] * QN[t]; const float inv = 1.0f / fmaxf(fabsf(den), EMT[t]);
                    const float h0 = num[tt][0][r] * inv, h1 = num[tt][1][r] * inv; num[tt][0][r] = h0; num[tt][1][r] = h1;
                    const float s1 = row16_sum(h0 + h1), s2 = row16_sum(h0 * h0 + h1 * h1);
                    if (fr == 0) STP[t * 8 + wave] = (f32x2){s1, s2}; }
            }
            { ML_LANE(); mlstm_state_update(C, acc, nacc, decay, lane); }
            if (c + 1 < M_SEGC) { ml_issue_kv(R, qk, proj, tok0 + 64, h, tid);
#pragma unroll
                for (int i = 0; i < 2; ++i) rq[i] = *(const u32x4*)(qk + (tok0 + 64 + (tid >> 4) + 32 * i) * D + h * 128 + (tid & 15) * 8); }
            __syncthreads();
            { ML_LANE(); if (fr == 0) {
#pragma unroll
                for (int r = 0; r < 4; ++r) NS[wave * 16 + 4 * q + r] = nacc[r]; } }
            if (tid < 64) { float s1 = 0.f, s2 = 0.f;
#pragma unroll
                for (int w = 0; w < 8; ++w) { const f32x2 p = STP[tid * 8 + w]; s1 += p.x; s2 += p.y; }
                const float mean = s1 * (1.0f / 256.0f), var = fmaxf(s2 * (1.0f / 256.0f) - mean * mean, 0.f); MRS[tid] = (f32x2){mean, 1.0f / sqrtf(var + LN_EPS)}; }
            __syncthreads();
            { ML_LANE();
#pragma unroll
            for (int tt = 0; tt < 4; ++tt)
#pragma unroll
                for (int r = 0; r < 4; ++r) { const int t = tt * 16 + 4 * q + r; const f32x2 mr = MRS[t];
                    HOUT[t * ML_HSTR + (2 * wave) * 16 + fr] = (bf16)f2bf((num[tt][0][r] - mr.x) * mr.y); HOUT[t * ML_HSTR + (2 * wave + 1) * 16 + fr] = (bf16)f2bf((num[tt][1][r] - mr.x) * mr.y); }
            }
            __syncthreads();
            { const int t = tid >> 3, c8 = tid & 7; const float* ng = C.in[12] + (size_t)mj * 1024 + h * 256;
#pragma unroll
              for (int jj = 0; jj < 4; ++jj) { const int col = (c8 + 8 * jj) * 8;
                  const u32x4 hv = *(const LAS u32x4*)(HOUT + t * ML_HSTR + col); const u32x4 ov = og[jj];
                  const f32x4 g0 = *(const f32x4*)(ng + col), g1 = *(const f32x4*)(ng + col + 4);
                  u32x4 w;
                  w.x = pk2(bflo(hv.x) * g0.x * sigmoidf_(bflo(ov.x)), bfhi(hv.x) * g0.y * sigmoidf_(bfhi(ov.x))); w.y = pk2(bflo(hv.y) * g0.z * sigmoidf_(bflo(ov.y)), bfhi(hv.y) * g0.w * sigmoidf_(bfhi(ov.y)));
                  w.z = pk2(bflo(hv.z) * g1.x * sigmoidf_(bflo(ov.z)), bfhi(hv.z) * g1.y * sigmoidf_(bfhi(ov.z))); w.w = pk2(bflo(hv.w) * g1.z * sigmoidf_(bflo(ov.w)), bfhi(hv.w) * g1.w * sigmoidf_(bfhi(ov.w)));
                  *(u32x4*)(WSP(bf16, WS_MIXA) + (tok0 + t) * D + h * 256 + col) = w; } }
#undef ML_LANE
        }
    }
}

constexpr int S5_BUSTR = 132, S5_XSTR = 136, S5_WAVE_LDS = 16 * S5_BUSTR * 4 + 16 * S5_XSTR * 2;
static_assert(8 * S5_WAVE_LDS <= RING_BYTES, "s5 LDS");
DI float gelu_tanh(float x) { const float z = 0.7978845608028654f * (x + 0.044715f * x * x * x); return x * (1.0f - 1.0f / (1.0f + __expf(2.0f * z))); }

template <int PASS> DI void s5_pass(Ctx& C) {
    const int lane = C.lane, wave = C.wave, fr = lane & 15, q = lane >> 4;
    LAS float* BU = (LAS float*)(C.lds + wave * S5_WAVE_LDS); LAS bf16* XS = (LAS bf16*)(C.lds + wave * S5_WAVE_LDS + 16 * S5_BUSTR * 4);
    const bf16* U = WSP(bf16, WS_PROJ);
    for (int wi = C.vcu; wi < 2 * S5_NSEG * 8; wi += C.G) {
        const int g = (wi & 7) * 8 + wave, bs = wi >> 3, b = bs / S5_NSEG, seg = bs % S5_NSEG; const size_t tokbase = (size_t)b * SEQ + seg * S5_SEGT;
        const float ar = WSP(float, WS_S5ABAR)[(g * 64 + lane) * 2], ai = WSP(float, WS_S5ABAR)[(g * 64 + lane) * 2 + 1];
        bf16x8 bB[8];
#pragma unroll
        for (int nt = 0; nt < 8; ++nt) { bB[nt] = (bf16x8){0, 0, 0, 0, 0, 0, 0, 0}; if (q < 2) bB[nt] = *(const bf16x8*)(WSP(bf16, WS_S5BBT) + ((size_t)g * 128 + nt * 16 + fr) * 16 + 8 * q); }
        bf16x8 cB[4]; float xr = 0.f, xi = 0.f, dsk = 0.f;
        if constexpr (PASS == 2) {
#pragma unroll
            for (int ks = 0; ks < 4; ++ks) cB[ks] = *(const bf16x8*)(WSP(bf16, WS_S5CMT) + ((size_t)g * 16 + fr) * 128 + ks * 32 + 8 * q);
            dsk = C.in[22][g * 16 + fr];
            if (seg > 0) { const float dt = expf(C.in[17][g]), lr = C.in[15][g * 64 + lane], li = C.in[16][g * 64 + lane];
                const float mg = expf(lr * dt * (float)S5_SEGT); float sn, cs; sincosf(li * dt * (float)S5_SEGT, &sn, &cs); const float pr = mg * cs, pi = mg * sn;
                const float* en = WSP(float, WS_S5END) + (((size_t)b * 64 + g) * S5_NSEG) * 128 + lane * 2;
                for (int sp = 0; sp < seg; ++sp) { const float er = en[sp * 128], ei = en[sp * 128 + 1]; const float nr = pr * xr - pi * xi + er, ni = pr * xi + pi * xr + ei; xr = nr; xi = ni; } }
        }
        for (int sub = 0; sub < S5_SEGT / 16; ++sub) {
            const size_t tok0 = tokbase + sub * 16;
            bf16x8 a = (bf16x8){0, 0, 0, 0, 0, 0, 0, 0};
            if (q < 2) a = *(const bf16x8*)(U + (tok0 + fr) * D + g * 16 + 8 * q);
#pragma unroll
            for (int nt = 0; nt < 8; ++nt) { const f32x4 d = MMA(a, bB[nt], (f32x4){0.f, 0.f, 0.f, 0.f});
#pragma unroll
                for (int r = 0; r < 4; ++r) BU[(4 * q + r) * S5_BUSTR + nt * 16 + fr] = d[r]; }
            asm volatile("s_waitcnt lgkmcnt(0)" ::: "memory");
#pragma unroll
            for (int t = 0; t < 16; ++t) { const float br = BU[t * S5_BUSTR + lane], bi = BU[t * S5_BUSTR + 64 + lane];
                const float nr = ar * xr - ai * xi + br, ni = ar * xi + ai * xr + bi; xr = nr; xi = ni;
                if constexpr (PASS == 2) { XS[t * S5_XSTR + lane] = (bf16)f2bf(xr); XS[t * S5_XSTR + 64 + lane] = (bf16)f2bf(xi); } }
            if constexpr (PASS == 2) {
                asm volatile("s_waitcnt lgkmcnt(0)" ::: "memory");
                f32x4 y = {0.f, 0.f, 0.f, 0.f};
#pragma unroll
                for (int ks = 0; ks < 4; ++ks) { const bf16x8 xa = *(const LAS bf16x8*)(XS + fr * S5_XSTR + ks * 32 + 8 * q); y = MMA(xa, cB[ks], y); }
#pragma unroll
                for (int r = 0; r < 4; ++r) { const size_t o = (tok0 + 4 * q + r) * D + g * 16 + fr; const float uv = bf2f(U[o]);
                    WSP(bf16, WS_MIXA)[o] = (bf16)f2bf(gelu_tanh(y[r] + dsk * uv)); }
            }
            asm volatile("s_waitcnt lgkmcnt(0)" ::: "memory");
        }
        if constexpr (PASS == 1) { float* en = WSP(float, WS_S5END) + ((((size_t)b * 64 + g) * S5_NSEG) + seg) * 128 + lane * 2; en[0] = xr; en[1] = xi; }
    }
}

constexpr int AT_KSTR = 72, AT_VSTR = 200, AT_KS = 0, AT_VT = 192 * AT_KSTR * 2, AT_END = AT_VT + 64 * AT_VSTR * 2;
static_assert(AT_END <= RING_BYTES, "attn LDS");
DI void swa_phase(Ctx& C) {
    const bf16* QKV = WSP(bf16, WS_PROJ);
    LAS bf16* KS = (LAS bf16*)(C.lds + AT_KS); LAS bf16* VT = (LAS bf16*)(C.lds + AT_VT);
    const int lane = C.lane, wave = C.wave, tid = C.tid, fr = lane & 15, q = lane >> 4;
    for (int item = C.vcu; item < BATCH * A_KV * (SEQ / 64); item += C.G) {
        const int qb = item % (SEQ / 64), kvh = (item / (SEQ / 64)) % A_KV, b = item / ((SEQ / 64) * A_KV); const int q0 = qb * 64; const size_t tokb = (size_t)b * SEQ;
        __syncthreads();
#pragma unroll
        for (int i = 0; i < 3; ++i) { const int kk = (tid >> 3) + 64 * i, ch = tid & 7, kp = q0 - 128 + kk; u32x4 v = {0u, 0u, 0u, 0u};
            if (kp >= 0) v = *(const u32x4*)(QKV + (tokb + kp) * A_NQKV + 1024 + kvh * 64 + ch * 8);
            *(LAS u32x4*)(KS + kk * AT_KSTR + ch * 8) = v; }
#pragma unroll
        for (int i = 0; i < 3; ++i) { const int kk = lane + 64 * i, kp = q0 - 128 + kk; u32x4 v = {0u, 0u, 0u, 0u};
            if (kp >= 0) v = *(const u32x4*)(QKV + (tokb + kp) * A_NQKV + 1280 + kvh * 64 + wave * 8);
            const unsigned w[4] = {v.x, v.y, v.z, v.w};
#pragma unroll
            for (int e = 0; e < 4; ++e) { VT[(wave * 8 + 2 * e) * AT_VSTR + kk] = (bf16)(w[e] & 0xffffu); VT[(wave * 8 + 2 * e + 1) * AT_VSTR + kk] = (bf16)(w[e] >> 16); } }
        __syncthreads();
        const int g = wave >> 1, head = kvh * 4 + g; const float sink = C.in[26][head];
#pragma unroll 1
        for (int rt = 0; rt < 2; ++rt) {
            const int r0 = (wave & 1) * 32 + rt * 16, kt0 = r0 >> 4; const size_t tq = tokb + q0 + r0 + fr;
            const bf16x8 qf0 = *(const bf16x8*)(QKV + tq * A_NQKV + head * 64 + 8 * q), qf1 = *(const bf16x8*)(QKV + tq * A_NQKV + head * 64 + 32 + 8 * q);
            f32x4 s[9];
#pragma unroll
            for (int kt = 0; kt < 9; ++kt) { const LAS bf16* kp_ = KS + ((kt0 + kt) * 16 + fr) * AT_KSTR + 8 * q;
                s[kt] = MMA(*(const LAS bf16x8*)kp_, qf0, (f32x4){0.f, 0.f, 0.f, 0.f}); s[kt] = MMA(*(const LAS bf16x8*)(kp_ + 32), qf1, s[kt]); }
            float m = sink;
#pragma unroll
            for (int kt = 0; kt < 9; ++kt)
#pragma unroll
                for (int r = 0; r < 4; ++r) { const int kk = (kt0 + kt) * 16 + 4 * q + r; const bool ok = (kk > r0 + fr) && (kk <= r0 + fr + 128) && (q0 - 128 + kk >= 0);
                    s[kt][r] = ok ? s[kt][r] * 0.125f : -3.0e38f; m = fmaxf(m, s[kt][r]); }
            m = fmaxf(m, __shfl_xor(m, 16)); m = fmaxf(m, __shfl_xor(m, 32));
            float l = 0.f;
#pragma unroll
            for (int kt = 0; kt < 9; ++kt)
#pragma unroll
                for (int r = 0; r < 4; ++r) { const float p = __expf(s[kt][r] - m); s[kt][r] = p; l += p; }
            l += __shfl_xor(l, 16); l += __shfl_xor(l, 32);
            const float inv = 1.0f / (l + __expf(sink - m));
            f32x4 o[4];
#pragma unroll
            for (int dt = 0; dt < 4; ++dt) o[dt] = (f32x4){0.f, 0.f, 0.f, 0.f};
#pragma unroll
            for (int pr = 0; pr < 5; ++pr) { const int ka = 2 * pr, kb = 2 * pr + 1;
                u32x4 pw; pw.x = pk2(s[ka][0] * inv, s[ka][1] * inv); pw.y = pk2(s[ka][2] * inv, s[ka][3] * inv);
                if (kb < 9) { pw.z = pk2(s[kb < 9 ? kb : 8][0] * inv, s[kb < 9 ? kb : 8][1] * inv); pw.w = pk2(s[kb < 9 ? kb : 8][2] * inv, s[kb < 9 ? kb : 8][3] * inv); } else { pw.z = 0u; pw.w = 0u; }
                const bf16x8 pb = __builtin_bit_cast(bf16x8, pw);
#pragma unroll
                for (int dt = 0; dt < 4; ++dt) { const LAS bf16* vp = VT + (dt * 16 + fr) * AT_VSTR + 4 * q;
                    const u32x2 lo = *(const LAS u32x2*)(vp + (kt0 + ka) * 16); u32x2 hi = {0u, 0u}; if (kb < 9) hi = *(const LAS u32x2*)(vp + (kt0 + (kb < 9 ? kb : 8)) * 16);
                    u32x4 av; av.x = lo.x; av.y = lo.y; av.z = hi.x; av.w = hi.y;
                    o[dt] = MMA(__builtin_bit_cast(bf16x8, av), pb, o[dt]); } }
            bf16* orow = WSP(bf16, WS_MIXA) + tq * D + head * 64 + 4 * q;
#pragma unroll
            for (int dt = 0; dt < 4; ++dt) { u32x2 w; w.x = pk2(o[dt][0], o[dt][1]); w.y = pk2(o[dt][2], o[dt][3]); *(u32x2*)(orow + dt * 16) = w; }
        }
    }
}

template <class Epi> DI void dense_gemm(Ctx& C, const bf16* A, const bf16* Bt, int N, int K, const Epi& E) {
    pg8::Gemm g{A, Bt, T, N, K}; pg8::StaticOrder S; S.init(T, N, C.G, (int)blockIdx.x);
    pg8::gemm_phase<Epi, pg8::StaticOrder, true, true>(C.lds, g, S, E);
}
DI void moe_gemm1(Ctx& C, int layer) {
    const int nunits = moe_tables(C, layer);
    pg8::Gemm g{WSP(bf16, WS_HIN), WSP(bf16, WS_W13) + (size_t)layer * N_EXP * D * D, MOE_P, D, D};
    pg8::MoeOrder S{(const LAS int*)(C.lds + MISC_OFF), C.G, (int)blockIdx.x, nunits, WSP(int, WS_ELIST)};
    pg8::EpiPair<0> E{WSP(bf16, WS_HID), D_EXP, 3};
    pg8::gemm_phase<pg8::EpiPair<0>, pg8::MoeOrder, true, true, true>(C.lds, g, S, E);
}
DI void moe_gemm2(Ctx& C, int layer) {
    const int nunits = moe_tables(C, layer);
    pg8::Gemm g{WSP(bf16, WS_HID), WSP(bf16, WS_W2) + (size_t)layer * N_EXP * D * D_EXP, MOE_P, D, D_EXP};
    pg8::MoeOrder S{(const LAS int*)(C.lds + MISC_OFF), C.G, (int)blockIdx.x, nunits, nullptr};
    pg8::EpiStore E{WSP(bf16, WS_YEXP), D, nullptr, 3};
    pg8::gemm_phase<pg8::EpiStore, pg8::MoeOrder, true, true>(C.lds, g, S, E);
}

constexpr int N_PHASES = 37;
#ifndef REP_MASK
#define REP_MASK 0
#endif
struct Args { const float* in[35]; float* out; unsigned char* ws; int ph_lo, ph_hi, li, pad; };
__global__ void __launch_bounds__(512, 2) fwd(Args args) {
    extern __shared__ __attribute__((aligned(16))) unsigned char lds_raw[];
    Ctx C;
    C.lds = (LAS unsigned char*)lds_raw; C.ws = args.ws; C.ctl = (unsigned*)(args.ws + WS_CTL); C.out = args.out;
    C.in = args.in;
    C.tid = threadIdx.x; C.lane = C.tid & 63; C.wave = __builtin_amdgcn_readfirstlane(C.tid >> 6);
    C.G = gridDim.x; { const int bx = blockIdx.x; C.vcu = (C.G % 8 == 0) ? (bx % 8) * (C.G / 8) + bx / 8 : bx; }
    volatile LAS unsigned* xbw = (volatile LAS unsigned*)(C.lds + MISC_OFF + 512);
    if (C.tid < 4) xbw[C.tid] = 0u;
    __syncthreads();
    const int lo = args.ph_lo, hi = args.ph_hi;
    XcdBarrier bar; bar.bar = C.ctl + CW_BAR + args.li * XCD_BAR_WORDS; bar.x = 0; bar.st = xbw;
    if (hi - lo > 1) bar = xcd_barrier_post(C.ctl + CW_BAR + args.li * XCD_BAR_WORDS, xbw);
#ifdef PH_ONLY
#define IN(k) ((k) == PH_ONLY && lo <= (k) && (k) < hi)
#else
#define IN(k) (lo <= (k) && (k) < hi)
#endif
#define SEAM(k) do { if (IN(k) && IN((k) + 1)) xcd_barrier(bar); else __syncthreads(); } while (0)
    bf16* HIN = WSP(bf16, WS_HIN); bf16* PROJ = WSP(bf16, WS_PROJ); bf16* MIXA = WSP(bf16, WS_MIXA); bf16* YMIX = WSP(bf16, WS_YMIX);

    if (IN(0)) for (int rep_ = 0; rep_ < ((REP_MASK & 32) ? 2 : 1); ++rep_) { p0a_weights(C); __syncthreads(); } SEAM(0);
    if (IN(1)) for (int rep_ = 0; rep_ < ((REP_MASK & 128) ? 2 : 1); ++rep_) { row_phase<0, 1, true>(C, C.in[0], 0, 0, nullptr, nullptr, 0, 1, 0, 0); __syncthreads(); } SEAM(1);

    if (IN(2)) for (int rep_ = 0; rep_ < ((REP_MASK & 1) ? 2 : 1); ++rep_) { pg8::EpiStore E{PROJ, M_NIN, nullptr, -1}; dense_gemm(C, HIN, WSP(bf16, WS_WMIN), M_NIN, D, E); __syncthreads(); } SEAM(2);
    if (IN(3)) for (int rep_ = 0; rep_ < ((REP_MASK & 1024) ? 2 : 1); ++rep_) { mlstm_conv(C, 0); __syncthreads(); } SEAM(3);
    if (IN(4)) for (int rep_ = 0; rep_ < ((REP_MASK & 4) ? 2 : 1); ++rep_) { mlstm_m1(C, 0); __syncthreads(); } SEAM(4);
    if (IN(5)) for (int rep_ = 0; rep_ < ((REP_MASK & 256) ? 2 : 1); ++rep_) { mlstm_m15(C); __syncthreads(); } SEAM(5);
    if (IN(6)) for (int rep_ = 0; rep_ < ((REP_MASK & 512) ? 2 : 1); ++rep_) { mlstm_m2(C, 0); __syncthreads(); } SEAM(6);
    if (IN(7)) for (int rep_ = 0; rep_ < ((REP_MASK & 1) ? 2 : 1); ++rep_) { pg8::EpiStore E{YMIX, D, nullptr, -1}; dense_gemm(C, MIXA, WSP(bf16, WS_WMOUT), D, D, E); __syncthreads(); } SEAM(7);
    if (IN(8)) { row_phase<1, 3, true>(C, C.in[0], 0, 2, C.in[4], C.in[5], 0, 4, 3, 0); } SEAM(8);
    if (IN(9)) for (int rep_ = 0; rep_ < ((REP_MASK & 2) ? 2 : 1); ++rep_) { moe_gemm1(C, 0); __syncthreads(); } SEAM(9);
    if (IN(10)) for (int rep_ = 0; rep_ < ((REP_MASK & 2) ? 2 : 1); ++rep_) { moe_gemm2(C, 0); __syncthreads(); } SEAM(10);
    if (IN(11)) { row_phase<2, 0, true>(C, C.out, 0, 5, C.in[6], C.in[7], 1, 1, 0, 0); } SEAM(11);

    if (IN(12)) for (int rep_ = 0; rep_ < ((REP_MASK & 1) ? 2 : 1); ++rep_) { pg8::EpiStore E{PROJ, D, nullptr, -1}; dense_gemm(C, HIN, WSP(bf16, WS_WS5IN), D, D, E); __syncthreads(); } SEAM(12);
    if (IN(13)) for (int rep_ = 0; rep_ < ((REP_MASK & 8) ? 2 : 1); ++rep_) { s5_pass<1>(C); __syncthreads(); } SEAM(13);
    if (IN(14)) for (int rep_ = 0; rep_ < ((REP_MASK & 8) ? 2 : 1); ++rep_) { s5_pass<2>(C); __syncthreads(); } SEAM(14);
    if (IN(15)) for (int rep_ = 0; rep_ < ((REP_MASK & 1) ? 2 : 1); ++rep_) { pg8::EpiPair<1> E{YMIX, D, -1}; dense_gemm(C, MIXA, WSP(bf16, WS_WS5GLU), 2 * D, D, E); __syncthreads(); } SEAM(15);
    if (IN(16)) { row_phase<1, 3, true>(C, C.out, 1, 2, C.in[4] + D, C.in[5] + D, 1, 4, 3, 0); } SEAM(16);
    if (IN(17)) for (int rep_ = 0; rep_ < ((REP_MASK & 2) ? 2 : 1); ++rep_) { moe_gemm1(C, 1); __syncthreads(); } SEAM(17);
    if (IN(18)) for (int rep_ = 0; rep_ < ((REP_MASK & 2) ? 2 : 1); ++rep_) { moe_gemm2(C, 1); __syncthreads(); } SEAM(18);
    if (IN(19)) { row_phase<2, 0, true>(C, C.out, 1, 5, C.in[6] + D, C.in[7] + D, 2, 1, 0, 0); } SEAM(19);

    if (IN(20)) for (int rep_ = 0; rep_ < ((REP_MASK & 1) ? 2 : 1); ++rep_) { pg8::EpiStore E{PROJ, A_NQKV, C.in[25], -1}; dense_gemm(C, HIN, WSP(bf16, WS_WQKV), A_NQKV, D, E); __syncthreads(); } SEAM(20);
    if (IN(21)) for (int rep_ = 0; rep_ < ((REP_MASK & 16) ? 2 : 1); ++rep_) { swa_phase(C); __syncthreads(); } SEAM(21);
    if (IN(22)) for (int rep_ = 0; rep_ < ((REP_MASK & 1) ? 2 : 1); ++rep_) { pg8::EpiStore E{YMIX, D, nullptr, -1}; dense_gemm(C, MIXA, WSP(bf16, WS_WWO), D, D, E); __syncthreads(); } SEAM(22);
    if (IN(23)) { row_phase<1, 3, true>(C, C.out, 2, 2, C.in[4] + 2 * D, C.in[5] + 2 * D, 2, 4, 3, 0); } SEAM(23);
    if (IN(24)) for (int rep_ = 0; rep_ < ((REP_MASK & 2) ? 2 : 1); ++rep_) { moe_gemm1(C, 2); __syncthreads(); } SEAM(24);
    if (IN(25)) for (int rep_ = 0; rep_ < ((REP_MASK & 2) ? 2 : 1); ++rep_) { moe_gemm2(C, 2); __syncthreads(); } SEAM(25);
    if (IN(26)) { row_phase<2, 1, true>(C, C.out, 2, 5, C.in[6] + 2 * D, C.in[7] + 2 * D, 3, 1, 0, 1); } SEAM(26);

    if (IN(27)) for (int rep_ = 0; rep_ < ((REP_MASK & 1) ? 2 : 1); ++rep_) { pg8::EpiStore E{PROJ, M_NIN, nullptr, -1}; dense_gemm(C, HIN, WSP(bf16, WS_WMIN) + (size_t)M_NIN * D, M_NIN, D, E); __syncthreads(); } SEAM(27);
    if (IN(28)) for (int rep_ = 0; rep_ < ((REP_MASK & 1024) ? 2 : 1); ++rep_) { mlstm_conv(C, 1); __syncthreads(); } SEAM(28);
    if (IN(29)) for (int rep_ = 0; rep_ < ((REP_MASK & 4) ? 2 : 1); ++rep_) { mlstm_m1(C, 1); __syncthreads(); } SEAM(29);
    if (IN(30)) for (int rep_ = 0; rep_ < ((REP_MASK & 256) ? 2 : 1); ++rep_) { mlstm_m15(C); __syncthreads(); } SEAM(30);
    if (IN(31)) for (int rep_ = 0; rep_ < ((REP_MASK & 512) ? 2 : 1); ++rep_) { mlstm_m2(C, 1); __syncthreads(); } SEAM(31);
    if (IN(32)) for (int rep_ = 0; rep_ < ((REP_MASK & 1) ? 2 : 1); ++rep_) { pg8::EpiStore E{YMIX, D, nullptr, -1}; dense_gemm(C, MIXA, WSP(bf16, WS_WMOUT) + (size_t)D * D, D, D, E); __syncthreads(); } SEAM(32);
    if (IN(33)) { row_phase<1, 3, true>(C, C.out, 3, 2, C.in[4] + 3 * D, C.in[5] + 3 * D, 3, 4, 3, 0); } SEAM(33);
    if (IN(34)) for (int rep_ = 0; rep_ < ((REP_MASK & 2) ? 2 : 1); ++rep_) { moe_gemm1(C, 3); __syncthreads(); } SEAM(34);
    if (IN(35)) for (int rep_ = 0; rep_ < ((REP_MASK & 2) ? 2 : 1); ++rep_) { moe_gemm2(C, 3); __syncthreads(); } SEAM(35);
    if (IN(36)) { row_phase<2, 0, false>(C, C.out, 3, 5, C.in[6] + 3 * D, C.in[7] + 3 * D, 0, 0, 0, 0); }
#undef IN
#undef SEAM
}

#ifndef MK_LAUNCH_PER_PHASE
#define MK_LAUNCH_PER_PHASE 0
#endif
extern "C" void kernel_launch(void* const* d_in, const int* in_sizes, int n_in, void* d_out, int out_size, void* d_ws, size_t ws_size, hipStream_t stream) {
    static int grid = 0;
    if (grid == 0) {
        if (n_in != 35 || out_size != T * D || ws_size < WS_END) { fprintf(stderr, "kernel_launch: unexpected shapes (n_in %d, out %d, ws %zu < %zu)\n", n_in, out_size, ws_size, (size_t)WS_END); grid = -1; return; }
        int dev = 0, cus = 0, per_cu = 0;
        if (hipGetDevice(&dev) != hipSuccess || hipDeviceGetAttribute(&cus, hipDeviceAttributeMultiprocessorCount, dev) != hipSuccess) { grid = -1; return; }
        if (hipFuncSetAttribute((const void*)fwd, hipFuncAttributeMaxDynamicSharedMemorySize, LDS_BYTES) != hipSuccess) { fprintf(stderr, "kernel_launch: hipFuncSetAttribute failed\n"); grid = -1; return; }
        if (hipOccupancyMaxActiveBlocksPerMultiprocessor(&per_cu, (const void*)fwd, 512, LDS_BYTES) != hipSuccess || per_cu < 1) fprintf(stderr, "kernel_launch: occupancy query says %d\n", per_cu);
        (void)hipGetLastError();
        grid = cus;
    }
    if (grid < 0) return;
    (void)hipMemsetAsync((char*)d_ws + WS_CTL, 0, CTL_ZERO_BYTES, stream);
    Args a{};
    for (int i = 0; i < 35; ++i) a.in[i] = (const float*)d_in[i];
    a.out = (float*)d_out; a.ws = (unsigned char*)d_ws;
#if MK_LAUNCH_PER_PHASE
    for (int p = 0; p < N_PHASES; ++p) { a.ph_lo = p; a.ph_hi = p + 1; a.li = 0; hipLaunchKernelGGL(fwd, dim3(grid), dim3(512), LDS_BYTES, stream, a); }
#else
    a.ph_lo = 0; a.ph_hi = N_PHASES; a.li = 0;
    hipLaunchKernelGGL(fwd, dim3(grid), dim3(512), LDS_BYTES, stream, a);
#endif
}
```
